# Optimizing an MI355X kernel written in HIP

```python
import jax, jax.numpy as jnp
from jax import lax
import numpy as np

D_MODEL = 2048
BATCH = 8
SEQ = 4096
DEPTH = 1

GRID_W = 64
CTX_LEN = 256
D_FF = 5632
MIX_WIDTH = D_MODEL
MLSTM_HEADS = 4
MLSTM_DV = MIX_WIDTH // 2 // MLSTM_HEADS
MLSTM_DK = MLSTM_DV // 2
MLSTM_WIDTH = MLSTM_HEADS * MLSTM_DV
QK_WIDTH = 2 * MLSTM_HEADS * MLSTM_DK
CONV_K = 5
MLSTM_CHUNK = 128
GMLP_CHUNK = 128
GMLP_GROUPS = 8
GMLP_WIDTH = MIX_WIDTH - MLSTM_WIDTH
GMLP_GD = GMLP_WIDTH // GMLP_GROUPS
CHUNK_ROWS = GMLP_CHUNK // GRID_W
N_MOD = 9
EPS = 1e-6
COL_QK_END = QK_WIDTH
COL_V_END = COL_QK_END + MLSTM_WIDTH
COL_O_END = COL_V_END + MLSTM_WIDTH
COL_GATE_END = COL_O_END + 4 * MLSTM_HEADS
IN_COLS = COL_GATE_END + 2 * GMLP_WIDTH

kernel_name = "hymba_mlstm_gmlp_macaron_dit"


def rms_norm(x, g):
    xf = x.astype(jnp.float32)
    y = xf * lax.rsqrt(jnp.mean(xf * xf, axis=-1, keepdims=True) + EPS)
    return (y * g.astype(jnp.float32)).astype(x.dtype)


def modulate(x, shift, scale):
    return x * (1 + scale) + shift


def adaln(cond, w, b):
    mod = jax.nn.silu(cond) @ w + b
    return jnp.split(mod, N_MOD, axis=-1)


def swiglu(x, w_in, w_out):
    gate, up = jnp.split(x @ w_in, 2, axis=-1)
    return (jax.nn.silu(gate) * up) @ w_out


def centred_conv(x, w, b):
    T = x.shape[1]
    p = w.shape[0] // 2
    xp = jnp.pad(x, ((0, 0), (p, p), (0, 0)))
    y = b
    for j in range(w.shape[0]):
        y = y + xp[:, j:j + T] * w[j]
    return y


def _to_chunks(a, n_chunks):
    B, T, H, d = a.shape
    return a.astype(jnp.float32).reshape(B, n_chunks, T // n_chunks, H, d).transpose(1, 0, 3, 2, 4)


def _gate_chunks(a, n_chunks):
    B, T, H = a.shape
    return a.astype(jnp.float32).reshape(B, n_chunks, T // n_chunks, H).transpose(1, 0, 3, 2)


def _state_update(state, k, v, logi, b):
    C, n, m = state
    b_last = b[..., -1]
    g = b_last[..., None] - b + logi
    m_new = jnp.maximum(b_last + m, jnp.max(g, axis=-1))
    decay = jnp.exp(b_last + m - m_new)
    kw = k * jnp.exp(g - m_new[..., None])[..., None]
    C_new = decay[..., None, None] * C + jnp.einsum('bhld,bhle->bhde', kw, v)
    n_new = decay[..., None] * n + jnp.sum(kw, axis=2)
    return (C_new, n_new, m_new)


def _chunk_output(state, q, k, v, logi, b):
    C, n, m = state
    L = q.shape[2]
    tri = jnp.tril(jnp.ones((L, L), dtype=bool))
    d_mat = jnp.where(tri, b[..., :, None] - b[..., None, :] + logi[..., None, :], -jnp.inf)
    m_inter = b + m[..., None]
    m_tok = jnp.maximum(m_inter, jnp.max(d_mat, axis=-1))
    s = jnp.einsum('bhjd,bhld->bhjl', q, k) * jnp.exp(d_mat - m_tok[..., None])
    a = jnp.exp(m_inter - m_tok)
    num = a[..., None] * jnp.einsum('bhjd,bhde->bhje', q, C) + jnp.einsum('bhjl,bhle->bhje', s, v)
    nq = a * jnp.einsum('bhjd,bhd->bhj', q, n) + jnp.sum(s, axis=-1)
    return num / jnp.maximum(jnp.abs(nq), jnp.exp(-m_tok))[..., None]


def mlstm_scan(q, k, v, logi, logf, state):
    B, T, H, _ = q.shape
    nc = T // MLSTM_CHUNK
    xs = (_to_chunks(q, nc), _to_chunks(k, nc), _to_chunks(v, nc),
          _gate_chunks(logi, nc), _gate_chunks(logf, nc))

    def body(carry, inp):
        qc, kc, vc, ic, fc = inp
        b = jnp.cumsum(fc, axis=-1)
        h = _chunk_output(carry, qc, kc, vc, ic, b)
        return _state_update(carry, kc, vc, ic, b), h

    state, h = lax.scan(body, state, xs)
    h = h.transpose(1, 0, 3, 2, 4).reshape(B, T, H, -1)
    return h.astype(v.dtype), state


def mlstm_final_state(k, v, logi, logf, state):
    nc = k.shape[1] // MLSTM_CHUNK
    xs = (_to_chunks(k, nc), _to_chunks(v, nc), _gate_chunks(logi, nc), _gate_chunks(logf, nc))

    def body(carry, inp):
        kc, vc, ic, fc = inp
        return _state_update(carry, kc, vc, ic, jnp.cumsum(fc, axis=-1)), None

    state, _ = lax.scan(body, state, xs)
    return state


def mlstm_inputs(z, conv_w, conv_b, b_igate, b_fgate):
    B, T, _ = z.shape
    qk = jax.nn.silu(centred_conv(z[..., :COL_QK_END], conv_w, conv_b))
    q = qk[..., :QK_WIDTH // 2].reshape(B, T, MLSTM_HEADS, MLSTM_DK) * (MLSTM_DK ** -0.5)
    k = qk[..., QK_WIDTH // 2:].reshape(B, T, MLSTM_HEADS, MLSTM_DK)
    v = z[..., COL_QK_END:COL_V_END].reshape(B, T, MLSTM_HEADS, MLSTM_DV)
    o = jax.nn.sigmoid(z[..., COL_V_END:COL_O_END])
    gates = z[..., COL_O_END:COL_GATE_END].reshape(B, T, 2, 2, MLSTM_HEADS)
    logi = (gates[..., 0, :] + b_igate).astype(jnp.float32)
    logf = jax.nn.log_sigmoid((gates[..., 1, :] + b_fgate).astype(jnp.float32))
    return q, k, v, o, logi, logf


def mlstm_group(zc, zx, conv_w, conv_b, b_igate, b_fgate, norm_g, ctx_out):
    qc, kc, vc, oc, ic, fc = mlstm_inputs(zc, conv_w, conv_b, b_igate, b_fgate)
    qx, kx, vx, ox, ix, fx = mlstm_inputs(zx, conv_w, conv_b, b_igate, b_fgate)
    B = qx.shape[0]
    zero = (jnp.zeros((B, MLSTM_HEADS, MLSTM_DK, MLSTM_DV), jnp.float32),
            jnp.zeros((B, MLSTM_HEADS, MLSTM_DK), jnp.float32),
            jnp.zeros((B, MLSTM_HEADS), jnp.float32))
    hx = jnp.zeros_like(vx)
    hc = jnp.zeros_like(vc)
    for d in range(2):
        rev = (lambda a: jnp.flip(a, axis=1)) if d == 1 else (lambda a: a)
        if ctx_out:
            h, st = mlstm_scan(rev(qc), rev(kc), rev(vc), rev(ic[:, :, d]), rev(fc[:, :, d]), zero)
            hc = hc + rev(h)
        else:
            st = mlstm_final_state(rev(kc), rev(vc), rev(ic[:, :, d]), rev(fc[:, :, d]), zero)
        h, _ = mlstm_scan(rev(qx), rev(kx), rev(vx), rev(ix[:, :, d]), rev(fx[:, :, d]), st)
        hx = hx + rev(h)

    def finish(h, o):
        hn = rms_norm(h, norm_g.reshape(MLSTM_HEADS, MLSTM_DV))
        return hn.reshape(o.shape) * o

    return finish(hx, ox), (finish(hc, oc) if ctx_out else None)


def gmlp_group(z, w_s, b_s, norm_g, n_chunks):
    B, T, _ = z.shape
    u, v = jnp.split(jax.nn.gelu(z), 2, axis=-1)
    v = rms_norm(v, norm_g).reshape(B, n_chunks, T // n_chunks, GMLP_GROUPS, GMLP_GD)
    s = jnp.einsum('gpq,bcqgd->bcpgd', w_s, v) + b_s.T[:, :, None]
    return u * s.reshape(B, T, GMLP_WIDTH)


def setup_inputs(seed: int = 0) -> dict:
    key = jax.random.key(seed)
    ks = jax.random.split(key, 24)

    def nrm(k, shape, scale):
        return jax.random.normal(k, shape, jnp.float32) * scale

    L, D = DEPTH, D_MODEL
    return {
        "x": nrm(ks[0], (BATCH, SEQ, D), 1.0),
        "c": nrm(ks[1], (BATCH, D), 1.0),
        "ctx": nrm(ks[2], (BATCH, CTX_LEN, D), 1.0),
        "c_ctx": nrm(ks[3], (D,), 1.0),
        "w_ada": nrm(ks[4], (L, D, N_MOD * D), 0.5 * D ** -0.5),
        "b_ada": nrm(ks[5], (L, N_MOD * D), 0.02),
        "norm_ffn1": 1.0 + nrm(ks[6], (L, D), 0.02),
        "w_ffn1_in": nrm(ks[7], (L, D, 2 * D_FF), D ** -0.5),
        "w_ffn1_out": nrm(ks[8], (L, D_FF, D), D_FF ** -0.5),
        "norm_mix": 1.0 + nrm(ks[9], (L, D), 0.02),
        "w_in": nrm(ks[10], (L, D, IN_COLS), D ** -0.5),
        "conv_w": nrm(ks[11], (L, CONV_K, QK_WIDTH), CONV_K ** -0.5),
        "conv_b": nrm(ks[12], (L, QK_WIDTH), 0.02),
        "b_igate": nrm(ks[13], (L, 2, MLSTM_HEADS), 0.1),
        "b_fgate": 3.0 + 3.0 * jax.random.uniform(ks[14], (L, 2, MLSTM_HEADS), jnp.float32),
        "mlstm_norm": 1.0 + nrm(ks[15], (L, MLSTM_WIDTH), 0.02),
        "gmlp_norm": 1.0 + nrm(ks[16], (L, GMLP_WIDTH), 0.02),
        "gmlp_w": nrm(ks[17], (L, GMLP_GROUPS, GMLP_CHUNK, GMLP_CHUNK), GMLP_CHUNK ** -0.5),
        "gmlp_b": 1.0 + nrm(ks[18], (L, GMLP_GROUPS, GMLP_CHUNK), 0.1),
        "w_out": nrm(ks[19], (L, MIX_WIDTH, D), MIX_WIDTH ** -0.5),
        "norm_ffn2": 1.0 + nrm(ks[20], (L, D), 0.02),
        "w_ffn2_in": nrm(ks[21], (L, D, 2 * D_FF), D ** -0.5),
        "w_ffn2_out": nrm(ks[22], (L, D_FF, D), D_FF ** -0.5),
        "final_norm": 1.0 + nrm(ks[23], (D,), 0.02),
    }


def reference(x, c, ctx, c_ctx, w_ada, b_ada, norm_ffn1, w_ffn1_in, w_ffn1_out, norm_mix, w_in,
              conv_w, conv_b, b_igate, b_fgate, mlstm_norm, gmlp_norm, gmlp_w, gmlp_b, w_out,
              norm_ffn2, w_ffn2_in, w_ffn2_out, final_norm):
    rows = x.shape[1] // GRID_W
    n_lat_chunks = rows // CHUNK_ROWS
    n_ctx_chunks = ctx.shape[1] // GMLP_CHUNK
    for l in range(DEPTH):
        last = l == DEPTH - 1
        mx = [m[:, None, :] for m in adaln(c, w_ada[l], b_ada[l])]
        mc = adaln(c_ctx, w_ada[l], b_ada[l])

        x = x + 0.5 * mx[2] * swiglu(modulate(rms_norm(x, norm_ffn1[l]), mx[0], mx[1]), w_ffn1_in[l], w_ffn1_out[l])
        ctx = ctx + 0.5 * mc[2] * swiglu(modulate(rms_norm(ctx, norm_ffn1[l]), mc[0], mc[1]), w_ffn1_in[l], w_ffn1_out[l])

        zx = modulate(rms_norm(x, norm_mix[l]), mx[3], mx[4]) @ w_in[l]
        w_in_ctx = w_in[l][:, :COL_GATE_END] if last else w_in[l]
        zc = modulate(rms_norm(ctx, norm_mix[l]), mc[3], mc[4]) @ w_in_ctx
        hx, hc = mlstm_group(zc[..., :COL_GATE_END], zx[..., :COL_GATE_END], conv_w[l], conv_b[l],
                             b_igate[l], b_fgate[l], mlstm_norm[l], not last)
        gx = gmlp_group(zx[..., COL_GATE_END:], gmlp_w[l], gmlp_b[l], gmlp_norm[l], n_lat_chunks)
        x = x + mx[5] * (jnp.concatenate([hx, gx], axis=-1) @ w_out[l])

        x = x + 0.5 * mx[8] * swiglu(modulate(rms_norm(x, norm_ffn2[l]), mx[6], mx[7]), w_ffn2_in[l], w_ffn2_out[l])

        if not last:
            gc = gmlp_group(zc[..., COL_GATE_END:], gmlp_w[l], gmlp_b[l], gmlp_norm[l], n_ctx_chunks)
            ctx = ctx + mc[5] * (jnp.concatenate([hc, gc], axis=-1) @ w_out[l])
            ctx = ctx + 0.5 * mc[8] * swiglu(modulate(rms_norm(ctx, norm_ffn2[l]), mc[6], mc[7]), w_ffn2_in[l], w_ffn2_out[l])
    return rms_norm(x, final_norm)
```

```cpp
#include <hip/hip_runtime.h>
#include <hip/hip_cooperative_groups.h>
#include <cstdio>
namespace cg = cooperative_groups;

#ifndef MK_MULTI
#define MK_MULTI 0
#endif

#ifndef PHSEL
#define PHSEL 0xffff
#endif
#define PHON(n) ((PHSEL >> (n)) & 1)
#define LAS __attribute__((address_space(3)))
typedef unsigned short bf16_t;
typedef short bf16x8 __attribute__((ext_vector_type(8)));
typedef float f32x4 __attribute__((ext_vector_type(4)));
typedef unsigned u32x4 __attribute__((ext_vector_type(4)));
typedef unsigned u32x2 __attribute__((ext_vector_type(2)));

constexpr int D = 2048, ML = 32768, MC = 2048, M1 = ML + MC, DFF = 5632, NMODC = 9 * 2048, INP = 5376;
constexpr int NPH = 15;
constexpr int LDS_BYTES = 147456;

constexpr size_t al256(size_t x) { return (x + 255) & ~(size_t)255; }
constexpr size_t WS_WF1IN = 0;
constexpr size_t WS_WF1OUT = WS_WF1IN + (size_t)11264 * 2048 * 2;
constexpr size_t WS_WIN = WS_WF1OUT + (size_t)2048 * 5632 * 2;
constexpr size_t WS_WOUT = WS_WIN + (size_t)INP * 2048 * 2;
constexpr size_t WS_WF2IN = WS_WOUT + (size_t)2048 * 2048 * 2;
constexpr size_t WS_WF2OUT = WS_WF2IN + (size_t)11264 * 2048 * 2;
constexpr size_t WS_MOD = WS_WF2OUT + (size_t)2048 * 5632 * 2;
constexpr size_t WS_XN = al256(WS_MOD + (size_t)9 * NMODC * 4);
constexpr size_t WS_MPREV = WS_XN + (size_t)M1 * 2048 * 2;
constexpr size_t WS_H = al256(WS_MPREV + 64 * 32 * 4);
constexpr size_t WS_ZQK = WS_H;
constexpr size_t WS_V = WS_ZQK + (size_t)M1 * 1024 * 2;
constexpr size_t WS_O = WS_V + (size_t)M1 * 1024 * 2;
constexpr size_t WS_U = WS_O + (size_t)ML * 1024 * 2;
constexpr size_t WS_GV = WS_U + (size_t)ML * 1024 * 2;
constexpr size_t WS_HDIR = WS_U;
constexpr size_t WS_G = WS_GV + (size_t)ML * 1024 * 2;
constexpr size_t WS_Q = WS_G + (size_t)M1 * 16 * 4;
constexpr size_t WS_X1C = al256(WS_H + (size_t)M1 * DFF * 2);
constexpr size_t WS_CAT = WS_X1C + (size_t)MC * 2048 * 4;
constexpr size_t WS_K = WS_CAT + (size_t)ML * 2048 * 2;
constexpr size_t WS_KT = WS_K + (size_t)ML * 512 * 2;
constexpr size_t WS_VT = WS_KT + (size_t)272 * 4 * 128 * 128 * 2;
constexpr size_t WS_BAR = WS_VT + (size_t)272 * 4 * 256 * 128 * 2;
constexpr size_t WS_END = WS_BAR + 16384;
static_assert(WS_Q + (size_t)ML * 512 * 2 <= WS_X1C, "in-proj outputs overflow the H region");

struct Params {
    const float* in[24];
    float* out;
    unsigned char* ws;
    int ph_lo, ph_hi;
};

__device__ __forceinline__ unsigned cvt_pk_bf16(float lo, float hi) { unsigned r; asm volatile("v_cvt_pk_bf16_f32 %0, %1, %2" : "=v"(r) : "v"(lo), "v"(hi)); return r; }
__device__ __forceinline__ float bflo(unsigned u) { return __uint_as_float(u << 16); }
__device__ __forceinline__ float bfhi(unsigned u) { return __uint_as_float(u & 0xffff0000u); }
__device__ __forceinline__ float bfel(const u32x4& v, int c) { const unsigned w = (c >> 1) == 0 ? v.x : (c >> 1) == 1 ? v.y : (c >> 1) == 2 ? v.z : v.w; return (c & 1) ? bfhi(w) : bflo(w); }
__device__ __forceinline__ unsigned us16(const u32x4& v, int c) { const unsigned w = (c >> 1) == 0 ? v.x : (c >> 1) == 1 ? v.y : (c >> 1) == 2 ? v.z : v.w; return (c & 1) ? (w >> 16) : (w & 0xffffu); }
__device__ __forceinline__ float wave_sum(float v) {
#pragma unroll
    for (int o = 32; o; o >>= 1) v += __shfl_xor(v, o);
    return v; }
__device__ __forceinline__ float wave_max(float v) {
#pragma unroll
    for (int o = 32; o; o >>= 1) v = fmaxf(v, __shfl_xor(v, o));
    return v; }
__device__ __forceinline__ float wave_scan_sum(float v, int lane) {
#pragma unroll
    for (int o = 1; o < 64; o <<= 1) { const float t = __shfl_up(v, o); if (lane >= o) v += t; }
    return v; }
__device__ __forceinline__ float wave_scan_max(float v, int lane) {
#pragma unroll
    for (int o = 1; o < 64; o <<= 1) { const float t = __shfl_up(v, o); if (lane >= o) v = fmaxf(v, t); }
    return v; }
__device__ __forceinline__ float fexp2_(float x) { return __builtin_amdgcn_exp2f(x); }
__device__ __forceinline__ float sigmoidf_(float x) { return __builtin_amdgcn_rcpf(1.f + fexp2_(-1.4426950408889634f * x)); }
__device__ __forceinline__ float siluf_(float x) { return x * __builtin_amdgcn_rcpf(1.f + fexp2_(-1.4426950408889634f * x)); }
__device__ __forceinline__ float geluf_(float x) { const float y = x * (-2.3022082f + -0.1029432f * x * x); return x * __builtin_amdgcn_rcpf(1.f + fexp2_(y)); }

#define XB_TMO      128
#define XB_XCNT(j)  (256  + 64 * (j))
#define XB_XSUB(j)  (1280 + 64 * (j))
#define XB_XGEN(j)  (2304 + 64 * (j))
#define XB_TOP      3328
#define XB_TOPGEN   3392
#define XCD_BAR_WORDS 3456
#define XB_SPIN_CAP (1u << 22)
__device__ __forceinline__ unsigned xb_ld(unsigned* p)              { return __hip_atomic_load(p, __ATOMIC_RELAXED, __HIP_MEMORY_SCOPE_AGENT); }
__device__ __forceinline__ unsigned xb_add(unsigned* p, unsigned v) { return __hip_atomic_fetch_add(p, v, __ATOMIC_RELAXED, __HIP_MEMORY_SCOPE_AGENT); }
__device__ __forceinline__ unsigned xb_xcc_id() { return (unsigned)__builtin_amdgcn_s_getreg((3 << 11) | 20) & 0xFu; }
#define XB_SPIN(cond, bar) do { unsigned _sp = 0; while (cond) { __builtin_amdgcn_s_sleep(1); \
    if ((++_sp & 255u) == 0u) { if (xb_ld(&(bar)[XB_TMO])) break; if (_sp > XB_SPIN_CAP) { atomicAdd(&(bar)[XB_TMO], 1u); break; } } } } while (0)
struct XcdBarrier { unsigned* bar; unsigned x; volatile LAS unsigned* st; };
__device__ __forceinline__ XcdBarrier xcd_barrier_post(unsigned* bar, volatile LAS unsigned* st) {
    XcdBarrier b; b.bar = bar; b.x = xb_xcc_id(); b.st = st;
    if (threadIdx.x == 0) (void)xb_add(&bar[XB_XCNT(b.x)], 1u);
    return b;
}
__device__ __forceinline__ void xcd_barrier_complete(unsigned* bar, unsigned x, unsigned& nloc, unsigned& nx) {
    const unsigned G = gridDim.x * gridDim.y * gridDim.z;
    unsigned sum, cnt, mine, sp = 0u;
    for (;;) {
        sum = 0u; cnt = 0u; mine = 0u;
#pragma unroll
        for (unsigned j = 0; j < 16; ++j) { const unsigned c = xb_ld(&bar[XB_XCNT(j)]); sum += c; cnt += (c > 0u) ? 1u : 0u; mine = (j == x) ? c : mine; }
        if (sum == G) break;
        __builtin_amdgcn_s_sleep(1);
        if ((++sp & 255u) == 0u) { if (xb_ld(&bar[XB_TMO])) break; if (sp > XB_SPIN_CAP) { atomicAdd(&bar[XB_TMO], 1u); break; } }
    }
    nloc = mine > 0u ? mine : 1u; nx = cnt > 0u ? cnt : 1u;
}
__device__ __forceinline__ void xcd_barrier(const XcdBarrier& b) {
    asm volatile("s_waitcnt vmcnt(0)" ::: "memory");
    __syncthreads();
    if (threadIdx.x == 0) {
        unsigned* bar = b.bar;
        __builtin_amdgcn_s_waitcnt(0);
        unsigned nloc = b.st[0], nx = b.st[1];
        if (nloc == 0u) { xcd_barrier_complete(bar, b.x, nloc, nx); b.st[0] = nloc; b.st[1] = nx; }
        const unsigned old = xb_add(&bar[XB_XSUB(b.x)], 1u);
        const unsigned gen = old / nloc;
        if (old + 1u == (gen + 1u) * nloc) {
            __builtin_amdgcn_fence(__ATOMIC_RELEASE, "agent");
            asm volatile("s_waitcnt vmcnt(0)" ::: "memory");
            const unsigned og = xb_add(&bar[XB_TOP], 1u);
            const unsigned tg = og / nx;
            if (og + 1u == (tg + 1u) * nx) xb_add(&bar[XB_TOPGEN], 1u);
            else XB_SPIN(xb_ld(&bar[XB_TOPGEN]) == tg, bar);
            __builtin_amdgcn_fence(__ATOMIC_ACQUIRE, "agent");
            xb_add(&bar[XB_XGEN(b.x)], 1u);
            asm volatile("s_waitcnt vmcnt(0)" ::: "memory");
        } else {
            XB_SPIN(xb_ld(&bar[XB_XGEN(b.x)]) == gen, bar);
            __builtin_amdgcn_fence(__ATOMIC_ACQUIRE, "agent");
            asm volatile("s_waitcnt vmcnt(0)" ::: "memory");
        }
    }
    __syncthreads();
}

namespace pg8 {
constexpr int BM = 256, BK = 64, HALF = 128, HTB = HALF * BK * 2, NXCD = 8, WGM = 8;
__device__ __forceinline__ int lds_byte(int r, int c) { const int st = (r >> 4) * 2 + (c >> 5), rr = r & 15, cc = c & 31, ob = rr * 64 + cc * 2; return st * 1024 + (ob ^ (((ob >> 9) & 1) << 5)); }
__device__ __forceinline__ void stage_rc(int b, int& R, int& C) { const int st = b / 1024, sb = b % 1024, swz = sb ^ (((sb >> 9) & 1) << 5); R = (st >> 1) * 16 + swz / 64; C = (st & 1) * 32 + (swz % 64) / 2; }
__device__ __forceinline__ int perm32(int rho) { const int n = rho >> 4, i = rho & 15; return 8 * (i >> 2) + 4 * n + (i & 3); }
struct Unit { int pm, pn, ks; };
struct StaticOrder {
    int nM, nN, nwg, G, c;
    __device__ void init(int M, int N, int G_, int c_) { nM = M / BM; nN = N / BM; nwg = nM * nN; G = G_; c = c_; extra = 0; pre = 0; }
    int extra;
    int pre;
    __device__ bool next(int i, Unit& u) const {
        long L = (long)i * G + c; u.ks = -1;
        if (L < pre) { const int t = (int)L & 63; u.ks = (int)L >> 6; u.pm = nM + (t >> 3); u.pn = t & 7; return true; }
        L -= pre;
        if (L >= nwg + extra) return false;
        if (L >= nwg) { const int j = (int)(L - nwg); const int q = j >> 3; u.pm = nM + (j & 7); u.pn = q < 6 ? q + 2 : 20; return true; }
        int wgid = (int)L; { const int q = nwg / NXCD, r = nwg % NXCD, xcd = wgid % NXCD, off = wgid / NXCD; wgid = (xcd < r ? xcd * (q + 1) : r * (q + 1) + (xcd - r) * q) + off; }
        const int wgm = nN <= 8 ? 4 : WGM;
        const int nig = wgm * nN, gid = wgid / nig, fm = gid * wgm, gsz = (nM - fm) < wgm ? (nM - fm) : wgm;
        u.pm = fm + ((wgid % nig) % gsz); u.pn = (wgid % nig) / gsz; return true;
    }
};
}

enum { EPI_SWIGLU = 0, EPI_RESID = 1, EPI_INPROJ = 2 };
__device__ __forceinline__ void gemm_epilogue(const Params& p, const int epi, bf16_t* const Hp, const int goff, const float coef, const f32x4 (&acc)[2][2][4][2], const pg8::Unit& u, int wr, int wc, int fr, int fq) {
    if (epi == EPI_SWIGLU) {
        const int col0 = u.pn * 128 + wc * 32 + fq * 8;
#pragma unroll
        for (int ai = 0; ai < 2; ++ai)
#pragma unroll
            for (int m = 0; m < 4; ++m) {
                const int row = u.pm * 256 + ai * 128 + wr * 64 + m * 16 + fr;
                float h[8];
#pragma unroll
                for (int n = 0; n < 2; ++n)
#pragma unroll
                    for (int i = 0; i < 4; ++i) h[n * 4 + i] = siluf_(acc[ai][0][m][n][i]) * acc[ai][1][m][n][i];
                u32x4 o; o.x = cvt_pk_bf16(h[0], h[1]); o.y = cvt_pk_bf16(h[2], h[3]); o.z = cvt_pk_bf16(h[4], h[5]); o.w = cvt_pk_bf16(h[6], h[7]);
                *(u32x4*)(Hp + (size_t)row * DFF + col0) = o;
            }
    } else if (epi == EPI_RESID) {
        const bool lat = u.pm < 128;
        const int b = lat ? (u.pm >> 4) : 8;
        const float* gate = (const float*)(p.ws + WS_MOD) + (size_t)b * NMODC + goff;
#pragma unroll
        for (int bj = 0; bj < 2; ++bj) {
            const int col = u.pn * 256 + bj * 128 + wc * 32 + fq * 8;
            const f32x4 g0 = *(const f32x4*)(gate + col) * coef, g1 = *(const f32x4*)(gate + col + 4) * coef;
#pragma unroll
            for (int ai = 0; ai < 2; ++ai)
#pragma unroll
                for (int m = 0; m < 4; ++m) {
                    const int row = u.pm * 256 + ai * 128 + wr * 64 + m * 16 + fr;
                    const f32x4 v0 = acc[ai][bj][m][0] * g0, v1 = acc[ai][bj][m][1] * g1;
                    u32x4 o; o.x = cvt_pk_bf16(v0[0], v0[1]); o.y = cvt_pk_bf16(v0[2], v0[3]); o.z = cvt_pk_bf16(v1[0], v1[1]); o.w = cvt_pk_bf16(v1[2], v1[3]);
                    *(u32x4*)((u.ks >= 0 ? (bf16_t*)(p.ws + WS_CAT) + (size_t)u.ks * MC * D + (size_t)(row - ML) * D : Hp + (size_t)row * D) + col) = o;
                }
        }
    } else {
        const int seg = u.pn >> 2;
        const bool lat = u.pm < 128;
        if (seg < 5) {
            if (seg >= 2 && !lat) return;
            bf16_t* dst = (bf16_t*)(p.ws + (seg == 0 ? WS_ZQK : seg == 1 ? WS_V : seg == 2 ? WS_O : seg == 3 ? WS_U : WS_GV));
#pragma unroll
            for (int ai = 0; ai < 2; ++ai)
#pragma unroll
                for (int m = 0; m < 4; ++m) {
                    const int row = u.pm * 256 + ai * 128 + wr * 64 + m * 16 + fr;
#pragma unroll
                    for (int bj = 0; bj < 2; ++bj) {
                        const int cl = (u.pn & 3) * 256 + bj * 128 + wc * 32 + fq * 8;
                        float h[8];
#pragma unroll
                        for (int n = 0; n < 2; ++n)
#pragma unroll
                            for (int i = 0; i < 4; ++i) { const float a = acc[ai][bj][m][n][i]; h[n * 4 + i] = seg < 2 ? a : seg == 2 ? sigmoidf_(a) : geluf_(a); }
                        u32x4 o; o.x = cvt_pk_bf16(h[0], h[1]); o.y = cvt_pk_bf16(h[2], h[3]); o.z = cvt_pk_bf16(h[4], h[5]); o.w = cvt_pk_bf16(h[6], h[7]);
                        *(u32x4*)(dst + (size_t)row * 1024 + cl) = o;
                    }
                }
        } else if (wc == 0 && fq < 2) {
            const f32x4 bi = *(const f32x4*)(p.in[13] + fq * 4), bfv = *(const f32x4*)(p.in[14] + fq * 4);
#pragma unroll
            for (int ai = 0; ai < 2; ++ai)
#pragma unroll
                for (int m = 0; m < 4; ++m) {
                    const int row = u.pm * 256 + ai * 128 + wr * 64 + m * 16 + fr;
                    const f32x4 li = acc[ai][0][m][0] + bi;
                    const f32x4 xf = acc[ai][0][m][1] + bfv;
                    f32x4 lf;
#pragma unroll
                    for (int i = 0; i < 4; ++i) lf[i] = fminf(xf[i], 0.f) - log1pf(expf(-fabsf(xf[i])));
                    *(f32x4*)((float*)(p.ws + WS_G) + (size_t)row * 16 + fq * 8) = li;
                    *(f32x4*)((float*)(p.ws + WS_G) + (size_t)row * 16 + fq * 8 + 4) = lf;
                }
        }
    }
}

__device__ __forceinline__ void gemm_phase(LAS unsigned char* lds, const Params& p, const bf16_t* gA, const bf16_t* gBt, const int gM, const int gN, const int gK, const int epi, const int perm, bf16_t* const Hp, const int goff, const float coef) {
    using namespace pg8;
    const int tid = threadIdx.x, wid = __builtin_amdgcn_readfirstlane(tid >> 6), lane = tid & 63, wr = wid >> 2, wc = wid & 3, fr = lane & 15, fq = lane >> 4;
    const int K = gK, ntf = K / BK;
    const size_t ksl = (size_t)(K / 4) * 2;
    StaticOrder S; S.init(gM, gN, (int)gridDim.x, (int)blockIdx.x);
    if (epi == EPI_INPROJ) { S.init(ML, gN, (int)gridDim.x, (int)blockIdx.x); S.extra = 56; }
    if (epi == EPI_RESID && gM == M1) { S.init(ML, gN, (int)gridDim.x, (int)blockIdx.x); S.pre = 256; }
    unsigned voffA[2], voffB[2];
#pragma unroll
    for (int i = 0; i < 2; ++i) { int R, C; stage_rc(tid * 16 + i * 8192, R, C); const int Rb = perm ? ((R & ~31) + perm32(R & 31)) : R;
        voffA[i] = (unsigned)(R * K + C) * 2u; voffB[i] = (unsigned)(Rb * K + C) * 2u; }
    const size_t kstep = (size_t)(BK * 2);
    const size_t hstep = (size_t)HALF * K * 2;
    const size_t tstep = 2 * hstep;
    const unsigned ldsw = (unsigned)wid * 1024u;
    const int aoff = lds_byte(wr * 64 + fr, fq * 8), boff = lds_byte(wc * 32 + fr, fq * 8);
#define PG8_SA(b, h) (((b) * 2 + (h)) * HTB)
#define PG8_SB(b, h) ((4 + (b) * 2 + (h)) * HTB)
#define PG8_STAGE(bufoff, gbase, voff) do { _Pragma("unroll") for (int _i = 0; _i < 2; ++_i) \
        __builtin_amdgcn_global_load_lds((const unsigned*)((const char*)(gbase) + (voff)[_i]), (LAS unsigned*)(lds + (bufoff) + ldsw + _i * 8192), 16, 0, 0); } while (0)
#define PG8_LDA(dst, b, h) do { _Pragma("unroll") for (int m = 0; m < 4; ++m) _Pragma("unroll") for (int k = 0; k < 2; ++k) dst[m][k] = *(const LAS bf16x8*)(lds + PG8_SA(b, h) + aoff + m * 2048 + k * 1024); } while (0)
#define PG8_LDB(dst, b, h) do { _Pragma("unroll") for (int n = 0; n < 2; ++n) _Pragma("unroll") for (int k = 0; k < 2; ++k) dst[n][k] = *(const LAS bf16x8*)(lds + PG8_SB(b, h) + boff + n * 2048 + k * 1024); } while (0)
#define PG8_MMA(ai, bj, At, Bt) do { __builtin_amdgcn_s_setprio(1); _Pragma("unroll") for (int m = 0; m < 4; ++m) _Pragma("unroll") for (int n = 0; n < 2; ++n) _Pragma("unroll") for (int k = 0; k < 2; ++k) \
        acc[ai][bj][m][n] = __builtin_amdgcn_mfma_f32_16x16x32_bf16(Bt[n][k], At[m][k], acc[ai][bj][m][n], 0, 0, 0); __builtin_amdgcn_s_setprio(0); } while (0)
#define PG8_WAIT_V(n) asm volatile("s_waitcnt vmcnt(" #n ")" ::: "memory")
#define PG8_WAIT_L(n) asm volatile("s_waitcnt lgkmcnt(" #n ")" ::: "memory")
#define PG8_BAR __builtin_amdgcn_s_barrier()
#define PG8_SCHED __builtin_amdgcn_sched_barrier(0)
    Unit cur, nxt; int ui = 0;
    if (!S.next(0, cur)) return;
    f32x4 acc[2][2][4][2];
#pragma unroll
    for (int a = 0; a < 2; ++a)
#pragma unroll
        for (int b = 0; b < 2; ++b)
#pragma unroll
            for (int m = 0; m < 4; ++m)
#pragma unroll
                for (int n = 0; n < 2; ++n) acc[a][b][m][n] = (f32x4){0.f, 0.f, 0.f, 0.f};
    bf16x8 At[4][2], B0[2][2], B1[2][2];
    const char* cA = (const char*)gA + (size_t)cur.pm * tstep + (cur.ks > 0 ? cur.ks * ksl : 0); const char* cB = (const char*)gBt + (size_t)cur.pn * tstep + (cur.ks > 0 ? cur.ks * ksl : 0);
    PG8_STAGE(PG8_SB(0, 0), cB, voffB); PG8_STAGE(PG8_SA(0, 0), cA, voffA); PG8_STAGE(PG8_SB(0, 1), cB + hstep, voffB); PG8_STAGE(PG8_SA(0, 1), cA + hstep, voffA);
    if (wr == 1) PG8_BAR;
    PG8_WAIT_V(4); PG8_BAR;
    PG8_STAGE(PG8_SB(1, 0), cB + kstep, voffB); PG8_STAGE(PG8_SA(1, 0), cA + kstep, voffA); PG8_STAGE(PG8_SB(1, 1), cB + hstep + kstep, voffB);
    PG8_WAIT_V(6); PG8_BAR;
    for (;;) {
        const bool has_next = S.next(ui + 1, nxt);
        const char* nA = has_next ? (const char*)gA + (size_t)nxt.pm * tstep + (nxt.ks > 0 ? nxt.ks * ksl : 0) : cA; const char* nB = has_next ? (const char*)gBt + (size_t)nxt.pn * tstep + (nxt.ks > 0 ? nxt.ks * ksl : 0) : cB;
        const int nt = cur.ks >= 0 ? ntf / 4 : ntf;
        for (int t = 0; t < nt; t += 2) {
            const bool last = (t == nt - 2);
            const char* a1 = cA + (size_t)(t + 1) * kstep;
            const char* a2 = last ? nA : cA + (size_t)(t + 2) * kstep; const char* b2 = last ? nB : cB + (size_t)(t + 2) * kstep;
            const char* a3 = a2 + kstep; const char* b3 = b2 + kstep;
            PG8_LDB(B0, 0, 0); PG8_SCHED; PG8_LDA(At, 0, 0); PG8_STAGE(PG8_SA(1, 1), a1 + hstep, voffA);
            PG8_WAIT_L(8); PG8_BAR; PG8_WAIT_L(0); PG8_MMA(0, 0, At, B0); PG8_BAR; PG8_SCHED;
            PG8_LDB(B1, 0, 1); PG8_STAGE(PG8_SB(0, 0), b2, voffB);
            PG8_BAR; PG8_WAIT_L(0); PG8_MMA(0, 1, At, B1); PG8_BAR;
            PG8_LDA(At, 0, 1); PG8_STAGE(PG8_SA(0, 0), a2, voffA);
            PG8_BAR; PG8_WAIT_L(0); PG8_MMA(1, 0, At, B0); PG8_BAR; PG8_SCHED;
            PG8_STAGE(PG8_SB(0, 1), b2 + hstep, voffB);
            PG8_WAIT_V(6); PG8_BAR; PG8_MMA(1, 1, At, B1); PG8_BAR;
            PG8_LDB(B0, 1, 0); PG8_SCHED; PG8_LDA(At, 1, 0); PG8_STAGE(PG8_SA(0, 1), a2 + hstep, voffA);
            PG8_WAIT_L(8); PG8_BAR; PG8_WAIT_L(0); PG8_MMA(0, 0, At, B0); PG8_BAR; PG8_SCHED;
            PG8_LDB(B1, 1, 1); PG8_STAGE(PG8_SB(1, 0), b3, voffB);
            PG8_BAR; PG8_WAIT_L(0); PG8_MMA(0, 1, At, B1); PG8_BAR;
            PG8_LDA(At, 1, 1); PG8_STAGE(PG8_SA(1, 0), a3, voffA);
            PG8_BAR; PG8_WAIT_L(0); PG8_MMA(1, 0, At, B0); PG8_BAR; PG8_SCHED;
            PG8_STAGE(PG8_SB(1, 1), b3 + hstep, voffB);
            PG8_WAIT_V(6); PG8_BAR; PG8_MMA(1, 1, At, B1); PG8_BAR;
        }
        gemm_epilogue(p, epi, Hp, goff, coef, acc, cur, wr, wc, fr, fq);
        if (!has_next) break;
#pragma unroll
        for (int a = 0; a < 2; ++a)
#pragma unroll
            for (int b = 0; b < 2; ++b)
#pragma unroll
                for (int m = 0; m < 4; ++m)
#pragma unroll
                    for (int n = 0; n < 2; ++n) acc[a][b][m][n] = (f32x4){0.f, 0.f, 0.f, 0.f};
        cur = nxt; cA = nA; cB = nB; ++ui;
    }
    PG8_WAIT_V(0);
    if (wr == 0) PG8_BAR;
    PG8_BAR;
#undef PG8_SA
#undef PG8_SB
#undef PG8_STAGE
#undef PG8_LDA
#undef PG8_LDB
#undef PG8_MMA
#undef PG8_WAIT_V
#undef PG8_WAIT_L
#undef PG8_BAR
#undef PG8_SCHED
}

__device__ __forceinline__ void adaln_unit(const Params& p, LAS float* sm, int unit) {
    const int t = threadIdx.x;
    for (int idx = t; idx < 9 * 2048; idx += 512) { const int i = idx >> 11, k = idx & 2047; const float v = (i < 8) ? p.in[1][i * 2048 + k] : p.in[3][k]; sm[k * 9 + i] = siluf_(v); }
    __syncthreads();
    const int col4 = (t & 15) * 4, ksub = t >> 4;
    const float* w = p.in[4] + (size_t)unit * 64 + col4;
    float acc[9][4];
#pragma unroll
    for (int i = 0; i < 9; ++i)
#pragma unroll
        for (int j = 0; j < 4; ++j) acc[i][j] = 0.f;
#pragma unroll 4
    for (int kk = 0; kk < 64; ++kk) {
        const int k = kk * 32 + ksub;
        const f32x4 wv = __builtin_nontemporal_load((const f32x4*)(w + (size_t)k * NMODC));
#pragma unroll
        for (int i = 0; i < 9; ++i) { const float s = sm[k * 9 + i];
#pragma unroll
            for (int j = 0; j < 4; ++j) acc[i][j] += s * wv[j]; }
    }
    __syncthreads();
#pragma unroll
    for (int i = 0; i < 9; ++i)
#pragma unroll
        for (int j = 0; j < 4; ++j) sm[(ksub * 9 + i) * 64 + col4 + j] = acc[i][j];
    __syncthreads();
    float* mod = (float*)(p.ws + WS_MOD);
    for (int o = t; o < 9 * 64; o += 512) { const int i = o >> 6, c = o & 63; float s = 0.f;
        for (int ks = 0; ks < 32; ++ks) s += sm[(ks * 9 + i) * 64 + c];
        mod[(size_t)i * NMODC + unit * 64 + c] = s + p.in[5][unit * 64 + c]; }
    __syncthreads();
}

__device__ __forceinline__ int colmap(int map, int n) {
    if (map == 0) return n;
    if (map == 1) { const int pn = n >> 8, rem = n & 255; return (rem >> 7) * DFF + pn * 128 + (rem & 127); }
    return n < 3072 ? n : (n < 5120 ? n + 16 : (n < 5136 ? n - 2048 : -1));
}

__device__ __forceinline__ void wtile_unit(const Params& p, LAS float* sm, int tile) {
    const float* src; bf16_t* dst; int K, ldw, map, local;
    if (tile < 2816) { src = p.in[7]; dst = (bf16_t*)(p.ws + WS_WF1IN); K = 2048; ldw = 11264; map = 1; local = tile; }
    else if (tile < 4224) { src = p.in[8]; dst = (bf16_t*)(p.ws + WS_WF1OUT); K = 5632; ldw = 2048; map = 0; local = tile - 2816; }
    else if (tile < 5568) { src = p.in[10]; dst = (bf16_t*)(p.ws + WS_WIN); K = 2048; ldw = 5136; map = 2; local = tile - 4224; }
    else if (tile < 6080) { src = p.in[19]; dst = (bf16_t*)(p.ws + WS_WOUT); K = 2048; ldw = 2048; map = 0; local = tile - 5568; }
    else if (tile < 8896) { src = p.in[21]; dst = (bf16_t*)(p.ws + WS_WF2IN); K = 2048; ldw = 11264; map = 1; local = tile - 6080; }
    else { src = p.in[22]; dst = (bf16_t*)(p.ws + WS_WF2OUT); K = 5632; ldw = 2048; map = 0; local = tile - 8896; }
    const int nkt = K >> 7, ntile = local / nkt, kt = local - ntile * nkt;
    const int n0 = ntile * 64, k0 = kt * 128;
    const int t = threadIdx.x;
    {
        const int n4 = (t & 15) * 4, kr = t >> 4;
        const int col = colmap(map, n0 + n4);
#pragma unroll
        for (int i = 0; i < 4; ++i) { const int k = kr + 32 * i;
            f32x4 v = (f32x4){0.f, 0.f, 0.f, 0.f};
            if (col >= 0) v = __builtin_nontemporal_load((const f32x4*)(src + (size_t)(k0 + k) * ldw + col));
#pragma unroll
            for (int j = 0; j < 4; ++j) sm[k * 65 + n4 + j] = v[j]; }
    }
    __syncthreads();
#pragma unroll
    for (int it = 0; it < 2; ++it) {
        const int n = t >> 3, k8 = (t & 7) * 8 + 64 * it;
        float f[8];
#pragma unroll
        for (int j = 0; j < 8; ++j) f[j] = sm[(k8 + j) * 65 + n];
        u32x4 o; o.x = cvt_pk_bf16(f[0], f[1]); o.y = cvt_pk_bf16(f[2], f[3]); o.z = cvt_pk_bf16(f[4], f[5]); o.w = cvt_pk_bf16(f[6], f[7]);
        *(u32x4*)(dst + (size_t)(n0 + n) * K + k0 + k8) = o;
    }
    __syncthreads();
}

__device__ __forceinline__ void norm_phase(const float* lat, const float* ctxp, const bf16_t* dbuf, const bf16_t* dpart, float* xout, int nrows, const float* gw, const float* mod, int shift_off, int scale_off, bf16_t* outb, float* outf) {
    const int wid = threadIdx.x >> 6, lane = threadIdx.x & 63;
    const int nw = gridDim.x * 8, gwv = blockIdx.x * 8 + wid, per = (nrows + nw - 1) / nw;
    const int rb = gwv * per, re = (rb + per < nrows) ? rb + per : nrows;
    if (rb >= re) return;
    int cur_b = -1;
    f32x4 ca[8], cb[8], v[8]; u32x2 dv[8];
    { const float* src = rb < ML ? lat + (size_t)rb * D : ctxp + (size_t)(rb - ML) * D;
#pragma unroll
      for (int i = 0; i < 8; ++i) { v[i] = __builtin_nontemporal_load((const f32x4*)(src + i * 256 + lane * 4)); dv[i] = (u32x2){0u, 0u}; if (dbuf && !dpart) dv[i] = __builtin_nontemporal_load((const u32x2*)(dbuf + (size_t)rb * D + i * 256 + lane * 4)); } }
    for (int row = rb; row < re; ++row) {
        const int b = row < ML ? (row >> 12) : 8;
        if (b != cur_b) {
            cur_b = b;
#pragma unroll
            for (int i = 0; i < 8; ++i) { const int col = i * 256 + lane * 4; ca[i] = *(const f32x4*)(gw + col); cb[i] = (f32x4){0.f, 0.f, 0.f, 0.f};
                if (mod) { const f32x4 sc = *(const f32x4*)(mod + (size_t)b * NMODC + scale_off + col); cb[i] = *(const f32x4*)(mod + (size_t)b * NMODC + shift_off + col); ca[i] = ca[i] * (sc + 1.f); } }
        }
        f32x4 nv[8]; u32x2 nd[8];
        if (row + 1 < re) { const int r1 = row + 1; const float* src = r1 < ML ? lat + (size_t)r1 * D : ctxp + (size_t)(r1 - ML) * D;
#pragma unroll
            for (int i = 0; i < 8; ++i) { nv[i] = __builtin_nontemporal_load((const f32x4*)(src + i * 256 + lane * 4)); nd[i] = (u32x2){0u, 0u}; if (dbuf && !dpart) nd[i] = __builtin_nontemporal_load((const u32x2*)(dbuf + (size_t)r1 * D + i * 256 + lane * 4)); } }
        else {
#pragma unroll
            for (int i = 0; i < 8; ++i) { nv[i] = (f32x4){0.f, 0.f, 0.f, 0.f}; nd[i] = (u32x2){0u, 0u}; } }
        if (dpart && row < ML) {
#pragma unroll
            for (int i = 0; i < 8; ++i) { const u32x2 e = *(const u32x2*)(dbuf + (size_t)row * D + i * 256 + lane * 4);
                v[i][0] += bflo(e.x); v[i][1] += bfhi(e.x); v[i][2] += bflo(e.y); v[i][3] += bfhi(e.y); }
        }
        if (dpart && row >= ML) {
#pragma unroll
            for (int ks = 0; ks < 4; ++ks)
#pragma unroll
                for (int i = 0; i < 8; ++i) { const u32x2 e = *(const u32x2*)(dpart + (size_t)ks * MC * D + (size_t)(row - ML) * D + i * 256 + lane * 4);
                    v[i][0] += bflo(e.x); v[i][1] += bfhi(e.x); v[i][2] += bflo(e.y); v[i][3] += bfhi(e.y); if (i == 7) asm volatile("" ::: "memory"); }
        }
        float ss = 0.f;
#pragma unroll
        for (int i = 0; i < 8; ++i) {
            v[i][0] += bflo(dv[i].x); v[i][1] += bfhi(dv[i].x); v[i][2] += bflo(dv[i].y); v[i][3] += bfhi(dv[i].y);
            ss += v[i][0] * v[i][0] + v[i][1] * v[i][1] + v[i][2] * v[i][2] + v[i][3] * v[i][3]; }
        ss = wave_sum(ss);
        const float rstd = rsqrtf(ss * (1.f / 2048.f) + 1e-6f);
#pragma unroll
        for (int i = 0; i < 8; ++i) {
            const int col = i * 256 + lane * 4;
            if (xout && row < ML) __builtin_nontemporal_store(v[i], (f32x4*)(xout + (size_t)row * D + col));
            const f32x4 y = v[i] * rstd * ca[i] + cb[i];
            if (outb) { u32x2 o; o.x = cvt_pk_bf16(y[0], y[1]); o.y = cvt_pk_bf16(y[2], y[3]); *(u32x2*)(outb + (size_t)row * D + col) = o; }
            else __builtin_nontemporal_store(y, (f32x4*)(outf + (size_t)row * D + col));
        }
#pragma unroll
        for (int i = 0; i < 8; ++i) { v[i] = nv[i]; dv[i] = nd[i]; }
    }
}

__device__ __forceinline__ void conv_unit(const Params& p, int unit) {
    const int t = threadIdx.x, c8 = t & 31, t8 = t >> 5;
    const int ck = unit >> 3, cb = unit & 7;
    const int ch0 = cb * 256 + c8 * 8;
    const int row0 = ck * 128 + t8 * 8;
    const bool lat = ck < 256;
    const bf16_t* ZQK = (const bf16_t*)(p.ws + WS_ZQK);
    const bf16_t* V = (const bf16_t*)(p.ws + WS_V);
    bf16_t* Q = (bf16_t*)(p.ws + WS_Q); bf16_t* Kn = (bf16_t*)(p.ws + WS_K); bf16_t* KT = (bf16_t*)(p.ws + WS_KT); bf16_t* VT = (bf16_t*)(p.ws + WS_VT);
    if (cb < 4) {
        if (!lat && cb < 2) return;
        int seq_lo, seq_hi;
        if (lat) { seq_lo = (ck >> 5) * 4096; seq_hi = seq_lo + 4096; } else { seq_lo = ML + ((ck - 256) >> 1) * 256; seq_hi = seq_lo + 256; }
        u32x4 z[12];
#pragma unroll
        for (int i = 0; i < 12; ++i) { const int r = row0 - 2 + i; z[i] = (u32x4){0u, 0u, 0u, 0u}; if (r >= seq_lo && r < seq_hi) z[i] = *(const u32x4*)(ZQK + (size_t)r * 1024 + ch0); }
        const float* cw = p.in[11]; const float* cbias = p.in[12];
        float y[8][8];
#pragma unroll
        for (int c = 0; c < 8; ++c) {
            const float w0 = cw[0 * 1024 + ch0 + c], w1 = cw[1 * 1024 + ch0 + c], w2 = cw[2 * 1024 + ch0 + c], w3 = cw[3 * 1024 + ch0 + c], w4 = cw[4 * 1024 + ch0 + c], bb = cbias[ch0 + c];
#pragma unroll
            for (int r = 0; r < 8; ++r) {
                float a = bb + bfel(z[r], c) * w0 + bfel(z[r + 1], c) * w1 + bfel(z[r + 2], c) * w2 + bfel(z[r + 3], c) * w3 + bfel(z[r + 4], c) * w4;
                a = siluf_(a);
                y[r][c] = (cb < 2) ? a * 0.08838834764831845f : a;
            }
        }
        if (lat) {
            bf16_t* dn = (cb < 2) ? Q + (size_t)row0 * 512 + ch0 : Kn + (size_t)row0 * 512 + (ch0 - 512);
#pragma unroll
            for (int r = 0; r < 8; ++r) { u32x4 o; o.x = cvt_pk_bf16(y[r][0], y[r][1]); o.y = cvt_pk_bf16(y[r][2], y[r][3]); o.z = cvt_pk_bf16(y[r][4], y[r][5]); o.w = cvt_pk_bf16(y[r][6], y[r][7]);
                *(u32x4*)(dn + (size_t)r * 512) = o; }
        }
        if (cb >= 2) {
            const int kc = ch0 - 512, h = kc >> 7, dk = kc & 127;
            bf16_t* dt = KT + ((size_t)(ck * 4 + h) * 128 + dk) * 128 + t8 * 8;
#pragma unroll
            for (int c = 0; c < 8; ++c) { u32x4 o; o.x = cvt_pk_bf16(y[0][c], y[1][c]); o.y = cvt_pk_bf16(y[2][c], y[3][c]); o.z = cvt_pk_bf16(y[4][c], y[5][c]); o.w = cvt_pk_bf16(y[6][c], y[7][c]);
                *(u32x4*)(dt + (size_t)c * 128) = o; }
        }
    } else {
        const int vch = ch0 - 1024, h = vch >> 8, dv = vch & 255;
        u32x4 z[8];
#pragma unroll
        for (int r = 0; r < 8; ++r) z[r] = *(const u32x4*)(V + (size_t)(row0 + r) * 1024 + vch);
        bf16_t* dt = VT + ((size_t)(ck * 4 + h) * 256 + dv) * 128 + t8 * 8;
#pragma unroll
        for (int c = 0; c < 8; ++c) { u32x4 o;
            o.x = us16(z[0], c) | (us16(z[1], c) << 16); o.y = us16(z[2], c) | (us16(z[3], c) << 16); o.z = us16(z[4], c) | (us16(z[5], c) << 16); o.w = us16(z[6], c) | (us16(z[7], c) << 16);
            *(u32x4*)(dt + (size_t)c * 128) = o; }
    }
}

__device__ __forceinline__ void gmlp_unit(const Params& p, LAS unsigned char* lds, int unit) {
    LAS bf16_t* Wt = (LAS bf16_t*)lds;
    LAS bf16_t* vnT = (LAS bf16_t*)(lds + 34816);
    LAS float* rstd = (LAS float*)(lds + 69632);
    const int t = threadIdx.x, wid = t >> 6, lane = t & 63, fr = lane & 15, fq = lane >> 4;
    const int r0 = unit * 128;
    const bf16_t* U = (const bf16_t*)(p.ws + WS_U); const bf16_t* GV = (const bf16_t*)(p.ws + WS_GV); bf16_t* CAT = (bf16_t*)(p.ws + WS_CAT);
    for (int q = wid; q < 128; q += 8) {
        float ss = 0.f;
#pragma unroll
        for (int i = 0; i < 2; ++i) { const u32x4 v = *(const u32x4*)(GV + (size_t)(r0 + q) * 1024 + i * 512 + lane * 8);
#pragma unroll
            for (int c = 0; c < 8; ++c) { const float f = bfel(v, c); ss += f * f; } }
        ss = wave_sum(ss);
        if (lane == 0) rstd[q] = rsqrtf(ss * (1.f / 1024.f) + 1e-6f);
    }
    __syncthreads();
    for (int g = 0; g < 8; ++g) {
        const float* ws_ = p.in[17] + (size_t)g * 128 * 128;
#pragma unroll
        for (int i = 0; i < 8; ++i) { const int idx = t + 512 * i, pr = idx >> 5, q4 = (idx & 31) * 4; const f32x4 v = *(const f32x4*)(ws_ + pr * 128 + q4);
            u32x2 o; o.x = cvt_pk_bf16(v[0], v[1]); o.y = cvt_pk_bf16(v[2], v[3]); *(LAS u32x2*)(Wt + pr * 136 + q4) = o; }
        const float* gn = p.in[16] + g * 128;
#pragma unroll
        for (int i = 0; i < 4; ++i) { const int d8 = (t & 15) * 8, q = (t >> 4) + 32 * i; const u32x4 v = *(const u32x4*)(GV + (size_t)(r0 + q) * 1024 + g * 128 + d8); const float rs = rstd[q];
#pragma unroll
            for (int c = 0; c < 8; ++c) { const float f = bfel(v, c) * rs * gn[d8 + c]; vnT[(d8 + c) * 136 + q] = (bf16_t)(cvt_pk_bf16(f, 0.f) & 0xffffu); } }
        __syncthreads();
        f32x4 acc[8];
#pragma unroll
        for (int nb = 0; nb < 8; ++nb) acc[nb] = (f32x4){0.f, 0.f, 0.f, 0.f};
#pragma unroll
        for (int kk = 0; kk < 4; ++kk) { const bf16x8 a = *(const LAS bf16x8*)(Wt + (16 * wid + fr) * 136 + kk * 32 + fq * 8);
#pragma unroll
            for (int nb = 0; nb < 8; ++nb) { const bf16x8 bv = *(const LAS bf16x8*)(vnT + (nb * 16 + fr) * 136 + kk * 32 + fq * 8);
                acc[nb] = __builtin_amdgcn_mfma_f32_16x16x32_bf16(bv, a, acc[nb], 0, 0, 0); } }
        const int pp = 16 * wid + fr; const float bs = p.in[18][g * 128 + pp];
#pragma unroll
        for (int nb = 0; nb < 8; ++nb) { const int d = nb * 16 + fq * 4; const u32x2 uu = *(const u32x2*)(U + (size_t)(r0 + pp) * 1024 + g * 128 + d);
            u32x2 o; o.x = cvt_pk_bf16(bflo(uu.x) * (acc[nb][0] + bs), bfhi(uu.x) * (acc[nb][1] + bs)); o.y = cvt_pk_bf16(bflo(uu.y) * (acc[nb][2] + bs), bfhi(uu.y) * (acc[nb][3] + bs));
            *(u32x2*)(CAT + (size_t)(r0 + pp) * 2048 + 1024 + g * 128 + d) = o; }
        __syncthreads();
    }
}

__device__ __forceinline__ int scan_chunk(int s, int dir, int b) { if (s < 2) return 256 + 2 * b + (dir ? 1 - s : s); const int li = s - 2; return 32 * b + (dir ? 31 - li : li); }

__device__ __forceinline__ void scan_issue(const Params& p, int s, int dir, int b, int h, int slice, u32x4 (&kreg)[4], u32x4 (&vreg)[2]) {
    const int t = threadIdx.x;
    const int ck = scan_chunk(s, dir, b);
    const bf16_t* kt = (const bf16_t*)(p.ws + WS_KT) + (size_t)(ck * 4 + h) * 128 * 128;
#pragma unroll
    for (int i = 0; i < 4; ++i) { const int idx = t + 512 * i; kreg[i] = *(const u32x4*)(kt + (idx >> 4) * 128 + (idx & 15) * 8); }
    const bf16_t* vt = (const bf16_t*)(p.ws + WS_VT) + ((size_t)(ck * 4 + h) * 256 + slice * 64) * 128;
#pragma unroll
    for (int i = 0; i < 2; ++i) { const int idx = t + 512 * i; vreg[i] = *(const u32x4*)(vt + (idx >> 4) * 128 + (idx & 15) * 8); }
}

__device__ __forceinline__ void scan_phase(const Params& p, LAS unsigned char* lds) {
    LAS float* wls = (LAS float*)(lds + 113152);
    LAS float* scs = (LAS float*)(lds + 113152 + 17408);
    const int t = threadIdx.x, wid = t >> 6, lane = t & 63, fr = lane & 15, fq = lane >> 4;
    bf16_t* CP = (bf16_t*)(p.ws + WS_XN); float* MP = (float*)(p.ws + WS_MPREV);
    const float* G = (const float*)(p.ws + WS_G);
    for (int u = blockIdx.x; u < 256; u += gridDim.x) {
        const int chain = u >> 2, slice = u & 3, dir = chain & 1, bh = chain >> 1, h = bh & 3, b = bh >> 2;
        u32x4 kreg[4], vreg[2];
        scan_issue(p, 0, dir, b, h, slice, kreg, vreg);
        for (int s = wid; s < 34; s += 8) {
            const int ck = scan_chunk(s, dir, b);
            const int p0 = 2 * lane, t0 = dir ? 127 - p0 : p0, t1 = dir ? 126 - p0 : p0 + 1;
            const float* g = G + (size_t)ck * 128 * 16 + dir * 8 + h;
            const float gi0 = g[t0 * 16], gi1 = g[t1 * 16], gf0 = g[t0 * 16 + 4], gf1 = g[t1 * 16 + 4];
            const float P = wave_scan_sum(gf0 + gf1, lane);
            const float total = __shfl(P, 63);
            const float g0 = total - (P - gf1) + gi0, g1 = total - P + gi1;
            const float mloc = wave_max(fmaxf(g0, g1));
            wls[s * 128 + t0] = g0; wls[s * 128 + t1] = g1;
            if (lane == 0) { scs[s * 4 + 2] = total; scs[s * 4 + 3] = mloc; }
        }
        __syncthreads();
        if (t == 0) {
            float m = 0.f;
            for (int s = 0; s < 34; ++s) { const float total = scs[s * 4 + 2], mloc = scs[s * 4 + 3]; const float m_new = fmaxf(total + m, mloc);
                scs[s * 4 + 0] = __expf(total + m - m_new); scs[s * 4 + 1] = m; scs[s * 4 + 2] = m_new; m = m_new; }
        }
        __syncthreads();
        for (int idx = t; idx < 34 * 128; idx += 512) wls[idx] = __expf(wls[idx] - scs[(idx >> 7) * 4 + 2]);
        __syncthreads();
        f32x4 st[5];
#pragma unroll
        for (int nb = 0; nb < 5; ++nb) st[nb] = (f32x4){0.f, 0.f, 0.f, 0.f};
        for (int s = 0; s < 34; ++s) {
            LAS bf16_t* kT = (LAS bf16_t*)(lds + (s & 1) * 56576);
            LAS bf16_t* wvT = (LAS bf16_t*)(lds + (s & 1) * 56576 + 34816);
            LAS float* wb = wls + s * 128;
#pragma unroll
            for (int i = 0; i < 4; ++i) { const int idx = t + 512 * i; *(LAS u32x4*)(kT + (idx >> 4) * 136 + (idx & 15) * 8) = kreg[i]; }
#pragma unroll
            for (int i = 0; i < 2; ++i) { const int idx = t + 512 * i, r = idx >> 4, c8 = (idx & 15) * 8;
                const f32x4 w0 = *(const LAS f32x4*)(wb + c8), w1 = *(const LAS f32x4*)(wb + c8 + 4);
                u32x4 o; o.x = cvt_pk_bf16(bflo(vreg[i].x) * w0[0], bfhi(vreg[i].x) * w0[1]); o.y = cvt_pk_bf16(bflo(vreg[i].y) * w0[2], bfhi(vreg[i].y) * w0[3]);
                o.z = cvt_pk_bf16(bflo(vreg[i].z) * w1[0], bfhi(vreg[i].z) * w1[1]); o.w = cvt_pk_bf16(bflo(vreg[i].w) * w1[2], bfhi(vreg[i].w) * w1[3]);
                *(LAS u32x4*)(wvT + r * 136 + c8) = o; }
            if (t < 256) { const int r = 64 + (t >> 4), c8 = (t & 15) * 8; u32x4 o = (u32x4){0u, 0u, 0u, 0u};
                if (r == 64) { const f32x4 w0 = *(const LAS f32x4*)(wb + c8), w1 = *(const LAS f32x4*)(wb + c8 + 4);
                    o.x = cvt_pk_bf16(w0[0], w0[1]); o.y = cvt_pk_bf16(w0[2], w0[3]); o.z = cvt_pk_bf16(w1[0], w1[1]); o.w = cvt_pk_bf16(w1[2], w1[3]); }
                *(LAS u32x4*)(wvT + r * 136 + c8) = o; }
            const int ck = scan_chunk(s, dir, b);
            if (s + 1 < 34) scan_issue(p, s + 1, dir, b, h, slice, kreg, vreg);
            __syncthreads();
            const float decay = scs[s * 4];
            if (s >= 2) {
                const int cc = ck - 32 * b;
                bf16_t* cp = CP + (size_t)(chain * 32 + cc) * (272 * 128);
                const int col = 16 * wid + 4 * fq;
#pragma unroll
                for (int nb = 0; nb < 4; ++nb) { u32x2 o; o.x = cvt_pk_bf16(st[nb][0], st[nb][1]); o.y = cvt_pk_bf16(st[nb][2], st[nb][3]); *(u32x2*)(cp + (size_t)(slice * 64 + nb * 16 + fr) * 128 + col) = o; }
                if (slice == 0) { u32x2 o; o.x = cvt_pk_bf16(st[4][0], st[4][1]); o.y = cvt_pk_bf16(st[4][2], st[4][3]); *(u32x2*)(cp + (size_t)(256 + fr) * 128 + col) = o;
                    if (t == 0) MP[chain * 32 + cc] = scs[s * 4 + 1]; }
            }
            f32x4 acc[5];
#pragma unroll
            for (int nb = 0; nb < 5; ++nb) acc[nb] = (f32x4){0.f, 0.f, 0.f, 0.f};
#pragma unroll
            for (int kk = 0; kk < 4; ++kk) { const bf16x8 a = *(const LAS bf16x8*)(kT + (16 * wid + fr) * 136 + kk * 32 + fq * 8);
#pragma unroll
                for (int nb = 0; nb < 5; ++nb) { const bf16x8 bv = *(const LAS bf16x8*)(wvT + (nb * 16 + fr) * 136 + kk * 32 + fq * 8);
                    acc[nb] = __builtin_amdgcn_mfma_f32_16x16x32_bf16(a, bv, acc[nb], 0, 0, 0); } }
#pragma unroll
            for (int nb = 0; nb < 5; ++nb) st[nb] = st[nb] * decay + acc[nb];
        }
        __syncthreads();
    }
}

__device__ __forceinline__ void mout_issue(const Params& p, int u, u32x4 (&kreg)[4], bf16x8 (&qf)[4], float (&gg)[5]) {
    const int t = threadIdx.x, wid = t >> 6, lane = t & 63, fr = lane & 15, fq = lane >> 4;
    const int dir = u & 1, cc = (u >> 1) & 31, bh = u >> 6, h = bh & 3, b = bh >> 2, chain = bh * 2 + dir, ck = 32 * b + cc, r0 = ck * 128;
    const bf16_t* Q = (const bf16_t*)(p.ws + WS_Q); const bf16_t* Kn = (const bf16_t*)(p.ws + WS_K);
#pragma unroll
    for (int i = 0; i < 4; ++i) { const int idx = t + 512 * i, r = idx >> 4, c8 = (idx & 15) * 8; kreg[i] = *(const u32x4*)(Kn + (size_t)(r0 + r) * 512 + h * 128 + c8); }
#pragma unroll
    for (int kk = 0; kk < 4; ++kk) qf[kk] = *(const bf16x8*)(Q + (size_t)(r0 + 16 * wid + fr) * 512 + h * 128 + kk * 32 + fq * 8);
    if (wid == 0) {
        const int p0 = 2 * lane, t0 = dir ? 127 - p0 : p0, t1 = dir ? 126 - p0 : p0 + 1;
        const float* g = (const float*)(p.ws + WS_G) + (size_t)r0 * 16 + dir * 8 + h;
        gg[0] = g[t0 * 16]; gg[1] = g[t1 * 16]; gg[2] = g[t0 * 16 + 4]; gg[3] = g[t1 * 16 + 4];
        gg[4] = ((const float*)(p.ws + WS_MPREV))[chain * 32 + cc];
    }
}

__device__ __forceinline__ void mout_phase(const Params& p, LAS unsigned char* lds) {
    LAS bf16_t* T = (LAS bf16_t*)lds;
    LAS bf16_t* sb = (LAS bf16_t*)(lds + 73984);
    LAS float* fv = (LAS float*)(lds + 73984 + 34816);
    const int t = threadIdx.x, wid = t >> 6, lane = t & 63, fr = lane & 15, fq = lane >> 4;
    const bf16_t* CP = (const bf16_t*)(p.ws + WS_XN);
    const bf16_t* VT = (const bf16_t*)(p.ws + WS_VT);
    u32x4 kreg[4]; bf16x8 qf[4]; float gg[5] = {0.f, 0.f, 0.f, 0.f, 0.f};
    int u = 2 * blockIdx.x;
    if (u < 2048) mout_issue(p, u, kreg, qf, gg);
    for (; u < 2048; u = (u & 1) ? u - 1 + 2 * (int)gridDim.x : u + 1) {
        const int dir = u & 1, cc = (u >> 1) & 31, bh = u >> 6, h = bh & 3, b = bh >> 2, chain = bh * 2 + dir, ck = 32 * b + cc, r0 = ck * 128;
        if (wid == 0) {
            const int p0 = 2 * lane, t0 = dir ? 127 - p0 : p0, t1 = dir ? 126 - p0 : p0 + 1;
            const float gi0 = gg[0], gi1 = gg[1], gf0 = gg[2], gf1 = gg[3], mst = gg[4];
            const float P = wave_scan_sum(gf0 + gf1, lane);
            const float b1 = P, b0 = P - gf1;
            const float c0 = gi0 - b0, c1 = gi1 - b1;
            const float Mi = wave_scan_max(fmaxf(c0, c1), lane);
            float Me = __shfl_up(Mi, 1); if (lane == 0) Me = -INFINITY;
            const float pm0 = fmaxf(Me, c0), pm1 = Mi;
            const float mt0 = fmaxf(b0 + mst, b0 + pm0), mt1 = fmaxf(b1 + mst, b1 + pm1);
            fv[t0] = b0 - mt0; fv[t1] = b1 - mt1;
            fv[128 + t0] = c0; fv[128 + t1] = c1;
            fv[256 + t0] = __expf(b0 + mst - mt0); fv[256 + t1] = __expf(b1 + mst - mt1);
            fv[384 + t0] = __expf(-mt0); fv[384 + t1] = __expf(-mt1);
        }
#pragma unroll
        for (int i = 0; i < 4; ++i) { const int idx = t + 512 * i, r = idx >> 4, c8 = (idx & 15) * 8; *(LAS u32x4*)(T + r * 136 + c8) = kreg[i]; }
        u32x4 creg[9];
        { const bf16_t* cp = CP + (size_t)(chain * 32 + cc) * (272 * 128);
#pragma unroll
          for (int i = 0; i < 9; ++i) { const int idx = t + 512 * i; creg[i] = (u32x4){0u, 0u, 0u, 0u}; if (idx < 272 * 16) creg[i] = *(const u32x4*)(cp + (size_t)(idx >> 4) * 128 + (idx & 15) * 8); } }
        __syncthreads();
        const int j = 16 * wid + fr;
        {
            f32x4 S[8];
#pragma unroll
            for (int nb = 0; nb < 8; ++nb) S[nb] = (f32x4){0.f, 0.f, 0.f, 0.f};
#pragma unroll
            for (int kk = 0; kk < 4; ++kk)
#pragma unroll
                for (int nb = 0; nb < 8; ++nb) { const bf16x8 kf = *(const LAS bf16x8*)(T + (nb * 16 + fr) * 136 + kk * 32 + fq * 8);
                    S[nb] = __builtin_amdgcn_mfma_f32_16x16x32_bf16(kf, qf[kk], S[nb], 0, 0, 0); }
            const float rb = fv[j];
#pragma unroll
            for (int nb = 0; nb < 8; ++nb) { const int l0 = nb * 16 + 4 * fq; const f32x4 cw = *(const LAS f32x4*)(fv + 128 + l0);
                float sv[4];
#pragma unroll
                for (int i = 0; i < 4; ++i) { const int l = l0 + i; const bool valid = dir ? (l >= j) : (l <= j); sv[i] = valid ? S[nb][i] * __expf(rb + cw[i]) : 0.f; }
                u32x2 o; o.x = cvt_pk_bf16(sv[0], sv[1]); o.y = cvt_pk_bf16(sv[2], sv[3]); *(LAS u32x2*)(sb + j * 136 + l0) = o; }
        }
        __syncthreads();
#pragma unroll
        for (int i = 0; i < 9; ++i) { const int idx = t + 512 * i; if (idx < 272 * 16) *(LAS u32x4*)(T + (idx >> 4) * 136 + (idx & 15) * 8) = creg[i]; }
        u32x4 vreg[8];
        { const bf16_t* vt = VT + (size_t)(ck * 4 + h) * 256 * 128;
#pragma unroll
          for (int i = 0; i < 8; ++i) { const int idx = t + 512 * i; vreg[i] = *(const u32x4*)(vt + (size_t)(idx >> 4) * 128 + (idx & 15) * 8); } }
        __syncthreads();
        f32x4 acc[17];
#pragma unroll
        for (int nb = 0; nb < 17; ++nb) acc[nb] = (f32x4){0.f, 0.f, 0.f, 0.f};
#pragma unroll
        for (int kk = 0; kk < 4; ++kk)
#pragma unroll
            for (int nb = 0; nb < 17; ++nb) { const bf16x8 cf = *(const LAS bf16x8*)(T + (nb * 16 + fr) * 136 + kk * 32 + fq * 8);
                acc[nb] = __builtin_amdgcn_mfma_f32_16x16x32_bf16(cf, qf[kk], acc[nb], 0, 0, 0); }
        { const float aj = fv[256 + j];
#pragma unroll
          for (int nb = 0; nb < 17; ++nb) acc[nb] = acc[nb] * aj; }
        __syncthreads();
#pragma unroll
        for (int i = 0; i < 8; ++i) { const int idx = t + 512 * i; *(LAS u32x4*)(T + (idx >> 4) * 136 + (idx & 15) * 8) = vreg[i]; }
        if (t < 256) { const int r = 256 + (t >> 4), c8 = (t & 15) * 8; const unsigned one = (r == 256) ? 0x3F803F80u : 0u; *(LAS u32x4*)(T + r * 136 + c8) = (u32x4){one, one, one, one}; }
        const float einv = fv[384 + j];
        { const int un = (u & 1) ? u - 1 + 2 * (int)gridDim.x : u + 1; if (un < 2048) mout_issue(p, un, kreg, qf, gg); }
        __syncthreads();
#pragma unroll
        for (int kk = 0; kk < 4; ++kk) { const bf16x8 sf = *(const LAS bf16x8*)(sb + j * 136 + kk * 32 + fq * 8);
#pragma unroll
            for (int nb = 0; nb < 17; ++nb) { const bf16x8 vf = *(const LAS bf16x8*)(T + (nb * 16 + fr) * 136 + kk * 32 + fq * 8);
                acc[nb] = __builtin_amdgcn_mfma_f32_16x16x32_bf16(vf, sf, acc[nb], 0, 0, 0); } }
        const float nq = __shfl(acc[16][0], fr);
        const float inv = 1.f / fmaxf(fabsf(nq), einv);
        bf16_t* hd = (bf16_t*)(p.ws + WS_HDIR) + (size_t)(r0 + j) * 1024 + h * 256;
        if (dir == 0) {
#pragma unroll
            for (int nb = 0; nb < 16; ++nb) { u32x2 o; o.x = cvt_pk_bf16(acc[nb][0] * inv, acc[nb][1] * inv); o.y = cvt_pk_bf16(acc[nb][2] * inv, acc[nb][3] * inv); *(u32x2*)(hd + nb * 16 + 4 * fq) = o; }
        } else {
            float ss = 0.f;
#pragma unroll
            for (int nb = 0; nb < 16; ++nb) { const u32x2 hv = *(const u32x2*)(hd + nb * 16 + 4 * fq);
                acc[nb][0] = acc[nb][0] * inv + bflo(hv.x); acc[nb][1] = acc[nb][1] * inv + bfhi(hv.x); acc[nb][2] = acc[nb][2] * inv + bflo(hv.y); acc[nb][3] = acc[nb][3] * inv + bfhi(hv.y);
                ss += acc[nb][0] * acc[nb][0] + acc[nb][1] * acc[nb][1] + acc[nb][2] * acc[nb][2] + acc[nb][3] * acc[nb][3]; }
            ss += __shfl_xor(ss, 16); ss += __shfl_xor(ss, 32);
            const float rstd = rsqrtf(ss * (1.f / 256.f) + 1e-6f);
            const float* ng = p.in[15] + h * 256;
            const bf16_t* og = (const bf16_t*)(p.ws + WS_O) + (size_t)(r0 + j) * 1024 + h * 256;
            bf16_t* cat = (bf16_t*)(p.ws + WS_CAT) + (size_t)(r0 + j) * 2048 + h * 256;
#pragma unroll
            for (int nb = 0; nb < 16; ++nb) { const int dv = nb * 16 + 4 * fq; const f32x4 gn = *(const f32x4*)(ng + dv); const u32x2 ov = *(const u32x2*)(og + dv);
                u32x2 o; o.x = cvt_pk_bf16(acc[nb][0] * rstd * gn[0] * bflo(ov.x), acc[nb][1] * rstd * gn[1] * bfhi(ov.x));
                o.y = cvt_pk_bf16(acc[nb][2] * rstd * gn[2] * bflo(ov.y), acc[nb][3] * rstd * gn[3] * bfhi(ov.y));
                *(u32x2*)(cat + dv) = o;
                if ((nb & 3) == 3) asm volatile("" ::: "memory"); }
        }
        __syncthreads();
    }
}

__device__ __forceinline__ void finish_phase(const Params& p) {
    const int wid = threadIdx.x >> 6, lane = threadIdx.x & 63;
    const bf16_t* HD = (const bf16_t*)(p.ws + WS_HDIR); const bf16_t* O = (const bf16_t*)(p.ws + WS_O); bf16_t* CAT = (bf16_t*)(p.ws + WS_CAT);
    const float* ng = p.in[15];
    for (int row = blockIdx.x * 8 + wid; row < ML; row += gridDim.x * 8) {
        const int e0 = lane * 16;
        float hs[16]; float ss = 0.f;
#pragma unroll
        for (int i = 0; i < 2; ++i) { const u32x4 a = *(const u32x4*)(HD + (size_t)row * 1024 + e0 + i * 8), bq = *(const u32x4*)(HD + (size_t)ML * 1024 + (size_t)row * 1024 + e0 + i * 8);
#pragma unroll
            for (int c = 0; c < 8; ++c) { const float f = bfel(a, c) + bfel(bq, c); hs[i * 8 + c] = f; ss += f * f; } }
        ss += __shfl_xor(ss, 1); ss += __shfl_xor(ss, 2); ss += __shfl_xor(ss, 4); ss += __shfl_xor(ss, 8);
        const float rstd = rsqrtf(ss * (1.f / 256.f) + 1e-6f);
#pragma unroll
        for (int i = 0; i < 2; ++i) { const u32x4 ov = *(const u32x4*)(O + (size_t)row * 1024 + e0 + i * 8);
            float y[8];
#pragma unroll
            for (int c = 0; c < 8; ++c) y[c] = hs[i * 8 + c] * rstd * ng[e0 + i * 8 + c] * bfel(ov, c);
            u32x4 o; o.x = cvt_pk_bf16(y[0], y[1]); o.y = cvt_pk_bf16(y[2], y[3]); o.z = cvt_pk_bf16(y[4], y[5]); o.w = cvt_pk_bf16(y[6], y[7]);
            *(u32x4*)(CAT + (size_t)row * 2048 + e0 + i * 8) = o; }
    }
}

template <int ph> __device__ __forceinline__ void run_phase(const Params& p, LAS unsigned char* lds) {
    unsigned char* ws = p.ws;
    const float* mod = (const float*)(ws + WS_MOD);
    bf16_t* const XN = (bf16_t*)(ws + WS_XN); bf16_t* const Hb = (bf16_t*)(ws + WS_H);
    if (ph == 0) { for (int u = blockIdx.x; u < 288 + 10304; u += gridDim.x) { if (u < 288) adaln_unit(p, (LAS float*)lds, u); else wtile_unit(p, (LAS float*)lds, u - 288); } }
    else if (ph == 1) norm_phase(p.in[0], p.in[2], nullptr, nullptr, nullptr, M1, p.in[6], mod, 0 * D, 1 * D, XN, nullptr);
    else if (ph == 2) gemm_phase(lds, p, XN, (const bf16_t*)(ws + WS_WF1IN), M1, 2 * DFF, D, EPI_SWIGLU, 1, Hb, 0, 0.f);
    else if (ph == 3) gemm_phase(lds, p, Hb, (const bf16_t*)(ws + WS_WF1OUT), M1, D, DFF, EPI_RESID, 1, XN, 2 * D, 0.5f);
    else if (ph == 4) norm_phase(p.in[0], p.in[2], XN, (const bf16_t*)(ws + WS_CAT), p.out, M1, p.in[9], mod, 3 * D, 4 * D, XN, nullptr);
    else if (ph == 5) gemm_phase(lds, p, XN, (const bf16_t*)(ws + WS_WIN), M1, INP, D, EPI_INPROJ, 1, Hb, 0, 0.f);
    else if (ph == 6) { for (int u = blockIdx.x; u < 256 + 2176; u += gridDim.x) { if (u < 256) gmlp_unit(p, lds, u); else conv_unit(p, u - 256); } }
    else if (ph == 7) scan_phase(p, lds);
    else if (ph == 8) mout_phase(p, lds);
    else if (ph == 9) { }
    else if (ph == 10) gemm_phase(lds, p, (const bf16_t*)(ws + WS_CAT), (const bf16_t*)(ws + WS_WOUT), ML, D, D, EPI_RESID, 1, XN, 5 * D, 1.0f);
    else if (ph == 11) norm_phase(p.out, p.out, XN, nullptr, p.out, ML, p.in[20], mod, 6 * D, 7 * D, XN, nullptr);
    else if (ph == 12) gemm_phase(lds, p, XN, (const bf16_t*)(ws + WS_WF2IN), ML, 2 * DFF, D, EPI_SWIGLU, 1, Hb, 0, 0.f);
    else if (ph == 13) gemm_phase(lds, p, Hb, (const bf16_t*)(ws + WS_WF2OUT), ML, D, DFF, EPI_RESID, 1, XN, 8 * D, 0.5f);
    else if (ph == 14) norm_phase(p.out, p.out, XN, nullptr, nullptr, ML, p.in[23], nullptr, 0, 0, nullptr, p.out);
}

#define RUNPH(n) if (p.ph_lo <= n && n < p.ph_hi) { run_phase<n>(p, lds); if (n + 1 < p.ph_hi) xcd_barrier(xb); }
__global__ void __launch_bounds__(512, 2) hymba_megakernel(Params p) {
    extern __shared__ __attribute__((aligned(16))) unsigned char shm[];
    LAS unsigned char* lds = (LAS unsigned char*)shm;
    cg::grid_group grid = cg::this_grid();
    unsigned* barw = (unsigned*)(p.ws + WS_BAR);
    volatile LAS unsigned* stw = (volatile LAS unsigned*)(lds + LDS_BYTES - 16);
    if (blockIdx.x == 0) for (int i = threadIdx.x; i < XCD_BAR_WORDS; i += 512) barw[i] = 0u;
    run_phase<0>(p, lds);
    grid.sync();
    if (threadIdx.x == 0) { stw[0] = 0u; stw[1] = 0u; }
    __syncthreads();
    XcdBarrier xb = xcd_barrier_post(barw, stw);
    RUNPH(1) RUNPH(2) RUNPH(3) RUNPH(4) RUNPH(5) RUNPH(6) RUNPH(7) RUNPH(8) RUNPH(10) RUNPH(11) RUNPH(12) RUNPH(13) RUNPH(14)
}

extern "C" void kernel_launch(void* const* d_in, const int* in_sizes, int n_in, void* d_out, int out_size, void* d_ws, size_t ws_size, hipStream_t stream) {
    static int grid = 0;
    if (grid == 0) {
        if (n_in != 24 || out_size != ML * D || ws_size < WS_END) { fprintf(stderr, "kernel_launch: unexpected shapes (n_in %d out %d ws %zu need %zu)\n", n_in, out_size, ws_size, (size_t)WS_END); grid = -1; return; }
        int dev = 0, cus = 0, per_cu = 0;
        hipGetDevice(&dev);
        hipDeviceGetAttribute(&cus, hipDeviceAttributeMultiprocessorCount, dev);
        if (hipFuncSetAttribute((const void*)hymba_megakernel, hipFuncAttributeMaxDynamicSharedMemorySize, LDS_BYTES) != hipSuccess) { fprintf(stderr, "kernel_launch: hipFuncSetAttribute failed\n"); }
        if (hipOccupancyMaxActiveBlocksPerMultiprocessor(&per_cu, (const void*)hymba_megakernel, 512, LDS_BYTES) != hipSuccess || per_cu < 1) per_cu = 1;
        (void)hipGetLastError();
        grid = cus * per_cu;
        fprintf(stderr, "kernel_launch: cus %d per_cu %d grid %d\n", cus, per_cu, grid);
    }
    if (grid < 0) return;
    Params p{};
    for (int i = 0; i < 24; ++i) p.in[i] = (const float*)d_in[i];
    p.out = (float*)d_out; p.ws = (unsigned char*)d_ws;
#if MK_MULTI
    for (int ph = 0; ph < NPH; ++ph) { p.ph_lo = ph; p.ph_hi = ph + 1; hipLaunchKernelGGL(hymba_megakernel, dim3(grid), dim3(512), LDS_BYTES, stream, p); }
#else
    p.ph_lo = 0; p.ph_hi = NPH;
    void* args[] = {&p};
    hipError_t e = hipLaunchCooperativeKernel((const void*)hymba_megakernel, dim3(grid), dim3(512), args, LDS_BYTES, stream);
    if (e != hipSuccess) fprintf(stderr, "cooperative launch failed: %s (grid %d)\n", hipGetErrorString(e), grid);
#endif
}
```

```cpp
#include <hip/hip_runtime.h>
#include <hip/hip_cooperative_groups.h>
#include <cstdio>
namespace cg = cooperative_groups;

#ifndef MK_MULTI
#define MK_MULTI 0
#endif

#ifndef PHSEL
#define PHSEL 0xffff
#endif
#define PHON(n) ((PHSEL >> (n)) & 1)
#define LAS __attribute__((address_space(3)))
typedef unsigned short bf16_t;
typedef short bf16x8 __attribute__((ext_vector_type(8)));
typedef float f32x4 __attribute__((ext_vector_type(4)));
typedef unsigned u32x4 __attribute__((ext_vector_type(4)));
typedef unsigned u32x2 __attribute__((ext_vector_type(2)));

constexpr int D = 2048, ML = 32768, MC = 2048, M1 = ML + MC, DFF = 5632, NMODC = 9 * 2048, INP = 5376;
constexpr int NPH = 15;
constexpr int LDS_BYTES = 147456;

constexpr size_t al256(size_t x) { return (x + 255) & ~(size_t)255; }
constexpr size_t WS_WF1IN = 0;
constexpr size_t WS_WF1OUT = WS_WF1IN + (size_t)11264 * 2048 * 2;
constexpr size_t WS_WIN = WS_WF1OUT + (size_t)2048 * 5632 * 2;
constexpr size_t WS_WOUT = WS_WIN + (size_t)INP * 2048 * 2;
constexpr size_t WS_WF2IN = WS_WOUT + (size_t)2048 * 2048 * 2;
constexpr size_t WS_WF2OUT = WS_WF2IN + (size_t)11264 * 2048 * 2;
constexpr size_t WS_MOD = WS_WF2OUT + (size_t)2048 * 5632 * 2;
constexpr size_t WS_XN = al256(WS_MOD + (size_t)9 * NMODC * 4);
constexpr size_t WS_MPREV = WS_XN + (size_t)M1 * 2048 * 2;
constexpr size_t WS_H = al256(WS_MPREV + 64 * 32 * 4);
constexpr size_t WS_ZQK = WS_H;
constexpr size_t WS_V = WS_ZQK + (size_t)M1 * 1024 * 2;
constexpr size_t WS_O = WS_V + (size_t)M1 * 1024 * 2;
constexpr size_t WS_U = WS_O + (size_t)ML * 1024 * 2;
constexpr size_t WS_GV = WS_U + (size_t)ML * 1024 * 2;
constexpr size_t WS_HDIR = WS_U;
constexpr size_t WS_G = WS_GV + (size_t)ML * 1024 * 2;
constexpr size_t WS_Q = WS_G + (size_t)M1 * 16 * 4;
constexpr size_t WS_X1C = al256(WS_H + (size_t)M1 * DFF * 2);
constexpr size_t WS_CAT = WS_X1C + (size_t)MC * 2048 * 4;
constexpr size_t WS_K = WS_CAT + (size_t)ML * 2048 * 2;
constexpr size_t WS_KT = WS_K + (size_t)ML * 512 * 2;
constexpr size_t WS_VT = WS_KT + (size_t)272 * 4 * 128 * 128 * 2;
constexpr size_t WS_BAR = WS_VT + (size_t)272 * 4 * 256 * 128 * 2;
constexpr size_t WS_END = WS_BAR + 16384;
static_assert(WS_Q + (size_t)ML * 512 * 2 <= WS_X1C, "in-proj outputs overflow the H region");

struct Params {
    const float* in[24];
    float* out;
    unsigned char* ws;
    int ph_lo, ph_hi;
};

__device__ __forceinline__ unsigned cvt_pk_bf16(float lo, float hi) { unsigned r; asm volatile("v_cvt_pk_bf16_f32 %0, %1, %2" : "=v"(r) : "v"(lo), "v"(hi)); return r; }
__device__ __forceinline__ float bflo(unsigned u) { return __uint_as_float(u << 16); }
__device__ __forceinline__ float bfhi(unsigned u) { return __uint_as_float(u & 0xffff0000u); }
__device__ __forceinline__ float bfel(const u32x4& v, int c) { const unsigned w = (c >> 1) == 0 ? v.x : (c >> 1) == 1 ? v.y : (c >> 1) == 2 ? v.z : v.w; return (c & 1) ? bfhi(w) : bflo(w); }
__device__ __forceinline__ unsigned us16(const u32x4& v, int c) { const unsigned w = (c >> 1) == 0 ? v.x : (c >> 1) == 1 ? v.y : (c >> 1) == 2 ? v.z : v.w; return (c & 1) ? (w >> 16) : (w & 0xffffu); }
__device__ __forceinline__ float wave_sum(float v) {
#pragma unroll
    for (int o = 32; o; o >>= 1) v += __shfl_xor(v, o);
    return v; }
__device__ __forceinline__ float wave_max(float v) {
#pragma unroll
    for (int o = 32; o; o >>= 1) v = fmaxf(v, __shfl_xor(v, o));
    return v; }
__device__ __forceinline__ float wave_scan_sum(float v, int lane) {
#pragma unroll
    for (int o = 1; o < 64; o <<= 1) { const float t = __shfl_up(v, o); if (lane >= o) v += t; }
    return v; }
__device__ __forceinline__ float wave_scan_max(float v, int lane) {
#pragma unroll
    for (int o = 1; o < 64; o <<= 1) { const float t = __shfl_up(v, o); if (lane >= o) v = fmaxf(v, t); }
    return v; }
__device__ __forceinline__ float fexp2_(float x) { return __builtin_amdgcn_exp2f(x); }
__device__ __forceinline__ float sigmoidf_(float x) { return __builtin_amdgcn_rcpf(1.f + fexp2_(-1.4426950408889634f * x)); }
__device__ __forceinline__ float siluf_(float x) { return x * __builtin_amdgcn_rcpf(1.f + fexp2_(-1.4426950408889634f * x)); }
__device__ __forceinline__ float geluf_(float x) { const float y = x * (-2.3022082f + -0.1029432f * x * x); return x * __builtin_amdgcn_rcpf(1.f + fexp2_(y)); }

#define XB_TMO      128
#define XB_XCNT(j)  (256  + 64 * (j))
#define XB_XSUB(j)  (1280 + 64 * (j))
#define XB_XGEN(j)  (2304 + 64 * (j))
#define XB_TOP      3328
#define XB_TOPGEN   3392
#define XCD_BAR_WORDS 3456
#define XB_SPIN_CAP (1u << 22)
__device__ __forceinline__ unsigned xb_ld(unsigned* p)              { return __hip_atomic_load(p, __ATOMIC_RELAXED, __HIP_MEMORY_SCOPE_AGENT); }
__device__ __forceinline__ unsigned xb_add(unsigned* p, unsigned v) { return __hip_atomic_fetch_add(p, v, __ATOMIC_RELAXED, __HIP_MEMORY_SCOPE_AGENT); }
__device__ __forceinline__ unsigned xb_xcc_id() { return (unsigned)__builtin_amdgcn_s_getreg((3 << 11) | 20) & 0xFu; }
#define XB_SPIN(cond, bar) do { unsigned _sp = 0; while (cond) { __builtin_amdgcn_s_sleep(1); \
    if ((++_sp & 255u) == 0u) { if (xb_ld(&(bar)[XB_TMO])) break; if (_sp > XB_SPIN_CAP) { atomicAdd(&(bar)[XB_TMO], 1u); break; } } } } while (0)
struct XcdBarrier { unsigned* bar; unsigned x; volatile LAS unsigned* st; };
__device__ __forceinline__ XcdBarrier xcd_barrier_post(unsigned* bar, volatile LAS unsigned* st) {
    XcdBarrier b; b.bar = bar; b.x = xb_xcc_id(); b.st = st;
    if (threadIdx.x == 0) (void)xb_add(&bar[XB_XCNT(b.x)], 1u);
    return b;
}
__device__ __forceinline__ void xcd_barrier_complete(unsigned* bar, unsigned x, unsigned& nloc, unsigned& nx) {
    const unsigned G = gridDim.x * gridDim.y * gridDim.z;
    unsigned sum, cnt, mine, sp = 0u;
    for (;;) {
        sum = 0u; cnt = 0u; mine = 0u;
#pragma unroll
        for (unsigned j = 0; j < 16; ++j) { const unsigned c = xb_ld(&bar[XB_XCNT(j)]); sum += c; cnt += (c > 0u) ? 1u : 0u; mine = (j == x) ? c : mine; }
        if (sum == G) break;
        __builtin_amdgcn_s_sleep(1);
        if ((++sp & 255u) == 0u) { if (xb_ld(&bar[XB_TMO])) break; if (sp > XB_SPIN_CAP) { atomicAdd(&bar[XB_TMO], 1u); break; } }
    }
    nloc = mine > 0u ? mine : 1u; nx = cnt > 0u ? cnt : 1u;
}
__device__ __forceinline__ void xcd_barrier(const XcdBarrier& b) {
    asm volatile("s_waitcnt vmcnt(0)" ::: "memory");
    __syncthreads();
    if (threadIdx.x == 0) {
        unsigned* bar = b.bar;
        __builtin_amdgcn_s_waitcnt(0);
        unsigned nloc = b.st[0], nx = b.st[1];
        if (nloc == 0u) { xcd_barrier_complete(bar, b.x, nloc, nx); b.st[0] = nloc; b.st[1] = nx; }
        const unsigned old = xb_add(&bar[XB_XSUB(b.x)], 1u);
        const unsigned gen = old / nloc;
        if (old + 1u == (gen + 1u) * nloc) {
            __builtin_amdgcn_fence(__ATOMIC_RELEASE, "agent");
            asm volatile("s_waitcnt vmcnt(0)" ::: "memory");
            const unsigned og = xb_add(&bar[XB_TOP], 1u);
            const unsigned tg = og / nx;
            if (og + 1u == (tg + 1u) * nx) xb_add(&bar[XB_TOPGEN], 1u);
            else XB_SPIN(xb_ld(&bar[XB_TOPGEN]) == tg, bar);
            __builtin_amdgcn_fence(__ATOMIC_ACQUIRE, "agent");
            xb_add(&bar[XB_XGEN(b.x)], 1u);
            asm volatile("s_waitcnt vmcnt(0)" ::: "memory");
        } else {
            XB_SPIN(xb_ld(&bar[XB_XGEN(b.x)]) == gen, bar);
            __builtin_amdgcn_fence(__ATOMIC_ACQUIRE, "agent");
            asm volatile("s_waitcnt vmcnt(0)" ::: "memory");
        }
    }
    __syncthreads();
}

namespace pg8 {
constexpr int BM = 256, BK = 64, HALF = 128, HTB = HALF * BK * 2, NXCD = 8, WGM = 8;
__device__ __forceinline__ int lds_byte(int r, int c) { const int st = (r >> 4) * 2 + (c >> 5), rr = r & 15, cc = c & 31, ob = rr * 64 + cc * 2; return st * 1024 + (ob ^ (((ob >> 9) & 1) << 5)); }
__device__ __forceinline__ void stage_rc(int b, int& R, int& C) { const int st = b / 1024, sb = b % 1024, swz = sb ^ (((sb >> 9) & 1) << 5); R = (st >> 1) * 16 + swz / 64; C = (st & 1) * 32 + (swz % 64) / 2; }
__device__ __forceinline__ int perm32(int rho) { const int n = rho >> 4, i = rho & 15; return 8 * (i >> 2) + 4 * n + (i & 3); }
struct Unit { int pm, pn, ks; };
struct StaticOrder {
    int nM, nN, nwg, G, c;
    __device__ void init(int M, int N, int G_, int c_) { nM = M / BM; nN = N / BM; nwg = nM * nN; G = G_; c = c_; extra = 0; pre = 0; }
    int extra;
    int pre;
    __device__ bool next(int i, Unit& u) const {
        long L = (long)i * G + c; u.ks = -1;
        if (L < pre) { const int t = (int)L & 63; u.ks = (int)L >> 6; u.pm = nM + (t >> 3); u.pn = t & 7; return true; }
        L -= pre;
        if (L >= nwg + extra) return false;
        if (L >= nwg) { const int j = (int)(L - nwg); const int q = j >> 3; u.pm = nM + (j & 7); u.pn = q < 6 ? q + 2 : 20; return true; }
        int wgid = (int)L; { const int q = nwg / NXCD, r = nwg % NXCD, xcd = wgid % NXCD, off = wgid / NXCD; wgid = (xcd < r ? xcd * (q + 1) : r * (q + 1) + (xcd - r) * q) + off; }
        const int wgm = nN <= 8 ? 4 : WGM;
        const int nig = wgm * nN, gid = wgid / nig, fm = gid * wgm, gsz = (nM - fm) < wgm ? (nM - fm) : wgm;
        u.pm = fm + ((wgid % nig) % gsz); u.pn = (wgid % nig) / gsz; return true;
    }
};
}

enum { EPI_SWIGLU = 0, EPI_RESID = 1, EPI_INPROJ = 2 };
__device__ __forceinline__ void gemm_epilogue(const Params& p, const int epi, bf16_t* const Hp, const int goff, const float coef, const f32x4 (&acc)[2][2][4][2], const pg8::Unit& u, int wr, int wc, int fr, int fq) {
    if (epi == EPI_SWIGLU) {
        const int col0 = u.pn * 128 + wc * 32 + fq * 8;
#pragma unroll
        for (int ai = 0; ai < 2; ++ai)
#pragma unroll
            for (int m = 0; m < 4; ++m) {
                const int row = u.pm * 256 + ai * 128 + wr * 64 + m * 16 + fr;
                float h[8];
#pragma unroll
                for (int n = 0; n < 2; ++n)
#pragma unroll
                    for (int i = 0; i < 4; ++i) h[n * 4 + i] = siluf_(acc[ai][0][m][n][i]) * acc[ai][1][m][n][i];
                u32x4 o; o.x = cvt_pk_bf16(h[0], h[1]); o.y = cvt_pk_bf16(h[2], h[3]); o.z = cvt_pk_bf16(h[4], h[5]); o.w = cvt_pk_bf16(h[6], h[7]);
                *(u32x4*)(Hp + (size_t)row * DFF + col0) = o;
            }
    } else if (epi == EPI_RESID) {
        const bool lat = u.pm < 128;
        const int b = lat ? (u.pm >> 4) : 8;
        const float* gate = (const float*)(p.ws + WS_MOD) + (size_t)b * NMODC + goff;
#pragma unroll
        for (int bj = 0; bj < 2; ++bj) {
            const int col = u.pn * 256 + bj * 128 + wc * 32 + fq * 8;
            const f32x4 g0 = *(const f32x4*)(gate + col) * coef, g1 = *(const f32x4*)(gate + col + 4) * coef;
#pragma unroll
            for (int ai = 0; ai < 2; ++ai)
#pragma unroll
                for (int m = 0; m < 4; ++m) {
                    const int row = u.pm * 256 + ai * 128 + wr * 64 + m * 16 + fr;
                    const f32x4 v0 = acc[ai][bj][m][0] * g0, v1 = acc[ai][bj][m][1] * g1;
                    u32x4 o; o.x = cvt_pk_bf16(v0[0], v0[1]); o.y = cvt_pk_bf16(v0[2], v0[3]); o.z = cvt_pk_bf16(v1[0], v1[1]); o.w = cvt_pk_bf16(v1[2], v1[3]);
                    *(u32x4*)((u.ks >= 0 ? (bf16_t*)(p.ws + WS_CAT) + (size_t)u.ks * MC * D + (size_t)(row - ML) * D : Hp + (size_t)row * D) + col) = o;
                }
        }
    } else {
        const int seg = u.pn >> 2;
        const bool lat = u.pm < 128;
        if (seg < 5) {
            if (seg >= 2 && !lat) return;
            bf16_t* dst = (bf16_t*)(p.ws + (seg == 0 ? WS_ZQK : seg == 1 ? WS_V : seg == 2 ? WS_O : seg == 3 ? WS_U : WS_GV));
#pragma unroll
            for (int ai = 0; ai < 2; ++ai)
#pragma unroll
                for (int m = 0; m < 4; ++m) {
                    const int row = u.pm * 256 + ai * 128 + wr * 64 + m * 16 + fr;
#pragma unroll
                    for (int bj = 0; bj < 2; ++bj) {
                        const int cl = (u.pn & 3) * 256 + bj * 128 + wc * 32 + fq * 8;
                        float h[8];
#pragma unroll
                        for (int n = 0; n < 2; ++n)
#pragma unroll
                            for (int i = 0; i < 4; ++i) { const float a = acc[ai][bj][m][n][i]; h[n * 4 + i] = seg < 2 ? a : seg == 2 ? sigmoidf_(a) : geluf_(a); }
                        u32x4 o; o.x = cvt_pk_bf16(h[0], h[1]); o.y = cvt_pk_bf16(h[2], h[3]); o.z = cvt_pk_bf16(h[4], h[5]); o.w = cvt_pk_bf16(h[6], h[7]);
                        *(u32x4*)(dst + (size_t)row * 1024 + cl) = o;
                    }
                }
        } else if (wc == 0 && fq < 2) {
            const f32x4 bi = *(const f32x4*)(p.in[13] + fq * 4), bfv = *(const f32x4*)(p.in[14] + fq * 4);
#pragma unroll
            for (int ai = 0; ai < 2; ++ai)
#pragma unroll
                for (int m = 0; m < 4; ++m) {
                    const int row = u.pm * 256 + ai * 128 + wr * 64 + m * 16 + fr;
                    const f32x4 li = acc[ai][0][m][0] + bi;
                    const f32x4 xf = acc[ai][0][m][1] + bfv;
                    f32x4 lf;
#pragma unroll
                    for (int i = 0; i < 4; ++i) lf[i] = fminf(xf[i], 0.f) - log1pf(expf(-fabsf(xf[i])));
                    *(f32x4*)((float*)(p.ws + WS_G) + (size_t)row * 16 + fq * 8) = li;
                    *(f32x4*)((float*)(p.ws + WS_G) + (size_t)row * 16 + fq * 8 + 4) = lf;
                }
        }
    }
}

__device__ __forceinline__ void gemm_phase(LAS unsigned char* lds, const Params& p, const bf16_t* gA, const bf16_t* gBt, const int gM, const int gN, const int gK, const int epi, const int perm, bf16_t* const Hp, const int goff, const float coef) {
    using namespace pg8;
    const int tid = threadIdx.x, wid = __builtin_amdgcn_readfirstlane(tid >> 6), lane = tid & 63, wr = wid >> 2, wc = wid & 3, fr = lane & 15, fq = lane >> 4;
    const int K = gK, ntf = K / BK;
    const size_t ksl = (size_t)(K / 4) * 2;
    StaticOrder S; S.init(gM, gN, (int)gridDim.x, (int)blockIdx.x);
    if (epi == EPI_INPROJ) { S.init(ML, gN, (int)gridDim.x, (int)blockIdx.x); S.extra = 56; }
    if (epi == EPI_RESID && gM == M1) { S.init(ML, gN, (int)gridDim.x, (int)blockIdx.x); S.pre = 256; }
    unsigned voffA[2], voffB[2];
#pragma unroll
    for (int i = 0; i < 2; ++i) { int R, C; stage_rc(tid * 16 + i * 8192, R, C); const int Rb = perm ? ((R & ~31) + perm32(R & 31)) : R;
        voffA[i] = (unsigned)(R * K + C) * 2u; voffB[i] = (unsigned)(Rb * K + C) * 2u; }
    const size_t kstep = (size_t)(BK * 2);
    const size_t hstep = (size_t)HALF * K * 2;
    const size_t tstep = 2 * hstep;
    const unsigned ldsw = (unsigned)wid * 1024u;
    const int aoff = lds_byte(wr * 64 + fr, fq * 8), boff = lds_byte(wc * 32 + fr, fq * 8);
#define PG8_SA(b, h) (((b) * 2 + (h)) * HTB)
#define PG8_SB(b, h) ((4 + (b) * 2 + (h)) * HTB)
#define PG8_STAGE(bufoff, gbase, voff) do { _Pragma("unroll") for (int _i = 0; _i < 2; ++_i) \
        __builtin_amdgcn_global_load_lds((const unsigned*)((const char*)(gbase) + (voff)[_i]), (LAS unsigned*)(lds + (bufoff) + ldsw + _i * 8192), 16, 0, 0); } while (0)
#define PG8_LDA(dst, b, h) do { _Pragma("unroll") for (int m = 0; m < 4; ++m) _Pragma("unroll") for (int k = 0; k < 2; ++k) dst[m][k] = *(const LAS bf16x8*)(lds + PG8_SA(b, h) + aoff + m * 2048 + k * 1024); } while (0)
#define PG8_LDB(dst, b, h) do { _Pragma("unroll") for (int n = 0; n < 2; ++n) _Pragma("unroll") for (int k = 0; k < 2; ++k) dst[n][k] = *(const LAS bf16x8*)(lds + PG8_SB(b, h) + boff + n * 2048 + k * 1024); } while (0)
#define PG8_MMA(ai, bj, At, Bt) do { __builtin_amdgcn_s_setprio(1); _Pragma("unroll") for (int m = 0; m < 4; ++m) _Pragma("unroll") for (int n = 0; n < 2; ++n) _Pragma("unroll") for (int k = 0; k < 2; ++k) \
        acc[ai][bj][m][n] = __builtin_amdgcn_mfma_f32_16x16x32_bf16(Bt[n][k], At[m][k], acc[ai][bj][m][n], 0, 0, 0); __builtin_amdgcn_s_setprio(0); } while (0)
#define PG8_WAIT_V(n) asm volatile("s_waitcnt vmcnt(" #n ")" ::: "memory")
#define PG8_WAIT_L(n) asm volatile("s_waitcnt lgkmcnt(" #n ")" ::: "memory")
#define PG8_BAR __builtin_amdgcn_s_barrier()
#define PG8_SCHED __builtin_amdgcn_sched_barrier(0)
    Unit cur, nxt; int ui = 0;
    if (!S.next(0, cur)) return;
    f32x4 acc[2][2][4][2];
#pragma unroll
    for (int a = 0; a < 2; ++a)
#pragma unroll
        for (int b = 0; b < 2; ++b)
#pragma unroll
            for (int m = 0; m < 4; ++m)
#pragma unroll
                for (int n = 0; n < 2; ++n) acc[a][b][m][n] = (f32x4){0.f, 0.f, 0.f, 0.f};
    bf16x8 At[4][2], B0[2][2], B1[2][2];
    const char* cA = (const char*)gA + (size_t)cur.pm * tstep + (cur.ks > 0 ? cur.ks * ksl : 0); const char* cB = (const char*)gBt + (size_t)cur.pn * tstep + (cur.ks > 0 ? cur.ks * ksl : 0);
    PG8_STAGE(PG8_SB(0, 0), cB, voffB); PG8_STAGE(PG8_SA(0, 0), cA, voffA); PG8_STAGE(PG8_SB(0, 1), cB + hstep, voffB); PG8_STAGE(PG8_SA(0, 1), cA + hstep, voffA);
    if (wr == 1) PG8_BAR;
    PG8_WAIT_V(4); PG8_BAR;
    PG8_STAGE(PG8_SB(1, 0), cB + kstep, voffB); PG8_STAGE(PG8_SA(1, 0), cA + kstep, voffA); PG8_STAGE(PG8_SB(1, 1), cB + hstep + kstep, voffB);
    PG8_WAIT_V(6); PG8_BAR;
    for (;;) {
        const bool has_next = S.next(ui + 1, nxt);
        const char* nA = has_next ? (const char*)gA + (size_t)nxt.pm * tstep + (nxt.ks > 0 ? nxt.ks * ksl : 0) : cA; const char* nB = has_next ? (const char*)gBt + (size_t)nxt.pn * tstep + (nxt.ks > 0 ? nxt.ks * ksl : 0) : cB;
        const int nt = cur.ks >= 0 ? ntf / 4 : ntf;
        for (int t = 0; t < nt; t += 2) {
            const bool last = (t == nt - 2);
            const char* a1 = cA + (size_t)(t + 1) * kstep;
            const char* a2 = last ? nA : cA + (size_t)(t + 2) * kstep; const char* b2 = last ? nB : cB + (size_t)(t + 2) * kstep;
            const char* a3 = a2 + kstep; const char* b3 = b2 + kstep;
            PG8_LDB(B0, 0, 0); PG8_SCHED; PG8_LDA(At, 0, 0); PG8_STAGE(PG8_SA(1, 1), a1 + hstep, voffA);
            PG8_WAIT_L(8); PG8_BAR; PG8_WAIT_L(0); PG8_MMA(0, 0, At, B0); PG8_BAR; PG8_SCHED;
            PG8_LDB(B1, 0, 1); PG8_STAGE(PG8_SB(0, 0), b2, voffB);
            PG8_BAR; PG8_WAIT_L(0); PG8_MMA(0, 1, At, B1); PG8_BAR;
            PG8_LDA(At, 0, 1); PG8_STAGE(PG8_SA(0, 0), a2, voffA);
            PG8_BAR; PG8_WAIT_L(0); PG8_MMA(1, 0, At, B0); PG8_BAR; PG8_SCHED;
            PG8_STAGE(PG8_SB(0, 1), b2 + hstep, voffB);
            PG8_WAIT_V(6); PG8_BAR; PG8_MMA(1, 1, At, B1); PG8_BAR;
            PG8_LDB(B0, 1, 0); PG8_SCHED; PG8_LDA(At, 1, 0); PG8_STAGE(PG8_SA(0, 1), a2 + hstep, voffA);
            PG8_WAIT_L(8); PG8_BAR; PG8_WAIT_L(0); PG8_MMA(0, 0, At, B0); PG8_BAR; PG8_SCHED;
            PG8_LDB(B1, 1, 1); PG8_STAGE(PG8_SB(1, 0), b3, voffB);
            PG8_BAR; PG8_WAIT_L(0); PG8_MMA(0, 1, At, B1); PG8_BAR;
            PG8_LDA(At, 1, 1); PG8_STAGE(PG8_SA(1, 0), a3, voffA);
            PG8_BAR; PG8_WAIT_L(0); PG8_MMA(1, 0, At, B0); PG8_BAR; PG8_SCHED;
            PG8_STAGE(PG8_SB(1, 1), b3 + hstep, voffB);
            PG8_WAIT_V(6); PG8_BAR; PG8_MMA(1, 1, At, B1); PG8_BAR;
        }
        if (wr == 0) PG8_BAR;
        gemm_epilogue(p, epi, Hp, goff, coef, acc, cur, wr, wc, fr, fq);
        if (!has_next) break;
#pragma unroll
        for (int a = 0; a < 2; ++a)
#pragma unroll
            for (int b = 0; b < 2; ++b)
#pragma unroll
                for (int m = 0; m < 4; ++m)
#pragma unroll
                    for (int n = 0; n < 2; ++n) acc[a][b][m][n] = (f32x4){0.f, 0.f, 0.f, 0.f};
        cur = nxt; cA = nA; cB = nB; ++ui;
        if (wr == 1) PG8_BAR;
    }
    PG8_WAIT_V(0);
    PG8_BAR;
#undef PG8_SA
#undef PG8_SB
#undef PG8_STAGE
#undef PG8_LDA
#undef PG8_LDB
#undef PG8_MMA
#undef PG8_WAIT_V
#undef PG8_WAIT_L
#undef PG8_BAR
#undef PG8_SCHED
}

__device__ __forceinline__ void adaln_unit(const Params& p, LAS float* sm, int unit) {
    const int t = threadIdx.x;
    for (int idx = t; idx < 9 * 2048; idx += 512) { const int i = idx >> 11, k = idx & 2047; const float v = (i < 8) ? p.in[1][i * 2048 + k] : p.in[3][k]; sm[k * 9 + i] = siluf_(v); }
    __syncthreads();
    const int col4 = (t & 15) * 4, ksub = t >> 4;
    const float* w = p.in[4] + (size_t)unit * 64 + col4;
    float acc[9][4];
#pragma unroll
    for (int i = 0; i < 9; ++i)
#pragma unroll
        for (int j = 0; j < 4; ++j) acc[i][j] = 0.f;
#pragma unroll 4
    for (int kk = 0; kk < 64; ++kk) {
        const int k = kk * 32 + ksub;
        const f32x4 wv = *(const f32x4*)(w + (size_t)k * NMODC);
#pragma unroll
        for (int i = 0; i < 9; ++i) { const float s = sm[k * 9 + i];
#pragma unroll
            for (int j = 0; j < 4; ++j) acc[i][j] += s * wv[j]; }
    }
    __syncthreads();
#pragma unroll
    for (int i = 0; i < 9; ++i)
#pragma unroll
        for (int j = 0; j < 4; ++j) sm[(ksub * 9 + i) * 64 + col4 + j] = acc[i][j];
    __syncthreads();
    float* mod = (float*)(p.ws + WS_MOD);
    for (int o = t; o < 9 * 64; o += 512) { const int i = o >> 6, c = o & 63; float s = 0.f;
        for (int ks = 0; ks < 32; ++ks) s += sm[(ks * 9 + i) * 64 + c];
        mod[(size_t)i * NMODC + unit * 64 + c] = s + p.in[5][unit * 64 + c]; }
    __syncthreads();
}

__device__ __forceinline__ int colmap(int map, int n) {
    if (map == 0) return n;
    if (map == 1) { const int pn = n >> 8, rem = n & 255; return (rem >> 7) * DFF + pn * 128 + (rem & 127); }
    return n < 3072 ? n : (n < 5120 ? n + 16 : (n < 5136 ? n - 2048 : -1));
}

__device__ __forceinline__ void wtile_unit(const Params& p, LAS float* sm, int tile) {
    const float* src; bf16_t* dst; int K, ldw, map, local;
    if (tile < 2816) { src = p.in[7]; dst = (bf16_t*)(p.ws + WS_WF1IN); K = 2048; ldw = 11264; map = 1; local = tile; }
    else if (tile < 4224) { src = p.in[8]; dst = (bf16_t*)(p.ws + WS_WF1OUT); K = 5632; ldw = 2048; map = 0; local = tile - 2816; }
    else if (tile < 5568) { src = p.in[10]; dst = (bf16_t*)(p.ws + WS_WIN); K = 2048; ldw = 5136; map = 2; local = tile - 4224; }
    else if (tile < 6080) { src = p.in[19]; dst = (bf16_t*)(p.ws + WS_WOUT); K = 2048; ldw = 2048; map = 0; local = tile - 5568; }
    else if (tile < 8896) { src = p.in[21]; dst = (bf16_t*)(p.ws + WS_WF2IN); K = 2048; ldw = 11264; map = 1; local = tile - 6080; }
    else { src = p.in[22]; dst = (bf16_t*)(p.ws + WS_WF2OUT); K = 5632; ldw = 2048; map = 0; local = tile - 8896; }
    const int nkt = K >> 7, ntile = local / nkt, kt = local - ntile * nkt;
    const int n0 = ntile * 64, k0 = kt * 128;
    const int t = threadIdx.x;
    {
        const int n4 = (t & 15) * 4, kr = t >> 4;
        const int col = colmap(map, n0 + n4);
#pragma unroll
        for (int i = 0; i < 4; ++i) { const int k = kr + 32 * i;
            f32x4 v = (f32x4){0.f, 0.f, 0.f, 0.f};
            if (col >= 0) v = *(const f32x4*)(src + (size_t)(k0 + k) * ldw + col);
#pragma unroll
            for (int j = 0; j < 4; ++j) sm[k * 65 + n4 + j] = v[j]; }
    }
    __syncthreads();
#pragma unroll
    for (int it = 0; it < 2; ++it) {
        const int n = t >> 3, k8 = (t & 7) * 8 + 64 * it;
        float f[8];
#pragma unroll
        for (int j = 0; j < 8; ++j) f[j] = sm[(k8 + j) * 65 + n];
        u32x4 o; o.x = cvt_pk_bf16(f[0], f[1]); o.y = cvt_pk_bf16(f[2], f[3]); o.z = cvt_pk_bf16(f[4], f[5]); o.w = cvt_pk_bf16(f[6], f[7]);
        *(u32x4*)(dst + (size_t)(n0 + n) * K + k0 + k8) = o;
    }
    __syncthreads();
}

__device__ __forceinline__ void norm_phase(const float* lat, const float* ctxp, const bf16_t* dbuf, const bf16_t* dpart, float* xout, int nrows, const float* gw, const float* mod, int shift_off, int scale_off, bf16_t* outb, float* outf) {
    const int wid = threadIdx.x >> 6, lane = threadIdx.x & 63;
    const int nw = gridDim.x * 8, gwv = blockIdx.x * 8 + wid, per = (nrows + nw - 1) / nw;
    const int rb = gwv * per, re = (rb + per < nrows) ? rb + per : nrows;
    if (rb >= re) return;
    int cur_b = -1;
    f32x4 ca[8], cb[8], v[8]; u32x2 dv[8];
    { const float* src = rb < ML ? lat + (size_t)rb * D : ctxp + (size_t)(rb - ML) * D;
#pragma unroll
      for (int i = 0; i < 8; ++i) { v[i] = __builtin_nontemporal_load((const f32x4*)(src + i * 256 + lane * 4)); dv[i] = (u32x2){0u, 0u}; if (dbuf && !dpart) dv[i] = *(const u32x2*)(dbuf + (size_t)rb * D + i * 256 + lane * 4); } }
    for (int row = rb; row < re; ++row) {
        const int b = row < ML ? (row >> 12) : 8;
        if (b != cur_b) {
            cur_b = b;
#pragma unroll
            for (int i = 0; i < 8; ++i) { const int col = i * 256 + lane * 4; ca[i] = *(const f32x4*)(gw + col); cb[i] = (f32x4){0.f, 0.f, 0.f, 0.f};
                if (mod) { const f32x4 sc = *(const f32x4*)(mod + (size_t)b * NMODC + scale_off + col); cb[i] = *(const f32x4*)(mod + (size_t)b * NMODC + shift_off + col); ca[i] = ca[i] * (sc + 1.f); } }
        }
        f32x4 nv[8]; u32x2 nd[8];
        if (row + 1 < re) { const int r1 = row + 1; const float* src = r1 < ML ? lat + (size_t)r1 * D : ctxp + (size_t)(r1 - ML) * D;
#pragma unroll
            for (int i = 0; i < 8; ++i) { nv[i] = __builtin_nontemporal_load((const f32x4*)(src + i * 256 + lane * 4)); nd[i] = (u32x2){0u, 0u}; if (dbuf && !dpart) nd[i] = *(const u32x2*)(dbuf + (size_t)r1 * D + i * 256 + lane * 4); } }
        else {
#pragma unroll
            for (int i = 0; i < 8; ++i) { nv[i] = (f32x4){0.f, 0.f, 0.f, 0.f}; nd[i] = (u32x2){0u, 0u}; } }
        if (dpart && row < ML) {
#pragma unroll
            for (int i = 0; i < 8; ++i) { const u32x2 e = *(const u32x2*)(dbuf + (size_t)row * D + i * 256 + lane * 4);
                v[i][0] += bflo(e.x); v[i][1] += bfhi(e.x); v[i][2] += bflo(e.y); v[i][3] += bfhi(e.y); }
        }
        if (dpart && row >= ML) {
#pragma unroll
            for (int ks = 0; ks < 4; ++ks)
#pragma unroll
                for (int i = 0; i < 8; ++i) { const u32x2 e = *(const u32x2*)(dpart + (size_t)ks * MC * D + (size_t)(row - ML) * D + i * 256 + lane * 4);
                    v[i][0] += bflo(e.x); v[i][1] += bfhi(e.x); v[i][2] += bflo(e.y); v[i][3] += bfhi(e.y); if (i == 7) asm volatile("" ::: "memory"); }
        }
        float ss = 0.f;
#pragma unroll
        for (int i = 0; i < 8; ++i) {
            v[i][0] += bflo(dv[i].x); v[i][1] += bfhi(dv[i].x); v[i][2] += bflo(dv[i].y); v[i][3] += bfhi(dv[i].y);
            ss += v[i][0] * v[i][0] + v[i][1] * v[i][1] + v[i][2] * v[i][2] + v[i][3] * v[i][3]; }
        ss = wave_sum(ss);
        const float rstd = rsqrtf(ss * (1.f / 2048.f) + 1e-6f);
#pragma unroll
        for (int i = 0; i < 8; ++i) {
            const int col = i * 256 + lane * 4;
            if (xout && row < ML) __builtin_nontemporal_store(v[i], (f32x4*)(xout + (size_t)row * D + col));
            const f32x4 y = v[i] * rstd * ca[i] + cb[i];
            if (outb) { u32x2 o; o.x = cvt_pk_bf16(y[0], y[1]); o.y = cvt_pk_bf16(y[2], y[3]); *(u32x2*)(outb + (size_t)row * D + col) = o; }
            else __builtin_nontemporal_store(y, (f32x4*)(outf + (size_t)row * D + col));
        }
#pragma unroll
        for (int i = 0; i < 8; ++i) { v[i] = nv[i]; dv[i] = nd[i]; }
    }
}

__device__ __forceinline__ void conv_unit(const Params& p, int unit) {
    const int t = threadIdx.x, c8 = t & 31, t8 = t >> 5;
    const int ck = unit >> 3, cb = unit & 7;
    const int ch0 = cb * 256 + c8 * 8;
    const int row0 = ck * 128 + t8 * 8;
    const bool lat = ck < 256;
    const bf16_t* ZQK = (const bf16_t*)(p.ws + WS_ZQK);
    const bf16_t* V = (const bf16_t*)(p.ws + WS_V);
    bf16_t* Q = (bf16_t*)(p.ws + WS_Q); bf16_t* Kn = (bf16_t*)(p.ws + WS_K); bf16_t* KT = (bf16_t*)(p.ws + WS_KT); bf16_t* VT = (bf16_t*)(p.ws + WS_VT);
    if (cb < 4) {
        if (!lat && cb < 2) return;
        int seq_lo, seq_hi;
        if (lat) { seq_lo = (ck >> 5) * 4096; seq_hi = seq_lo + 4096; } else { seq_lo = ML + ((ck - 256) >> 1) * 256; seq_hi = seq_lo + 256; }
        u32x4 z[12];
#pragma unroll
        for (int i = 0; i < 12; ++i) { const int r = row0 - 2 + i; z[i] = (u32x4){0u, 0u, 0u, 0u}; if (r >= seq_lo && r < seq_hi) z[i] = *(const u32x4*)(ZQK + (size_t)r * 1024 + ch0); }
        const float* cw = p.in[11]; const float* cbias = p.in[12];
        float y[8][8];
#pragma unroll
        for (int c = 0; c < 8; ++c) {
            const float w0 = cw[0 * 1024 + ch0 + c], w1 = cw[1 * 1024 + ch0 + c], w2 = cw[2 * 1024 + ch0 + c], w3 = cw[3 * 1024 + ch0 + c], w4 = cw[4 * 1024 + ch0 + c], bb = cbias[ch0 + c];
#pragma unroll
            for (int r = 0; r < 8; ++r) {
                float a = bb + bfel(z[r], c) * w0 + bfel(z[r + 1], c) * w1 + bfel(z[r + 2], c) * w2 + bfel(z[r + 3], c) * w3 + bfel(z[r + 4], c) * w4;
                a = siluf_(a);
                y[r][c] = (cb < 2) ? a * 0.08838834764831845f : a;
            }
        }
        if (lat) {
            bf16_t* dn = (cb < 2) ? Q + (size_t)row0 * 512 + ch0 : Kn + (size_t)row0 * 512 + (ch0 - 512);
#pragma unroll
            for (int r = 0; r < 8; ++r) { u32x4 o; o.x = cvt_pk_bf16(y[r][0], y[r][1]); o.y = cvt_pk_bf16(y[r][2], y[r][3]); o.z = cvt_pk_bf16(y[r][4], y[r][5]); o.w = cvt_pk_bf16(y[r][6], y[r][7]);
                *(u32x4*)(dn + (size_t)r * 512) = o; }
        }
        if (cb >= 2) {
            const int kc = ch0 - 512, h = kc >> 7, dk = kc & 127;
            bf16_t* dt = KT + ((size_t)(ck * 4 + h) * 128 + dk) * 128 + t8 * 8;
#pragma unroll
            for (int c = 0; c < 8; ++c) { u32x4 o; o.x = cvt_pk_bf16(y[0][c], y[1][c]); o.y = cvt_pk_bf16(y[2][c], y[3][c]); o.z = cvt_pk_bf16(y[4][c], y[5][c]); o.w = cvt_pk_bf16(y[6][c], y[7][c]);
                *(u32x4*)(dt + (size_t)c * 128) = o; }
        }
    } else {
        const int vch = ch0 - 1024, h = vch >> 8, dv = vch & 255;
        u32x4 z[8];
#pragma unroll
        for (int r = 0; r < 8; ++r) z[r] = *(const u32x4*)(V + (size_t)(row0 + r) * 1024 + vch);
        bf16_t* dt = VT + ((size_t)(ck * 4 + h) * 256 + dv) * 128 + t8 * 8;
#pragma unroll
        for (int c = 0; c < 8; ++c) { u32x4 o;
            o.x = us16(z[0], c) | (us16(z[1], c) << 16); o.y = us16(z[2], c) | (us16(z[3], c) << 16); o.z = us16(z[4], c) | (us16(z[5], c) << 16); o.w = us16(z[6], c) | (us16(z[7], c) << 16);
            *(u32x4*)(dt + (size_t)c * 128) = o; }
    }
}

__device__ __forceinline__ void gmlp_unit(const Params& p, LAS unsigned char* lds, int unit) {
    LAS bf16_t* Wt = (LAS bf16_t*)lds;
    LAS bf16_t* vnT = (LAS bf16_t*)(lds + 34816);
    LAS float* rstd = (LAS float*)(lds + 69632);
    const int t = threadIdx.x, wid = t >> 6, lane = t & 63, fr = lane & 15, fq = lane >> 4;
    const int r0 = unit * 128;
    const bf16_t* U = (const bf16_t*)(p.ws + WS_U); const bf16_t* GV = (const bf16_t*)(p.ws + WS_GV); bf16_t* CAT = (bf16_t*)(p.ws + WS_CAT);
    for (int q = wid; q < 128; q += 8) {
        float ss = 0.f;
#pragma unroll
        for (int i = 0; i < 2; ++i) { const u32x4 v = *(const u32x4*)(GV + (size_t)(r0 + q) * 1024 + i * 512 + lane * 8);
#pragma unroll
            for (int c = 0; c < 8; ++c) { const float f = bfel(v, c); ss += f * f; } }
        ss = wave_sum(ss);
        if (lane == 0) rstd[q] = rsqrtf(ss * (1.f / 1024.f) + 1e-6f);
    }
    __syncthreads();
    for (int g = 0; g < 8; ++g) {
        const float* ws_ = p.in[17] + (size_t)g * 128 * 128;
#pragma unroll
        for (int i = 0; i < 8; ++i) { const int idx = t + 512 * i, pr = idx >> 5, q4 = (idx & 31) * 4; const f32x4 v = *(const f32x4*)(ws_ + pr * 128 + q4);
            u32x2 o; o.x = cvt_pk_bf16(v[0], v[1]); o.y = cvt_pk_bf16(v[2], v[3]); *(LAS u32x2*)(Wt + pr * 136 + q4) = o; }
        const float* gn = p.in[16] + g * 128;
#pragma unroll
        for (int i = 0; i < 4; ++i) { const int d8 = (t & 15) * 8, q = (t >> 4) + 32 * i; const u32x4 v = *(const u32x4*)(GV + (size_t)(r0 + q) * 1024 + g * 128 + d8); const float rs = rstd[q];
#pragma unroll
            for (int c = 0; c < 8; ++c) { const float f = bfel(v, c) * rs * gn[d8 + c]; vnT[(d8 + c) * 136 + q] = (bf16_t)(cvt_pk_bf16(f, 0.f) & 0xffffu); } }
        __syncthreads();
        f32x4 acc[8];
#pragma unroll
        for (int nb = 0; nb < 8; ++nb) acc[nb] = (f32x4){0.f, 0.f, 0.f, 0.f};
#pragma unroll
        for (int kk = 0; kk < 4; ++kk) { const bf16x8 a = *(const LAS bf16x8*)(Wt + (16 * wid + fr) * 136 + kk * 32 + fq * 8);
#pragma unroll
            for (int nb = 0; nb < 8; ++nb) { const bf16x8 bv = *(const LAS bf16x8*)(vnT + (nb * 16 + fr) * 136 + kk * 32 + fq * 8);
                acc[nb] = __builtin_amdgcn_mfma_f32_16x16x32_bf16(bv, a, acc[nb], 0, 0, 0); } }
        const int pp = 16 * wid + fr; const float bs = p.in[18][g * 128 + pp];
#pragma unroll
        for (int nb = 0; nb < 8; ++nb) { const int d = nb * 16 + fq * 4; const u32x2 uu = *(const u32x2*)(U + (size_t)(r0 + pp) * 1024 + g * 128 + d);
            u32x2 o; o.x = cvt_pk_bf16(bflo(uu.x) * (acc[nb][0] + bs), bfhi(uu.x) * (acc[nb][1] + bs)); o.y = cvt_pk_bf16(bflo(uu.y) * (acc[nb][2] + bs), bfhi(uu.y) * (acc[nb][3] + bs));
            *(u32x2*)(CAT + (size_t)(r0 + pp) * 2048 + 1024 + g * 128 + d) = o; }
        __syncthreads();
    }
}

__device__ __forceinline__ int scan_chunk(int s, int dir, int b) { if (s < 2) return 256 + 2 * b + (dir ? 1 - s : s); const int li = s - 2; return 32 * b + (dir ? 31 - li : li); }

__device__ __forceinline__ void scan_issue(const Params& p, int s, int dir, int b, int h, int slice, u32x4 (&kreg)[4], u32x4 (&vreg)[2]) {
    const int t = threadIdx.x;
    const int ck = scan_chunk(s, dir, b);
    const bf16_t* kt = (const bf16_t*)(p.ws + WS_KT) + (size_t)(ck * 4 + h) * 128 * 128;
#pragma unroll
    for (int i = 0; i < 4; ++i) { const int idx = t + 512 * i; kreg[i] = *(const u32x4*)(kt + (idx >> 4) * 128 + (idx & 15) * 8); }
    const bf16_t* vt = (const bf16_t*)(p.ws + WS_VT) + ((size_t)(ck * 4 + h) * 256 + slice * 64) * 128;
#pragma unroll
    for (int i = 0; i < 2; ++i) { const int idx = t + 512 * i; vreg[i] = *(const u32x4*)(vt + (idx >> 4) * 128 + (idx & 15) * 8); }
}

__device__ __forceinline__ void scan_phase(const Params& p, LAS unsigned char* lds) {
    LAS float* wls = (LAS float*)(lds + 113152);
    LAS float* scs = (LAS float*)(lds + 113152 + 17408);
    const int t = threadIdx.x, wid = t >> 6, lane = t & 63, fr = lane & 15, fq = lane >> 4;
    bf16_t* CP = (bf16_t*)(p.ws + WS_XN); float* MP = (float*)(p.ws + WS_MPREV);
    const float* G = (const float*)(p.ws + WS_G);
    for (int u = blockIdx.x; u < 256; u += gridDim.x) {
        const int chain = u >> 2, slice = u & 3, dir = chain & 1, bh = chain >> 1, h = bh & 3, b = bh >> 2;
        u32x4 kreg[4], vreg[2];
        scan_issue(p, 0, dir, b, h, slice, kreg, vreg);
        for (int s = wid; s < 34; s += 8) {
            const int ck = scan_chunk(s, dir, b);
            const int p0 = 2 * lane, t0 = dir ? 127 - p0 : p0, t1 = dir ? 126 - p0 : p0 + 1;
            const float* g = G + (size_t)ck * 128 * 16 + dir * 8 + h;
            const float gi0 = g[t0 * 16], gi1 = g[t1 * 16], gf0 = g[t0 * 16 + 4], gf1 = g[t1 * 16 + 4];
            const float P = wave_scan_sum(gf0 + gf1, lane);
            const float total = __shfl(P, 63);
            const float g0 = total - (P - gf1) + gi0, g1 = total - P + gi1;
            const float mloc = wave_max(fmaxf(g0, g1));
            wls[s * 128 + t0] = g0; wls[s * 128 + t1] = g1;
            if (lane == 0) { scs[s * 4 + 2] = total; scs[s * 4 + 3] = mloc; }
        }
        __syncthreads();
        if (t == 0) {
            float m = 0.f;
            for (int s = 0; s < 34; ++s) { const float total = scs[s * 4 + 2], mloc = scs[s * 4 + 3]; const float m_new = fmaxf(total + m, mloc);
                scs[s * 4 + 0] = __expf(total + m - m_new); scs[s * 4 + 1] = m; scs[s * 4 + 2] = m_new; m = m_new; }
        }
        __syncthreads();
        for (int idx = t; idx < 34 * 128; idx += 512) wls[idx] = __expf(wls[idx] - scs[(idx >> 7) * 4 + 2]);
        __syncthreads();
        f32x4 st[5];
#pragma unroll
        for (int nb = 0; nb < 5; ++nb) st[nb] = (f32x4){0.f, 0.f, 0.f, 0.f};
        for (int s = 0; s < 34; ++s) {
            LAS bf16_t* kT = (LAS bf16_t*)(lds + (s & 1) * 56576);
            LAS bf16_t* wvT = (LAS bf16_t*)(lds + (s & 1) * 56576 + 34816);
            LAS float* wb = wls + s * 128;
#pragma unroll
            for (int i = 0; i < 4; ++i) { const int idx = t + 512 * i; *(LAS u32x4*)(kT + (idx >> 4) * 136 + (idx & 15) * 8) = kreg[i]; }
#pragma unroll
            for (int i = 0; i < 2; ++i) { const int idx = t + 512 * i, r = idx >> 4, c8 = (idx & 15) * 8;
                const f32x4 w0 = *(const LAS f32x4*)(wb + c8), w1 = *(const LAS f32x4*)(wb + c8 + 4);
                u32x4 o; o.x = cvt_pk_bf16(bflo(vreg[i].x) * w0[0], bfhi(vreg[i].x) * w0[1]); o.y = cvt_pk_bf16(bflo(vreg[i].y) * w0[2], bfhi(vreg[i].y) * w0[3]);
                o.z = cvt_pk_bf16(bflo(vreg[i].z) * w1[0], bfhi(vreg[i].z) * w1[1]); o.w = cvt_pk_bf16(bflo(vreg[i].w) * w1[2], bfhi(vreg[i].w) * w1[3]);
                *(LAS u32x4*)(wvT + r * 136 + c8) = o; }
            if (t < 256) { const int r = 64 + (t >> 4), c8 = (t & 15) * 8; u32x4 o = (u32x4){0u, 0u, 0u, 0u};
                if (r == 64) { const f32x4 w0 = *(const LAS f32x4*)(wb + c8), w1 = *(const LAS f32x4*)(wb + c8 + 4);
                    o.x = cvt_pk_bf16(w0[0], w0[1]); o.y = cvt_pk_bf16(w0[2], w0[3]); o.z = cvt_pk_bf16(w1[0], w1[1]); o.w = cvt_pk_bf16(w1[2], w1[3]); }
                *(LAS u32x4*)(wvT + r * 136 + c8) = o; }
            const int ck = scan_chunk(s, dir, b);
            if (s + 1 < 34) scan_issue(p, s + 1, dir, b, h, slice, kreg, vreg);
            __syncthreads();
            const float decay = scs[s * 4];
            if (s >= 2) {
                const int cc = ck - 32 * b;
                bf16_t* cp = CP + (size_t)(chain * 32 + cc) * (272 * 128);
                const int col = 16 * wid + 4 * fq;
#pragma unroll
                for (int nb = 0; nb < 4; ++nb) { u32x2 o; o.x = cvt_pk_bf16(st[nb][0], st[nb][1]); o.y = cvt_pk_bf16(st[nb][2], st[nb][3]); *(u32x2*)(cp + (size_t)(slice * 64 + nb * 16 + fr) * 128 + col) = o; }
                if (slice == 0) { u32x2 o; o.x = cvt_pk_bf16(st[4][0], st[4][1]); o.y = cvt_pk_bf16(st[4][2], st[4][3]); *(u32x2*)(cp + (size_t)(256 + fr) * 128 + col) = o;
                    if (t == 0) MP[chain * 32 + cc] = scs[s * 4 + 1]; }
            }
            f32x4 acc[5];
#pragma unroll
            for (int nb = 0; nb < 5; ++nb) acc[nb] = (f32x4){0.f, 0.f, 0.f, 0.f};
#pragma unroll
            for (int kk = 0; kk < 4; ++kk) { const bf16x8 a = *(const LAS bf16x8*)(kT + (16 * wid + fr) * 136 + kk * 32 + fq * 8);
#pragma unroll
                for (int nb = 0; nb < 5; ++nb) { const bf16x8 bv = *(const LAS bf16x8*)(wvT + (nb * 16 + fr) * 136 + kk * 32 + fq * 8);
                    acc[nb] = __builtin_amdgcn_mfma_f32_16x16x32_bf16(a, bv, acc[nb], 0, 0, 0); } }
#pragma unroll
            for (int nb = 0; nb < 5; ++nb) st[nb] = st[nb] * decay + acc[nb];
        }
        __syncthreads();
    }
}

__device__ __forceinline__ void mout_issue(const Params& p, int u, u32x4 (&kreg)[4], bf16x8 (&qf)[4], float (&gg)[5]) {
    const int t = threadIdx.x, wid = t >> 6, lane = t & 63, fr = lane & 15, fq = lane >> 4;
    const int dir = u & 1, cc = (u >> 1) & 31, bh = u >> 6, h = bh & 3, b = bh >> 2, chain = bh * 2 + dir, ck = 32 * b + cc, r0 = ck * 128;
    const bf16_t* Q = (const bf16_t*)(p.ws + WS_Q); const bf16_t* Kn = (const bf16_t*)(p.ws + WS_K);
#pragma unroll
    for (int i = 0; i < 4; ++i) { const int idx = t + 512 * i, r = idx >> 4, c8 = (idx & 15) * 8; kreg[i] = *(const u32x4*)(Kn + (size_t)(r0 + r) * 512 + h * 128 + c8); }
#pragma unroll
    for (int kk = 0; kk < 4; ++kk) qf[kk] = *(const bf16x8*)(Q + (size_t)(r0 + 16 * wid + fr) * 512 + h * 128 + kk * 32 + fq * 8);
    if (wid == 0) {
        const int p0 = 2 * lane, t0 = dir ? 127 - p0 : p0, t1 = dir ? 126 - p0 : p0 + 1;
        const float* g = (const float*)(p.ws + WS_G) + (size_t)r0 * 16 + dir * 8 + h;
        gg[0] = g[t0 * 16]; gg[1] = g[t1 * 16]; gg[2] = g[t0 * 16 + 4]; gg[3] = g[t1 * 16 + 4];
        gg[4] = ((const float*)(p.ws + WS_MPREV))[chain * 32 + cc];
    }
}

__device__ __forceinline__ void mout_phase(const Params& p, LAS unsigned char* lds) {
    LAS bf16_t* T = (LAS bf16_t*)lds;
    LAS bf16_t* sb = (LAS bf16_t*)(lds + 73984);
    LAS float* fv = (LAS float*)(lds + 73984 + 34816);
    const int t = threadIdx.x, wid = t >> 6, lane = t & 63, fr = lane & 15, fq = lane >> 4;
    const bf16_t* CP = (const bf16_t*)(p.ws + WS_XN);
    const bf16_t* VT = (const bf16_t*)(p.ws + WS_VT);
    u32x4 kreg[4]; bf16x8 qf[4]; float gg[5] = {0.f, 0.f, 0.f, 0.f, 0.f};
    int u = 2 * blockIdx.x;
    if (u < 2048) mout_issue(p, u, kreg, qf, gg);
    for (; u < 2048; u = (u & 1) ? u - 1 + 2 * (int)gridDim.x : u + 1) {
        const int dir = u & 1, cc = (u >> 1) & 31, bh = u >> 6, h = bh & 3, b = bh >> 2, chain = bh * 2 + dir, ck = 32 * b + cc, r0 = ck * 128;
        if (wid == 0) {
            const int p0 = 2 * lane, t0 = dir ? 127 - p0 : p0, t1 = dir ? 126 - p0 : p0 + 1;
            const float gi0 = gg[0], gi1 = gg[1], gf0 = gg[2], gf1 = gg[3], mst = gg[4];
            const float P = wave_scan_sum(gf0 + gf1, lane);
            const float b1 = P, b0 = P - gf1;
            const float c0 = gi0 - b0, c1 = gi1 - b1;
            const float Mi = wave_scan_max(fmaxf(c0, c1), lane);
            float Me = __shfl_up(Mi, 1); if (lane == 0) Me = -INFINITY;
            const float pm0 = fmaxf(Me, c0), pm1 = Mi;
            const float mt0 = fmaxf(b0 + mst, b0 + pm0), mt1 = fmaxf(b1 + mst, b1 + pm1);
            fv[t0] = b0 - mt0; fv[t1] = b1 - mt1;
            fv[128 + t0] = c0; fv[128 + t1] = c1;
            fv[256 + t0] = __expf(b0 + mst - mt0); fv[256 + t1] = __expf(b1 + mst - mt1);
            fv[384 + t0] = __expf(-mt0); fv[384 + t1] = __expf(-mt1);
        }
#pragma unroll
        for (int i = 0; i < 4; ++i) { const int idx = t + 512 * i, r = idx >> 4, c8 = (idx & 15) * 8; *(LAS u32x4*)(T + r * 136 + c8) = kreg[i]; }
        u32x4 creg[9];
        { const bf16_t* cp = CP + (size_t)(chain * 32 + cc) * (272 * 128);
#pragma unroll
          for (int i = 0; i < 9; ++i) { const int idx = t + 512 * i; creg[i] = (u32x4){0u, 0u, 0u, 0u}; if (idx < 272 * 16) creg[i] = *(const u32x4*)(cp + (size_t)(idx >> 4) * 128 + (idx & 15) * 8); } }
        __syncthreads();
        const int j = 16 * wid + fr;
        {
            f32x4 S[8];
#pragma unroll
            for (int nb = 0; nb < 8; ++nb) S[nb] = (f32x4){0.f, 0.f, 0.f, 0.f};
#pragma unroll
            for (int kk = 0; kk < 4; ++kk)
#pragma unroll
                for (int nb = 0; nb < 8; ++nb) { const bf16x8 kf = *(const LAS bf16x8*)(T + (nb * 16 + fr) * 136 + kk * 32 + fq * 8);
                    S[nb] = __builtin_amdgcn_mfma_f32_16x16x32_bf16(kf, qf[kk], S[nb], 0, 0, 0); }
            const float rb = fv[j];
#pragma unroll
            for (int nb = 0; nb < 8; ++nb) { const int l0 = nb * 16 + 4 * fq; const f32x4 cw = *(const LAS f32x4*)(fv + 128 + l0);
                float sv[4];
#pragma unroll
                for (int i = 0; i < 4; ++i) { const int l = l0 + i; const bool valid = dir ? (l >= j) : (l <= j); sv[i] = valid ? S[nb][i] * __expf(rb + cw[i]) : 0.f; }
                u32x2 o; o.x = cvt_pk_bf16(sv[0], sv[1]); o.y = cvt_pk_bf16(sv[2], sv[3]); *(LAS u32x2*)(sb + j * 136 + l0) = o; }
        }
        __syncthreads();
#pragma unroll
        for (int i = 0; i < 9; ++i) { const int idx = t + 512 * i; if (idx < 272 * 16) *(LAS u32x4*)(T + (idx >> 4) * 136 + (idx & 15) * 8) = creg[i]; }
        u32x4 vreg[8];
        { const bf16_t* vt = VT + (size_t)(ck * 4 + h) * 256 * 128;
#pragma unroll
          for (int i = 0; i < 8; ++i) { const int idx = t + 512 * i; vreg[i] = *(const u32x4*)(vt + (size_t)(idx >> 4) * 128 + (idx & 15) * 8); } }
        __syncthreads();
        f32x4 acc[17];
#pragma unroll
        for (int nb = 0; nb < 17; ++nb) acc[nb] = (f32x4){0.f, 0.f, 0.f, 0.f};
#pragma unroll
        for (int kk = 0; kk < 4; ++kk)
#pragma unroll
            for (int nb = 0; nb < 17; ++nb) { const bf16x8 cf = *(const LAS bf16x8*)(T + (nb * 16 + fr) * 136 + kk * 32 + fq * 8);
                acc[nb] = __builtin_amdgcn_mfma_f32_16x16x32_bf16(cf, qf[kk], acc[nb], 0, 0, 0); }
        { const float aj = fv[256 + j];
#pragma unroll
          for (int nb = 0; nb < 17; ++nb) acc[nb] = acc[nb] * aj; }
        __syncthreads();
#pragma unroll
        for (int i = 0; i < 8; ++i) { const int idx = t + 512 * i; *(LAS u32x4*)(T + (idx >> 4) * 136 + (idx & 15) * 8) = vreg[i]; }
        if (t < 256) { const int r = 256 + (t >> 4), c8 = (t & 15) * 8; const unsigned one = (r == 256) ? 0x3F803F80u : 0u; *(LAS u32x4*)(T + r * 136 + c8) = (u32x4){one, one, one, one}; }
        const float einv = fv[384 + j];
        { const int un = (u & 1) ? u - 1 + 2 * (int)gridDim.x : u + 1; if (un < 2048) mout_issue(p, un, kreg, qf, gg); }
        __syncthreads();
#pragma unroll
        for (int kk = 0; kk < 4; ++kk) { const bf16x8 sf = *(const LAS bf16x8*)(sb + j * 136 + kk * 32 + fq * 8);
#pragma unroll
            for (int nb = 0; nb < 17; ++nb) { const bf16x8 vf = *(const LAS bf16x8*)(T + (nb * 16 + fr) * 136 + kk * 32 + fq * 8);
                acc[nb] = __builtin_amdgcn_mfma_f32_16x16x32_bf16(vf, sf, acc[nb], 0, 0, 0); } }
        const float nq = __shfl(acc[16][0], fr);
        const float inv = 1.f / fmaxf(fabsf(nq), einv);
        bf16_t* hd = (bf16_t*)(p.ws + WS_HDIR) + (size_t)(r0 + j) * 1024 + h * 256;
        if (dir == 0) {
#pragma unroll
            for (int nb = 0; nb < 16; ++nb) { u32x2 o; o.x = cvt_pk_bf16(acc[nb][0] * inv, acc[nb][1] * inv); o.y = cvt_pk_bf16(acc[nb][2] * inv, acc[nb][3] * inv); *(u32x2*)(hd + nb * 16 + 4 * fq) = o; }
        } else {
            float ss = 0.f;
#pragma unroll
            for (int nb = 0; nb < 16; ++nb) { const u32x2 hv = *(const u32x2*)(hd + nb * 16 + 4 * fq);
                acc[nb][0] = acc[nb][0] * inv + bflo(hv.x); acc[nb][1] = acc[nb][1] * inv + bfhi(hv.x); acc[nb][2] = acc[nb][2] * inv + bflo(hv.y); acc[nb][3] = acc[nb][3] * inv + bfhi(hv.y);
                ss += acc[nb][0] * acc[nb][0] + acc[nb][1] * acc[nb][1] + acc[nb][2] * acc[nb][2] + acc[nb][3] * acc[nb][3]; }
            ss += __shfl_xor(ss, 16); ss += __shfl_xor(ss, 32);
            const float rstd = rsqrtf(ss * (1.f / 256.f) + 1e-6f);
            const float* ng = p.in[15] + h * 256;
            const bf16_t* og = (const bf16_t*)(p.ws + WS_O) + (size_t)(r0 + j) * 1024 + h * 256;
            bf16_t* cat = (bf16_t*)(p.ws + WS_CAT) + (size_t)(r0 + j) * 2048 + h * 256;
#pragma unroll
            for (int nb = 0; nb < 16; ++nb) { const int dv = nb * 16 + 4 * fq; const f32x4 gn = *(const f32x4*)(ng + dv); const u32x2 ov = *(const u32x2*)(og + dv);
                u32x2 o; o.x = cvt_pk_bf16(acc[nb][0] * rstd * gn[0] * bflo(ov.x), acc[nb][1] * rstd * gn[1] * bfhi(ov.x));
                o.y = cvt_pk_bf16(acc[nb][2] * rstd * gn[2] * bflo(ov.y), acc[nb][3] * rstd * gn[3] * bfhi(ov.y));
                *(u32x2*)(cat + dv) = o;
                if ((nb & 3) == 3) asm volatile("" ::: "memory"); }
        }
        __syncthreads();
    }
}

__device__ __forceinline__ void finish_phase(const Params& p) {
    const int wid = threadIdx.x >> 6, lane = threadIdx.x & 63;
    const bf16_t* HD = (const bf16_t*)(p.ws + WS_HDIR); const bf16_t* O = (const bf16_t*)(p.ws + WS_O); bf16_t* CAT = (bf16_t*)(p.ws + WS_CAT);
    const float* ng = p.in[15];
    for (int row = blockIdx.x * 8 + wid; row < ML; row += gridDim.x * 8) {
        const int e0 = lane * 16;
        float hs[16]; float ss = 0.f;
#pragma unroll
        for (int i = 0; i < 2; ++i) { const u32x4 a = *(const u32x4*)(HD + (size_t)row * 1024 + e0 + i * 8), bq = *(const u32x4*)(HD + (size_t)ML * 1024 + (size_t)row * 1024 + e0 + i * 8);
#pragma unroll
            for (int c = 0; c < 8; ++c) { const float f = bfel(a, c) + bfel(bq, c); hs[i * 8 + c] = f; ss += f * f; } }
        ss += __shfl_xor(ss, 1); ss += __shfl_xor(ss, 2); ss += __shfl_xor(ss, 4); ss += __shfl_xor(ss, 8);
        const float rstd = rsqrtf(ss * (1.f / 256.f) + 1e-6f);
#pragma unroll
        for (int i = 0; i < 2; ++i) { const u32x4 ov = *(const u32x4*)(O + (size_t)row * 1024 + e0 + i * 8);
            float y[8];
#pragma unroll
            for (int c = 0; c < 8; ++c) y[c] = hs[i * 8 + c] * rstd * ng[e0 + i * 8 + c] * bfel(ov, c);
            u32x4 o; o.x = cvt_pk_bf16(y[0], y[1]); o.y = cvt_pk_bf16(y[2], y[3]); o.z = cvt_pk_bf16(y[4], y[5]); o.w = cvt_pk_bf16(y[6], y[7]);
            *(u32x4*)(CAT + (size_t)row * 2048 + e0 + i * 8) = o; }
    }
}

template <int ph> __device__ __forceinline__ void run_phase(const Params& p, LAS unsigned char* lds) {
    unsigned char* ws = p.ws;
    const float* mod = (const float*)(ws + WS_MOD);
    bf16_t* const XN = (bf16_t*)(ws + WS_XN); bf16_t* const Hb = (bf16_t*)(ws + WS_H);
    if (ph == 0) { for (int u = blockIdx.x; u < 288 + 10304; u += gridDim.x) { if (u < 288) adaln_unit(p, (LAS float*)lds, u); else wtile_unit(p, (LAS float*)lds, u - 288); } }
    else if (ph == 1) norm_phase(p.in[0], p.in[2], nullptr, nullptr, nullptr, M1, p.in[6], mod, 0 * D, 1 * D, XN, nullptr);
    else if (ph == 2) gemm_phase(lds, p, XN, (const bf16_t*)(ws + WS_WF1IN), M1, 2 * DFF, D, EPI_SWIGLU, 1, Hb, 0, 0.f);
    else if (ph == 3) gemm_phase(lds, p, Hb, (const bf16_t*)(ws + WS_WF1OUT), M1, D, DFF, EPI_RESID, 1, XN, 2 * D, 0.5f);
    else if (ph == 4) norm_phase(p.in[0], p.in[2], XN, (const bf16_t*)(ws + WS_CAT), p.out, M1, p.in[9], mod, 3 * D, 4 * D, XN, nullptr);
    else if (ph == 5) gemm_phase(lds, p, XN, (const bf16_t*)(ws + WS_WIN), M1, INP, D, EPI_INPROJ, 1, Hb, 0, 0.f);
    else if (ph == 6) { for (int u = blockIdx.x; u < 256 + 2176; u += gridDim.x) { if (u < 256) gmlp_unit(p, lds, u); else conv_unit(p, u - 256); } }
    else if (ph == 7) scan_phase(p, lds);
    else if (ph == 8) mout_phase(p, lds);
    else if (ph == 9) { }
    else if (ph == 10) gemm_phase(lds, p, (const bf16_t*)(ws + WS_CAT), (const bf16_t*)(ws + WS_WOUT), ML, D, D, EPI_RESID, 1, XN, 5 * D, 1.0f);
    else if (ph == 11) norm_phase(p.out, p.out, XN, nullptr, p.out, ML, p.in[20], mod, 6 * D, 7 * D, XN, nullptr);
    else if (ph == 12) gemm_phase(lds, p, XN, (const bf16_t*)(ws + WS_WF2IN), ML, 2 * DFF, D, EPI_SWIGLU, 1, Hb, 0, 0.f);
    else if (ph == 13) gemm_phase(lds, p, Hb, (const bf16_t*)(ws + WS_WF2OUT), ML, D, DFF, EPI_RESID, 1, XN, 8 * D, 0.5f);
    else if (ph == 14) norm_phase(p.out, p.out, XN, nullptr, nullptr, ML, p.in[23], nullptr, 0, 0, nullptr, p.out);
}

#define RUNPH(n) if (p.ph_lo <= n && n < p.ph_hi) { run_phase<n>(p, lds); if (n + 1 < p.ph_hi) xcd_barrier(xb); }
__global__ void __launch_bounds__(512, 2) hymba_megakernel(Params p) {
    extern __shared__ __attribute__((aligned(16))) unsigned char shm[];
    LAS unsigned char* lds = (LAS unsigned char*)shm;
    cg::grid_group grid = cg::this_grid();
    unsigned* barw = (unsigned*)(p.ws + WS_BAR);
    volatile LAS unsigned* stw = (volatile LAS unsigned*)(lds + LDS_BYTES - 16);
    if (blockIdx.x == 0) for (int i = threadIdx.x; i < XCD_BAR_WORDS; i += 512) barw[i] = 0u;
    run_phase<0>(p, lds);
    grid.sync();
    if (threadIdx.x == 0) { stw[0] = 0u; stw[1] = 0u; }
    __syncthreads();
    XcdBarrier xb = xcd_barrier_post(barw, stw);
    RUNPH(1) RUNPH(2) RUNPH(3) RUNPH(4) RUNPH(5) RUNPH(6) RUNPH(7) RUNPH(8) RUNPH(10) RUNPH(11) RUNPH(12) RUNPH(13) RUNPH(14)
}

extern "C" void kernel_launch(void* const* d_in, const int* in_sizes, int n_in, void* d_out, int out_size, void* d_ws, size_t ws_size, hipStream_t stream) {
    static int grid = 0;
    if (grid == 0) {
        if (n_in != 24 || out_size != ML * D || ws_size < WS_END) { fprintf(stderr, "kernel_launch: unexpected shapes (n_in %d out %d ws %zu need %zu)\n", n_in, out_size, ws_size, (size_t)WS_END); grid = -1; return; }
        int dev = 0, cus = 0, per_cu = 0;
        hipGetDevice(&dev);
        hipDeviceGetAttribute(&cus, hipDeviceAttributeMultiprocessorCount, dev);
        if (hipFuncSetAttribute((const void*)hymba_megakernel, hipFuncAttributeMaxDynamicSharedMemorySize, LDS_BYTES) != hipSuccess) { fprintf(stderr, "kernel_launch: hipFuncSetAttribute failed\n"); }
        if (hipOccupancyMaxActiveBlocksPerMultiprocessor(&per_cu, (const void*)hymba_megakernel, 512, LDS_BYTES) != hipSuccess || per_cu < 1) per_cu = 1;
        (void)hipGetLastError();
        grid = cus * per_cu;
        fprintf(stderr, "kernel_launch: cus %d per_cu %d grid %d\n", cus, per_cu, grid);
    }
    if (grid < 0) return;
    Params p{};
    for (int i = 0; i < 24; ++i) p.in[i] = (const float*)d_in[i];
    p.out = (float*)d_out; p.ws = (unsigned char*)d_ws;
#if MK_MULTI
    for (int ph = 0; ph < NPH; ++ph) { p.ph_lo = ph; p.ph_hi = ph + 1; hipLaunchKernelGGL(hymba_megakernel, dim3(grid), dim3(512), LDS_BYTES, stream, p); }
#else
    p.ph_lo = 0; p.ph_hi = NPH;
    void* args[] = {&p};
    hipError_t e = hipLaunchCooperativeKernel((const void*)hymba_megakernel, dim3(grid), dim3(512), args, LDS_BYTES, stream);
    if (e != hipSuccess) fprintf(stderr, "cooperative launch failed: %s (grid %d)\n", hipGetErrorString(e), grid);
#endif
}
```

```cpp
#include <hip/hip_runtime.h>
#include <hip/hip_cooperative_groups.h>
#include <cstdio>
namespace cg = cooperative_groups;

#ifndef MK_MULTI
#define MK_MULTI 0
#endif

#ifndef PHSEL
#define PHSEL 0xffff
#endif
#define PHON(n) ((PHSEL >> (n)) & 1)
#define LAS __attribute__((address_space(3)))
typedef unsigned short bf16_t;
typedef short bf16x8 __attribute__((ext_vector_type(8)));
typedef float f32x4 __attribute__((ext_vector_type(4)));
typedef unsigned u32x4 __attribute__((ext_vector_type(4)));
typedef unsigned u32x2 __attribute__((ext_vector_type(2)));

constexpr int D = 2048, ML = 32768, MC = 2048, M1 = ML + MC, DFF = 5632, NMODC = 9 * 2048, INP = 5376;
constexpr int NPH = 15;
constexpr int LDS_BYTES = 147456;

constexpr size_t al256(size_t x) { return (x + 255) & ~(size_t)255; }
constexpr size_t WS_WF1IN = 0;
constexpr size_t WS_WF1OUT = WS_WF1IN + (size_t)11264 * 2048 * 2;
constexpr size_t WS_WIN = WS_WF1OUT + (size_t)2048 * 5632 * 2;
constexpr size_t WS_WOUT = WS_WIN + (size_t)INP * 2048 * 2;
constexpr size_t WS_WF2IN = WS_WOUT + (size_t)2048 * 2048 * 2;
constexpr size_t WS_WF2OUT = WS_WF2IN + (size_t)11264 * 2048 * 2;
constexpr size_t WS_MOD = WS_WF2OUT + (size_t)2048 * 5632 * 2;
constexpr size_t WS_XN = al256(WS_MOD + (size_t)9 * NMODC * 4);
constexpr size_t WS_MPREV = WS_XN + (size_t)M1 * 2048 * 2;
constexpr size_t WS_H = al256(WS_MPREV + 64 * 32 * 4);
constexpr size_t WS_ZQK = WS_H;
constexpr size_t WS_V = WS_ZQK + (size_t)M1 * 1024 * 2;
constexpr size_t WS_O = WS_V + (size_t)M1 * 1024 * 2;
constexpr size_t WS_U = WS_O + (size_t)ML * 1024 * 2;
constexpr size_t WS_GV = WS_U + (size_t)ML * 1024 * 2;
constexpr size_t WS_HDIR = WS_U;
constexpr size_t WS_G = WS_GV + (size_t)ML * 1024 * 2;
constexpr size_t WS_Q = WS_G + (size_t)M1 * 16 * 4;
constexpr size_t WS_X1C = al256(WS_H + (size_t)M1 * DFF * 2);
constexpr size_t WS_CAT = WS_X1C + (size_t)MC * 2048 * 4;
constexpr size_t WS_K = WS_CAT + (size_t)ML * 2048 * 2;
constexpr size_t WS_KT = WS_K + (size_t)ML * 512 * 2;
constexpr size_t WS_VT = WS_KT + (size_t)272 * 4 * 128 * 128 * 2;
constexpr size_t WS_BAR = WS_VT + (size_t)272 * 4 * 256 * 128 * 2;
constexpr size_t WS_END = WS_BAR + 16384;
static_assert(WS_Q + (size_t)ML * 512 * 2 <= WS_X1C, "in-proj outputs overflow the H region");

struct Params {
    const float* in[24];
    float* out;
    unsigned char* ws;
    int ph_lo, ph_hi;
};

__device__ __forceinline__ unsigned cvt_pk_bf16(float lo, float hi) { unsigned r; asm volatile("v_cvt_pk_bf16_f32 %0, %1, %2" : "=v"(r) : "v"(lo), "v"(hi)); return r; }
__device__ __forceinline__ float bflo(unsigned u) { return __uint_as_float(u << 16); }
__device__ __forceinline__ float bfhi(unsigned u) { return __uint_as_float(u & 0xffff0000u); }
__device__ __forceinline__ float bfel(const u32x4& v, int c) { const unsigned w = (c >> 1) == 0 ? v.x : (c >> 1) == 1 ? v.y : (c >> 1) == 2 ? v.z : v.w; return (c & 1) ? bfhi(w) : bflo(w); }
__device__ __forceinline__ unsigned us16(const u32x4& v, int c) { const unsigned w = (c >> 1) == 0 ? v.x : (c >> 1) == 1 ? v.y : (c >> 1) == 2 ? v.z : v.w; return (c & 1) ? (w >> 16) : (w & 0xffffu); }
__device__ __forceinline__ float wave_sum(float v) {
#pragma unroll
    for (int o = 32; o; o >>= 1) v += __shfl_xor(v, o);
    return v; }
__device__ __forceinline__ float wave_max(float v) {
#pragma unroll
    for (int o = 32; o; o >>= 1) v = fmaxf(v, __shfl_xor(v, o));
    return v; }
__device__ __forceinline__ float wave_scan_sum(float v, int lane) {
#pragma unroll
    for (int o = 1; o < 64; o <<= 1) { const float t = __shfl_up(v, o); if (lane >= o) v += t; }
    return v; }
__device__ __forceinline__ float wave_scan_max(float v, int lane) {
#pragma unroll
    for (int o = 1; o < 64; o <<= 1) { const float t = __shfl_up(v, o); if (lane >= o) v = fmaxf(v, t); }
    return v; }
__device__ __forceinline__ float fexp2_(float x) { return __builtin_amdgcn_exp2f(x); }
__device__ __forceinline__ float sigmoidf_(float x) { return __builtin_amdgcn_rcpf(1.f + fexp2_(-1.4426950408889634f * x)); }
__device__ __forceinline__ float siluf_(float x) { return x * __builtin_amdgcn_rcpf(1.f + fexp2_(-1.4426950408889634f * x)); }
__device__ __forceinline__ float geluf_(float x) { const float y = x * (-2.3022082f + -0.1029432f * x * x); return x * __builtin_amdgcn_rcpf(1.f + fexp2_(y)); }

#define XB_TMO      128
#define XB_XCNT(j)  (256  + 64 * (j))
#define XB_XSUB(j)  (1280 + 64 * (j))
#define XB_XGEN(j)  (2304 + 64 * (j))
#define XB_TOP      3328
#define XB_TOPGEN   3392
#define XCD_BAR_WORDS 3456
#define XB_SPIN_CAP (1u << 22)
__device__ __forceinline__ unsigned xb_ld(unsigned* p)              { return __hip_atomic_load(p, __ATOMIC_RELAXED, __HIP_MEMORY_SCOPE_AGENT); }
__device__ __forceinline__ unsigned xb_add(unsigned* p, unsigned v) { return __hip_atomic_fetch_add(p, v, __ATOMIC_RELAXED, __HIP_MEMORY_SCOPE_AGENT); }
__device__ __forceinline__ unsigned xb_xcc_id() { return (unsigned)__builtin_amdgcn_s_getreg((3 << 11) | 20) & 0xFu; }
#define XB_SPIN(cond, bar) do { unsigned _sp = 0; while (cond) { __builtin_amdgcn_s_sleep(1); \
    if ((++_sp & 255u) == 0u) { if (xb_ld(&(bar)[XB_TMO])) break; if (_sp > XB_SPIN_CAP) { atomicAdd(&(bar)[XB_TMO], 1u); break; } } } } while (0)
struct XcdBarrier { unsigned* bar; unsigned x; volatile LAS unsigned* st; };
__device__ __forceinline__ XcdBarrier xcd_barrier_post(unsigned* bar, volatile LAS unsigned* st) {
    XcdBarrier b; b.bar = bar; b.x = xb_xcc_id(); b.st = st;
    if (threadIdx.x == 0) (void)xb_add(&bar[XB_XCNT(b.x)], 1u);
    return b;
}
__device__ __forceinline__ void xcd_barrier_complete(unsigned* bar, unsigned x, unsigned& nloc, unsigned& nx) {
    const unsigned G = gridDim.x * gridDim.y * gridDim.z;
    unsigned sum, cnt, mine, sp = 0u;
    for (;;) {
        sum = 0u; cnt = 0u; mine = 0u;
#pragma unroll
        for (unsigned j = 0; j < 16; ++j) { const unsigned c = xb_ld(&bar[XB_XCNT(j)]); sum += c; cnt += (c > 0u) ? 1u : 0u; mine = (j == x) ? c : mine; }
        if (sum == G) break;
        __builtin_amdgcn_s_sleep(1);
        if ((++sp & 255u) == 0u) { if (xb_ld(&bar[XB_TMO])) break; if (sp > XB_SPIN_CAP) { atomicAdd(&bar[XB_TMO], 1u); break; } }
    }
    nloc = mine > 0u ? mine : 1u; nx = cnt > 0u ? cnt : 1u;
}
__device__ __forceinline__ void xcd_barrier(const XcdBarrier& b) {
    asm volatile("s_waitcnt vmcnt(0)" ::: "memory");
    __syncthreads();
    if (threadIdx.x == 0) {
        unsigned* bar = b.bar;
        __builtin_amdgcn_s_waitcnt(0);
        unsigned nloc = b.st[0], nx = b.st[1];
        if (nloc == 0u) { xcd_barrier_complete(bar, b.x, nloc, nx); b.st[0] = nloc; b.st[1] = nx; }
        const unsigned old = xb_add(&bar[XB_XSUB(b.x)], 1u);
        const unsigned gen = old / nloc;
        if (old + 1u == (gen + 1u) * nloc) {
            __builtin_amdgcn_fence(__ATOMIC_RELEASE, "agent");
            asm volatile("s_waitcnt vmcnt(0)" ::: "memory");
            const unsigned og = xb_add(&bar[XB_TOP], 1u);
            const unsigned tg = og / nx;
            if (og + 1u == (tg + 1u) * nx) xb_add(&bar[XB_TOPGEN], 1u);
            else XB_SPIN(xb_ld(&bar[XB_TOPGEN]) == tg, bar);
            __builtin_amdgcn_fence(__ATOMIC_ACQUIRE, "agent");
            xb_add(&bar[XB_XGEN(b.x)], 1u);
            asm volatile("s_waitcnt vmcnt(0)" ::: "memory");
        } else {
            XB_SPIN(xb_ld(&bar[XB_XGEN(b.x)]) == gen, bar);
            __builtin_amdgcn_fence(__ATOMIC_ACQUIRE, "agent");
            asm volatile("s_waitcnt vmcnt(0)" ::: "memory");
        }
    }
    __syncthreads();
}

namespace pg8 {
constexpr int BM = 256, BK = 64, HALF = 128, HTB = HALF * BK * 2, NXCD = 8, WGM = 8;
__device__ __forceinline__ int lds_byte(int r, int c) { const int st = (r >> 4) * 2 + (c >> 5), rr = r & 15, cc = c & 31, ob = rr * 64 + cc * 2; return st * 1024 + (ob ^ (((ob >> 9) & 1) << 5)); }
__device__ __forceinline__ void stage_rc(int b, int& R, int& C) { const int st = b / 1024, sb = b % 1024, swz = sb ^ (((sb >> 9) & 1) << 5); R = (st >> 1) * 16 + swz / 64; C = (st & 1) * 32 + (swz % 64) / 2; }
__device__ __forceinline__ int perm32(int rho) { const int n = rho >> 4, i = rho & 15; return 8 * (i >> 2) + 4 * n + (i & 3); }
struct Unit { int pm, pn, ks; };
struct StaticOrder {
    int nM, nN, nwg, G, c;
    __device__ void init(int M, int N, int G_, int c_) { nM = M / BM; nN = N / BM; nwg = nM * nN; G = G_; c = c_; extra = 0; pre = 0; }
    int extra;
    int pre;
    __device__ bool next(int i, Unit& u) const {
        long L = (long)i * G + c; u.ks = -1;
        if (L < pre) { const int t = (int)L & 63; u.ks = (int)L >> 6; u.pm = nM + (t >> 3); u.pn = t & 7; return true; }
        L -= pre;
        if (L >= nwg + extra) return false;
        if (L >= nwg) { const int j = (int)(L - nwg); const int q = j >> 3; u.pm = nM + (j & 7); u.pn = q < 6 ? q + 2 : 20; return true; }
        int wgid = (int)L; { const int q = nwg / NXCD, r = nwg % NXCD, xcd = wgid % NXCD, off = wgid / NXCD; wgid = (xcd < r ? xcd * (q + 1) : r * (q + 1) + (xcd - r) * q) + off; }
        const int wgm = nN <= 8 ? 4 : WGM;
        const int nig = wgm * nN, gid = wgid / nig, fm = gid * wgm, gsz = (nM - fm) < wgm ? (nM - fm) : wgm;
        u.pm = fm + ((wgid % nig) % gsz); u.pn = (wgid % nig) / gsz; return true;
    }
};
}

enum { EPI_SWIGLU = 0, EPI_RESID = 1, EPI_INPROJ = 2 };
__device__ __forceinline__ void gemm_epilogue(const Params& p, const int epi, bf16_t* const Hp, const int goff, const float coef, const f32x4 (&acc)[2][2][4][2], const pg8::Unit& u, int wr, int wc, int fr, int fq) {
    if (epi == EPI_SWIGLU) {
        const int col0 = u.pn * 128 + wc * 32 + fq * 8;
#pragma unroll
        for (int ai = 0; ai < 2; ++ai)
#pragma unroll
            for (int m = 0; m < 4; ++m) {
                const int row = u.pm * 256 + ai * 128 + wr * 64 + m * 16 + fr;
                float h[8];
#pragma unroll
                for (int n = 0; n < 2; ++n)
#pragma unroll
                    for (int i = 0; i < 4; ++i) h[n * 4 + i] = siluf_(acc[ai][0][m][n][i]) * acc[ai][1][m][n][i];
                u32x4 o; o.x = cvt_pk_bf16(h[0], h[1]); o.y = cvt_pk_bf16(h[2], h[3]); o.z = cvt_pk_bf16(h[4], h[5]); o.w = cvt_pk_bf16(h[6], h[7]);
                *(u32x4*)(Hp + (size_t)row * DFF + col0) = o;
            }
    } else if (epi == EPI_RESID) {
        const bool lat = u.pm < 128;
        const int b = lat ? (u.pm >> 4) : 8;
        const float* gate = (const float*)(p.ws + WS_MOD) + (size_t)b * NMODC + goff;
#pragma unroll
        for (int bj = 0; bj < 2; ++bj) {
            const int col = u.pn * 256 + bj * 128 + wc * 32 + fq * 8;
            const f32x4 g0 = *(const f32x4*)(gate + col) * coef, g1 = *(const f32x4*)(gate + col + 4) * coef;
#pragma unroll
            for (int ai = 0; ai < 2; ++ai)
#pragma unroll
                for (int m = 0; m < 4; ++m) {
                    const int row = u.pm * 256 + ai * 128 + wr * 64 + m * 16 + fr;
                    const f32x4 v0 = acc[ai][bj][m][0] * g0, v1 = acc[ai][bj][m][1] * g1;
                    u32x4 o; o.x = cvt_pk_bf16(v0[0], v0[1]); o.y = cvt_pk_bf16(v0[2], v0[3]); o.z = cvt_pk_bf16(v1[0], v1[1]); o.w = cvt_pk_bf16(v1[2], v1[3]);
                    *(u32x4*)((u.ks >= 0 ? (bf16_t*)(p.ws + WS_CAT) + (size_t)u.ks * MC * D + (size_t)(row - ML) * D : Hp + (size_t)row * D) + col) = o;
                }
        }
    } else {
        const int seg = u.pn >> 2;
        const bool lat = u.pm < 128;
        if (seg < 5) {
            if (seg >= 2 && !lat) return;
            bf16_t* dst = (bf16_t*)(p.ws + (seg == 0 ? WS_ZQK : seg == 1 ? WS_V : seg == 2 ? WS_O : seg == 3 ? WS_U : WS_GV));
#pragma unroll
            for (int ai = 0; ai < 2; ++ai)
#pragma unroll
                for (int m = 0; m < 4; ++m) {
                    const int row = u.pm * 256 + ai * 128 + wr * 64 + m * 16 + fr;
#pragma unroll
                    for (int bj = 0; bj < 2; ++bj) {
                        const int cl = (u.pn & 3) * 256 + bj * 128 + wc * 32 + fq * 8;
                        float h[8];
#pragma unroll
                        for (int n = 0; n < 2; ++n)
#pragma unroll
                            for (int i = 0; i < 4; ++i) { const float a = acc[ai][bj][m][n][i]; h[n * 4 + i] = seg < 2 ? a : seg == 2 ? sigmoidf_(a) : geluf_(a); }
                        u32x4 o; o.x = cvt_pk_bf16(h[0], h[1]); o.y = cvt_pk_bf16(h[2], h[3]); o.z = cvt_pk_bf16(h[4], h[5]); o.w = cvt_pk_bf16(h[6], h[7]);
                        *(u32x4*)(dst + (size_t)row * 1024 + cl) = o;
                    }
                }
        } else if (wc == 0 && fq < 2) {
            const f32x4 bi = *(const f32x4*)(p.in[13] + fq * 4), bfv = *(const f32x4*)(p.in[14] + fq * 4);
#pragma unroll
            for (int ai = 0; ai < 2; ++ai)
#pragma unroll
                for (int m = 0; m < 4; ++m) {
                    const int row = u.pm * 256 + ai * 128 + wr * 64 + m * 16 + fr;
                    const f32x4 li = acc[ai][0][m][0] + bi;
                    const f32x4 xf = acc[ai][0][m][1] + bfv;
                    f32x4 lf;
#pragma unroll
                    for (int i = 0; i < 4; ++i) lf[i] = fminf(xf[i], 0.f) - log1pf(expf(-fabsf(xf[i])));
                    *(f32x4*)((float*)(p.ws + WS_G) + (size_t)row * 16 + fq * 8) = li;
                    *(f32x4*)((float*)(p.ws + WS_G) + (size_t)row * 16 + fq * 8 + 4) = lf;
                }
        }
    }
}

__device__ __forceinline__ void gemm_phase(LAS unsigned char* lds, const Params& p, const bf16_t* gA, const bf16_t* gBt, const int gM, const int gN, const int gK, const int epi, const int perm, bf16_t* const Hp, const int goff, const float coef) {
    using namespace pg8;
    const int tid = threadIdx.x, wid = __builtin_amdgcn_readfirstlane(tid >> 6), lane = tid & 63, wr = wid >> 2, wc = wid & 3, fr = lane & 15, fq = lane >> 4;
    const int K = gK, ntf = K / BK;
    const size_t ksl = (size_t)(K / 4) * 2;
    StaticOrder S; S.init(gM, gN, (int)gridDim.x, (int)blockIdx.x);
    if (epi == EPI_INPROJ) { S.init(ML, gN, (int)gridDim.x, (int)blockIdx.x); S.extra = 56; }
    if (epi == EPI_RESID && gM == M1) { S.init(ML, gN, (int)gridDim.x, (int)blockIdx.x); S.pre = 256; }
    unsigned voffA[2], voffB[2];
#pragma unroll
    for (int i = 0; i < 2; ++i) { int R, C; stage_rc(tid * 16 + i * 8192, R, C); const int Rb = perm ? ((R & ~31) + perm32(R & 31)) : R;
        voffA[i] = (unsigned)(R * K + C) * 2u; voffB[i] = (unsigned)(Rb * K + C) * 2u; }
    const size_t kstep = (size_t)(BK * 2);
    const size_t hstep = (size_t)HALF * K * 2;
    const size_t tstep = 2 * hstep;
    const unsigned ldsw = (unsigned)wid * 1024u;
    const int aoff = lds_byte(wr * 64 + fr, fq * 8), boff = lds_byte(wc * 32 + fr, fq * 8);
#define PG8_SA(b, h) (((b) * 2 + (h)) * HTB)
#define PG8_SB(b, h) ((4 + (b) * 2 + (h)) * HTB)
#define PG8_STAGE(bufoff, gbase, voff) do { _Pragma("unroll") for (int _i = 0; _i < 2; ++_i) \
        __builtin_amdgcn_global_load_lds((const unsigned*)((const char*)(gbase) + (voff)[_i]), (LAS unsigned*)(lds + (bufoff) + ldsw + _i * 8192), 16, 0, 0); } while (0)
#define PG8_LDA(dst, b, h) do { _Pragma("unroll") for (int m = 0; m < 4; ++m) _Pragma("unroll") for (int k = 0; k < 2; ++k) dst[m][k] = *(const LAS bf16x8*)(lds + PG8_SA(b, h) + aoff + m * 2048 + k * 1024); } while (0)
#define PG8_LDB(dst, b, h) do { _Pragma("unroll") for (int n = 0; n < 2; ++n) _Pragma("unroll") for (int k = 0; k < 2; ++k) dst[n][k] = *(const LAS bf16x8*)(lds + PG8_SB(b, h) + boff + n * 2048 + k * 1024); } while (0)
#define PG8_MMA(ai, bj, At, Bt) do { __builtin_amdgcn_s_setprio(1); _Pragma("unroll") for (int m = 0; m < 4; ++m) _Pragma("unroll") for (int n = 0; n < 2; ++n) _Pragma("unroll") for (int k = 0; k < 2; ++k) \
        acc[ai][bj][m][n] = __builtin_amdgcn_mfma_f32_16x16x32_bf16(Bt[n][k], At[m][k], acc[ai][bj][m][n], 0, 0, 0); __builtin_amdgcn_s_setprio(0); } while (0)
#define PG8_WAIT_V(n) asm volatile("s_waitcnt vmcnt(" #n ")" ::: "memory")
#define PG8_WAIT_L(n) asm volatile("s_waitcnt lgkmcnt(" #n ")" ::: "memory")
#define PG8_BAR __builtin_amdgcn_s_barrier()
#define PG8_SCHED __builtin_amdgcn_sched_barrier(0)
    Unit cur, nxt; int ui = 0;
    if (!S.next(0, cur)) return;
    f32x4 acc[2][2][4][2];
#pragma unroll
    for (int a = 0; a < 2; ++a)
#pragma unroll
        for (int b = 0; b < 2; ++b)
#pragma unroll
            for (int m = 0; m < 4; ++m)
#pragma unroll
                for (int n = 0; n < 2; ++n) acc[a][b][m][n] = (f32x4){0.f, 0.f, 0.f, 0.f};
    bf16x8 At[4][2], B0[2][2], B1[2][2];
    const char* cA = (const char*)gA + (size_t)cur.pm * tstep + (cur.ks > 0 ? cur.ks * ksl : 0); const char* cB = (const char*)gBt + (size_t)cur.pn * tstep + (cur.ks > 0 ? cur.ks * ksl : 0);
    PG8_STAGE(PG8_SB(0, 0), cB, voffB); PG8_STAGE(PG8_SB(0, 1), cB + hstep, voffB); PG8_STAGE(PG8_SA(0, 0), cA, voffA); PG8_STAGE(PG8_SA(0, 1), cA + hstep, voffA);
    if (wr == 1) PG8_BAR;
    PG8_WAIT_V(2); PG8_BAR;
    PG8_STAGE(PG8_SB(1, 0), cB + kstep, voffB); PG8_STAGE(PG8_SA(1, 0), cA + kstep, voffA); PG8_STAGE(PG8_SB(1, 1), cB + hstep + kstep, voffB);
    PG8_WAIT_V(6); PG8_BAR;
    for (;;) {
        const bool has_next = S.next(ui + 1, nxt);
        const char* nA = has_next ? (const char*)gA + (size_t)nxt.pm * tstep + (nxt.ks > 0 ? nxt.ks * ksl : 0) : cA; const char* nB = has_next ? (const char*)gBt + (size_t)nxt.pn * tstep + (nxt.ks > 0 ? nxt.ks * ksl : 0) : cB;
        const int nt = cur.ks >= 0 ? ntf / 4 : ntf;
        for (int t = 0; t < nt; t += 2) {
            const bool last = (t == nt - 2);
            const char* a1 = cA + (size_t)(t + 1) * kstep;
            const char* a2 = last ? nA : cA + (size_t)(t + 2) * kstep; const char* b2 = last ? nB : cB + (size_t)(t + 2) * kstep;
            const char* a3 = a2 + kstep; const char* b3 = b2 + kstep;
            PG8_LDB(B0, 0, 0); PG8_LDB(B1, 0, 1); PG8_SCHED; PG8_LDA(At, 0, 0); PG8_STAGE(PG8_SA(1, 1), a1 + hstep, voffA);
            PG8_WAIT_V(8); PG8_WAIT_L(0); PG8_BAR; PG8_MMA(0, 0, At, B0); PG8_MMA(0, 1, At, B1); PG8_BAR; PG8_SCHED;
            PG8_LDA(At, 0, 1); PG8_STAGE(PG8_SB(0, 0), b2, voffB); PG8_STAGE(PG8_SB(0, 1), b2 + hstep, voffB); PG8_STAGE(PG8_SA(0, 0), a2, voffA);
            PG8_WAIT_V(8); PG8_WAIT_L(0); PG8_BAR; PG8_MMA(1, 0, At, B0); PG8_MMA(1, 1, At, B1); PG8_BAR; PG8_SCHED;
            PG8_LDB(B0, 1, 0); PG8_LDB(B1, 1, 1); PG8_SCHED; PG8_LDA(At, 1, 0); PG8_STAGE(PG8_SA(0, 1), a2 + hstep, voffA);
            PG8_WAIT_V(8); PG8_WAIT_L(0); PG8_BAR; PG8_MMA(0, 0, At, B0); PG8_MMA(0, 1, At, B1); PG8_BAR; PG8_SCHED;
            PG8_LDA(At, 1, 1); PG8_STAGE(PG8_SB(1, 0), b3, voffB); PG8_STAGE(PG8_SB(1, 1), b3 + hstep, voffB); PG8_STAGE(PG8_SA(1, 0), a3, voffA);
            PG8_WAIT_V(8); PG8_WAIT_L(0); PG8_BAR; PG8_MMA(1, 0, At, B0); PG8_MMA(1, 1, At, B1); PG8_BAR; PG8_SCHED;
        }
        if (wr == 0) PG8_BAR;
        gemm_epilogue(p, epi, Hp, goff, coef, acc, cur, wr, wc, fr, fq);
        if (!has_next) break;
#pragma unroll
        for (int a = 0; a < 2; ++a)
#pragma unroll
            for (int b = 0; b < 2; ++b)
#pragma unroll
                for (int m = 0; m < 4; ++m)
#pragma unroll
                    for (int n = 0; n < 2; ++n) acc[a][b][m][n] = (f32x4){0.f, 0.f, 0.f, 0.f};
        cur = nxt; cA = nA; cB = nB; ++ui;
        if (wr == 1) PG8_BAR;
    }
    PG8_WAIT_V(0);
    PG8_BAR;
#undef PG8_SA
#undef PG8_SB
#undef PG8_STAGE
#undef PG8_LDA
#undef PG8_LDB
#undef PG8_MMA
#undef PG8_WAIT_V
#undef PG8_WAIT_L
#undef PG8_BAR
#undef PG8_SCHED
}

__device__ __forceinline__ void adaln_unit(const Params& p, LAS float* sm, int unit) {
    const int t = threadIdx.x;
    for (int idx = t; idx < 9 * 2048; idx += 512) { const int i = idx >> 11, k = idx & 2047; const float v = (i < 8) ? p.in[1][i * 2048 + k] : p.in[3][k]; sm[k * 9 + i] = siluf_(v); }
    __syncthreads();
    const int col4 = (t & 15) * 4, ksub = t >> 4;
    const float* w = p.in[4] + (size_t)unit * 64 + col4;
    float acc[9][4];
#pragma unroll
    for (int i = 0; i < 9; ++i)
#pragma unroll
        for (int j = 0; j < 4; ++j) acc[i][j] = 0.f;
#pragma unroll 4
    for (int kk = 0; kk < 64; ++kk) {
        const int k = kk * 32 + ksub;
        const f32x4 wv = *(const f32x4*)(w + (size_t)k * NMODC);
#pragma unroll
        for (int i = 0; i < 9; ++i) { const float s = sm[k * 9 + i];
#pragma unroll
            for (int j = 0; j < 4; ++j) acc[i][j] += s * wv[j]; }
    }
    __syncthreads();
#pragma unroll
    for (int i = 0; i < 9; ++i)
#pragma unroll
        for (int j = 0; j < 4; ++j) sm[(ksub * 9 + i) * 64 + col4 + j] = acc[i][j];
    __syncthreads();
    float* mod = (float*)(p.ws + WS_MOD);
    for (int o = t; o < 9 * 64; o += 512) { const int i = o >> 6, c = o & 63; float s = 0.f;
        for (int ks = 0; ks < 32; ++ks) s += sm[(ks * 9 + i) * 64 + c];
        mod[(size_t)i * NMODC + unit * 64 + c] = s + p.in[5][unit * 64 + c]; }
    __syncthreads();
}

__device__ __forceinline__ int colmap(int map, int n) {
    if (map == 0) return n;
    if (map == 1) { const int pn = n >> 8, rem = n & 255; return (rem >> 7) * DFF + pn * 128 + (rem & 127); }
    return n < 3072 ? n : (n < 5120 ? n + 16 : (n < 5136 ? n - 2048 : -1));
}

__device__ __forceinline__ void wtile_unit(const Params& p, LAS float* sm, int tile) {
    const float* src; bf16_t* dst; int K, ldw, map, local;
    if (tile < 2816) { src = p.in[7]; dst = (bf16_t*)(p.ws + WS_WF1IN); K = 2048; ldw = 11264; map = 1; local = tile; }
    else if (tile < 4224) { src = p.in[8]; dst = (bf16_t*)(p.ws + WS_WF1OUT); K = 5632; ldw = 2048; map = 0; local = tile - 2816; }
    else if (tile < 5568) { src = p.in[10]; dst = (bf16_t*)(p.ws + WS_WIN); K = 2048; ldw = 5136; map = 2; local = tile - 4224; }
    else if (tile < 6080) { src = p.in[19]; dst = (bf16_t*)(p.ws + WS_WOUT); K = 2048; ldw = 2048; map = 0; local = tile - 5568; }
    else if (tile < 8896) { src = p.in[21]; dst = (bf16_t*)(p.ws + WS_WF2IN); K = 2048; ldw = 11264; map = 1; local = tile - 6080; }
    else { src = p.in[22]; dst = (bf16_t*)(p.ws + WS_WF2OUT); K = 5632; ldw = 2048; map = 0; local = tile - 8896; }
    const int nkt = K >> 7, ntile = local / nkt, kt = local - ntile * nkt;
    const int n0 = ntile * 64, k0 = kt * 128;
    const int t = threadIdx.x;
    {
        const int n4 = (t & 15) * 4, kr = t >> 4;
        const int col = colmap(map, n0 + n4);
#pragma unroll
        for (int i = 0; i < 4; ++i) { const int k = kr + 32 * i;
            f32x4 v = (f32x4){0.f, 0.f, 0.f, 0.f};
            if (col >= 0) v = *(const f32x4*)(src + (size_t)(k0 + k) * ldw + col);
#pragma unroll
            for (int j = 0; j < 4; ++j) sm[k * 65 + n4 + j] = v[j]; }
    }
    __syncthreads();
#pragma unroll
    for (int it = 0; it < 2; ++it) {
        const int n = t >> 3, k8 = (t & 7) * 8 + 64 * it;
        float f[8];
#pragma unroll
        for (int j = 0; j < 8; ++j) f[j] = sm[(k8 + j) * 65 + n];
        u32x4 o; o.x = cvt_pk_bf16(f[0], f[1]); o.y = cvt_pk_bf16(f[2], f[3]); o.z = cvt_pk_bf16(f[4], f[5]); o.w = cvt_pk_bf16(f[6], f[7]);
        *(u32x4*)(dst + (size_t)(n0 + n) * K + k0 + k8) = o;
    }
    __syncthreads();
}

__device__ __forceinline__ void norm_phase(const float* lat, const float* ctxp, const bf16_t* dbuf, const bf16_t* dpart, float* xout, int nrows, const float* gw, const float* mod, int shift_off, int scale_off, bf16_t* outb, float* outf) {
    const int wid = threadIdx.x >> 6, lane = threadIdx.x & 63;
    const int nw = gridDim.x * 8, gwv = blockIdx.x * 8 + wid, per = (nrows + nw - 1) / nw;
    const int rb = gwv * per, re = (rb + per < nrows) ? rb + per : nrows;
    if (rb >= re) return;
    int cur_b = -1;
    f32x4 ca[8], cb[8], v[8]; u32x2 dv[8];
    { const float* src = rb < ML ? lat + (size_t)rb * D : ctxp + (size_t)(rb - ML) * D;
#pragma unroll
      for (int i = 0; i < 8; ++i) { v[i] = __builtin_nontemporal_load((const f32x4*)(src + i * 256 + lane * 4)); dv[i] = (u32x2){0u, 0u}; if (dbuf && !dpart) dv[i] = *(const u32x2*)(dbuf + (size_t)rb * D + i * 256 + lane * 4); } }
    for (int row = rb; row < re; ++row) {
        const int b = row < ML ? (row >> 12) : 8;
        if (b != cur_b) {
            cur_b = b;
#pragma unroll
            for (int i = 0; i < 8; ++i) { const int col = i * 256 + lane * 4; ca[i] = *(const f32x4*)(gw + col); cb[i] = (f32x4){0.f, 0.f, 0.f, 0.f};
                if (mod) { const f32x4 sc = *(const f32x4*)(mod + (size_t)b * NMODC + scale_off + col); cb[i] = *(const f32x4*)(mod + (size_t)b * NMODC + shift_off + col); ca[i] = ca[i] * (sc + 1.f); } }
        }
        f32x4 nv[8]; u32x2 nd[8];
        if (row + 1 < re) { const int r1 = row + 1; const float* src = r1 < ML ? lat + (size_t)r1 * D : ctxp + (size_t)(r1 - ML) * D;
#pragma unroll
            for (int i = 0; i < 8; ++i) { nv[i] = __builtin_nontemporal_load((const f32x4*)(src + i * 256 + lane * 4)); nd[i] = (u32x2){0u, 0u}; if (dbuf && !dpart) nd[i] = *(const u32x2*)(dbuf + (size_t)r1 * D + i * 256 + lane * 4); } }
        else {
#pragma unroll
            for (int i = 0; i < 8; ++i) { nv[i] = (f32x4){0.f, 0.f, 0.f, 0.f}; nd[i] = (u32x2){0u, 0u}; } }
        if (dpart && row < ML) {
#pragma unroll
            for (int i = 0; i < 8; ++i) { const u32x2 e = *(const u32x2*)(dbuf + (size_t)row * D + i * 256 + lane * 4);
                v[i][0] += bflo(e.x); v[i][1] += bfhi(e.x); v[i][2] += bflo(e.y); v[i][3] += bfhi(e.y); }
        }
        if (dpart && row >= ML) {
#pragma unroll
            for (int ks = 0; ks < 4; ++ks)
#pragma unroll
                for (int i = 0; i < 8; ++i) { const u32x2 e = *(const u32x2*)(dpart + (size_t)ks * MC * D + (size_t)(row - ML) * D + i * 256 + lane * 4);
                    v[i][0] += bflo(e.x); v[i][1] += bfhi(e.x); v[i][2] += bflo(e.y); v[i][3] += bfhi(e.y); if (i == 7) asm volatile("" ::: "memory"); }
        }
        float ss = 0.f;
#pragma unroll
        for (int i = 0; i < 8; ++i) {
            v[i][0] += bflo(dv[i].x); v[i][1] += bfhi(dv[i].x); v[i][2] += bflo(dv[i].y); v[i][3] += bfhi(dv[i].y);
            ss += v[i][0] * v[i][0] + v[i][1] * v[i][1] + v[i][2] * v[i][2] + v[i][3] * v[i][3]; }
        ss = wave_sum(ss);
        const float rstd = rsqrtf(ss * (1.f / 2048.f) + 1e-6f);
#pragma unroll
        for (int i = 0; i < 8; ++i) {
            const int col = i * 256 + lane * 4;
            if (xout && row < ML) __builtin_nontemporal_store(v[i], (f32x4*)(xout + (size_t)row * D + col));
            const f32x4 y = v[i] * rstd * ca[i] + cb[i];
            if (outb) { u32x2 o; o.x = cvt_pk_bf16(y[0], y[1]); o.y = cvt_pk_bf16(y[2], y[3]); *(u32x2*)(outb + (size_t)row * D + col) = o; }
            else __builtin_nontemporal_store(y, (f32x4*)(outf + (size_t)row * D + col));
        }
#pragma unroll
        for (int i = 0; i < 8; ++i) { v[i] = nv[i]; dv[i] = nd[i]; }
    }
}

__device__ __forceinline__ void conv_unit(const Params& p, int unit) {
    const int t = threadIdx.x, c8 = t & 31, t8 = t >> 5;
    const int ck = unit >> 3, cb = unit & 7;
    const int ch0 = cb * 256 + c8 * 8;
    const int row0 = ck * 128 + t8 * 8;
    const bool lat = ck < 256;
    const bf16_t* ZQK = (const bf16_t*)(p.ws + WS_ZQK);
    const bf16_t* V = (const bf16_t*)(p.ws + WS_V);
    bf16_t* Q = (bf16_t*)(p.ws + WS_Q); bf16_t* Kn = (bf16_t*)(p.ws + WS_K); bf16_t* KT = (bf16_t*)(p.ws + WS_KT); bf16_t* VT = (bf16_t*)(p.ws + WS_VT);
    if (cb < 4) {
        if (!lat && cb < 2) return;
        int seq_lo, seq_hi;
        if (lat) { seq_lo = (ck >> 5) * 4096; seq_hi = seq_lo + 4096; } else { seq_lo = ML + ((ck - 256) >> 1) * 256; seq_hi = seq_lo + 256; }
        u32x4 z[12];
#pragma unroll
        for (int i = 0; i < 12; ++i) { const int r = row0 - 2 + i; z[i] = (u32x4){0u, 0u, 0u, 0u}; if (r >= seq_lo && r < seq_hi) z[i] = *(const u32x4*)(ZQK + (size_t)r * 1024 + ch0); }
        const float* cw = p.in[11]; const float* cbias = p.in[12];
        float y[8][8];
#pragma unroll
        for (int c = 0; c < 8; ++c) {
            const float w0 = cw[0 * 1024 + ch0 + c], w1 = cw[1 * 1024 + ch0 + c], w2 = cw[2 * 1024 + ch0 + c], w3 = cw[3 * 1024 + ch0 + c], w4 = cw[4 * 1024 + ch0 + c], bb = cbias[ch0 + c];
#pragma unroll
            for (int r = 0; r < 8; ++r) {
                float a = bb + bfel(z[r], c) * w0 + bfel(z[r + 1], c) * w1 + bfel(z[r + 2], c) * w2 + bfel(z[r + 3], c) * w3 + bfel(z[r + 4], c) * w4;
                a = siluf_(a);
                y[r][c] = (cb < 2) ? a * 0.08838834764831845f : a;
            }
        }
        if (lat) {
            bf16_t* dn = (cb < 2) ? Q + (size_t)row0 * 512 + ch0 : Kn + (size_t)row0 * 512 + (ch0 - 512);
#pragma unroll
            for (int r = 0; r < 8; ++r) { u32x4 o; o.x = cvt_pk_bf16(y[r][0], y[r][1]); o.y = cvt_pk_bf16(y[r][2], y[r][3]); o.z = cvt_pk_bf16(y[r][4], y[r][5]); o.w = cvt_pk_bf16(y[r][6], y[r][7]);
                *(u32x4*)(dn + (size_t)r * 512) = o; }
        }
        if (cb >= 2) {
            const int kc = ch0 - 512, h = kc >> 7, dk = kc & 127;
            bf16_t* dt = KT + ((size_t)(ck * 4 + h) * 128 + dk) * 128 + t8 * 8;
#pragma unroll
            for (int c = 0; c < 8; ++c) { u32x4 o; o.x = cvt_pk_bf16(y[0][c], y[1][c]); o.y = cvt_pk_bf16(y[2][c], y[3][c]); o.z = cvt_pk_bf16(y[4][c], y[5][c]); o.w = cvt_pk_bf16(y[6][c], y[7][c]);
                *(u32x4*)(dt + (size_t)c * 128) = o; }
        }
    } else {
        const int vch = ch0 - 1024, h = vch >> 8, dv = vch & 255;
        u32x4 z[8];
#pragma unroll
        for (int r = 0; r < 8; ++r) z[r] = *(const u32x4*)(V + (size_t)(row0 + r) * 1024 + vch);
        bf16_t* dt = VT + ((size_t)(ck * 4 + h) * 256 + dv) * 128 + t8 * 8;
#pragma unroll
        for (int c = 0; c < 8; ++c) { u32x4 o;
            o.x = us16(z[0], c) | (us16(z[1], c) << 16); o.y = us16(z[2], c) | (us16(z[3], c) << 16); o.z = us16(z[4], c) | (us16(z[5], c) << 16); o.w = us16(z[6], c) | (us16(z[7], c) << 16);
            *(u32x4*)(dt + (size_t)c * 128) = o; }
    }
}

__device__ __forceinline__ void gmlp_unit(const Params& p, LAS unsigned char* lds, int unit) {
    LAS bf16_t* Wt = (LAS bf16_t*)lds;
    LAS bf16_t* vnT = (LAS bf16_t*)(lds + 34816);
    LAS float* rstd = (LAS float*)(lds + 69632);
    const int t = threadIdx.x, wid = t >> 6, lane = t & 63, fr = lane & 15, fq = lane >> 4;
    const int r0 = unit * 128;
    const bf16_t* U = (const bf16_t*)(p.ws + WS_U); const bf16_t* GV = (const bf16_t*)(p.ws + WS_GV); bf16_t* CAT = (bf16_t*)(p.ws + WS_CAT);
    for (int q = wid; q < 128; q += 8) {
        float ss = 0.f;
#pragma unroll
        for (int i = 0; i < 2; ++i) { const u32x4 v = *(const u32x4*)(GV + (size_t)(r0 + q) * 1024 + i * 512 + lane * 8);
#pragma unroll
            for (int c = 0; c < 8; ++c) { const float f = bfel(v, c); ss += f * f; } }
        ss = wave_sum(ss);
        if (lane == 0) rstd[q] = rsqrtf(ss * (1.f / 1024.f) + 1e-6f);
    }
    __syncthreads();
    for (int g = 0; g < 8; ++g) {
        const float* ws_ = p.in[17] + (size_t)g * 128 * 128;
#pragma unroll
        for (int i = 0; i < 8; ++i) { const int idx = t + 512 * i, pr = idx >> 5, q4 = (idx & 31) * 4; const f32x4 v = *(const f32x4*)(ws_ + pr * 128 + q4);
            u32x2 o; o.x = cvt_pk_bf16(v[0], v[1]); o.y = cvt_pk_bf16(v[2], v[3]); *(LAS u32x2*)(Wt + pr * 136 + q4) = o; }
        const float* gn = p.in[16] + g * 128;
#pragma unroll
        for (int i = 0; i < 4; ++i) { const int d8 = (t & 15) * 8, q = (t >> 4) + 32 * i; const u32x4 v = *(const u32x4*)(GV + (size_t)(r0 + q) * 1024 + g * 128 + d8); const float rs = rstd[q];
#pragma unroll
            for (int c = 0; c < 8; ++c) { const float f = bfel(v, c) * rs * gn[d8 + c]; vnT[(d8 + c) * 136 + q] = (bf16_t)(cvt_pk_bf16(f, 0.f) & 0xffffu); } }
        __syncthreads();
        f32x4 acc[8];
#pragma unroll
        for (int nb = 0; nb < 8; ++nb) acc[nb] = (f32x4){0.f, 0.f, 0.f, 0.f};
#pragma unroll
        for (int kk = 0; kk < 4; ++kk) { const bf16x8 a = *(const LAS bf16x8*)(Wt + (16 * wid + fr) * 136 + kk * 32 + fq * 8);
#pragma unroll
            for (int nb = 0; nb < 8; ++nb) { const bf16x8 bv = *(const LAS bf16x8*)(vnT + (nb * 16 + fr) * 136 + kk * 32 + fq * 8);
                acc[nb] = __builtin_amdgcn_mfma_f32_16x16x32_bf16(bv, a, acc[nb], 0, 0, 0); } }
        const int pp = 16 * wid + fr; const float bs = p.in[18][g * 128 + pp];
#pragma unroll
        for (int nb = 0; nb < 8; ++nb) { const int d = nb * 16 + fq * 4; const u32x2 uu = *(const u32x2*)(U + (size_t)(r0 + pp) * 1024 + g * 128 + d);
            u32x2 o; o.x = cvt_pk_bf16(bflo(uu.x) * (acc[nb][0] + bs), bfhi(uu.x) * (acc[nb][1] + bs)); o.y = cvt_pk_bf16(bflo(uu.y) * (acc[nb][2] + bs), bfhi(uu.y) * (acc[nb][3] + bs));
            *(u32x2*)(CAT + (size_t)(r0 + pp) * 2048 + 1024 + g * 128 + d) = o; }
        __syncthreads();
    }
}

__device__ __forceinline__ int scan_chunk(int s, int dir, int b) { if (s < 2) return 256 + 2 * b + (dir ? 1 - s : s); const int li = s - 2; return 32 * b + (dir ? 31 - li : li); }

__device__ __forceinline__ void scan_issue(const Params& p, int s, int dir, int b, int h, int slice, u32x4 (&kreg)[4], u32x4 (&vreg)[2]) {
    const int t = threadIdx.x;
    const int ck = scan_chunk(s, dir, b);
    const bf16_t* kt = (const bf16_t*)(p.ws + WS_KT) + (size_t)(ck * 4 + h) * 128 * 128;
#pragma unroll
    for (int i = 0; i < 4; ++i) { const int idx = t + 512 * i; kreg[i] = *(const u32x4*)(kt + (idx >> 4) * 128 + (idx & 15) * 8); }
    const bf16_t* vt = (const bf16_t*)(p.ws + WS_VT) + ((size_t)(ck * 4 + h) * 256 + slice * 64) * 128;
#pragma unroll
    for (int i = 0; i < 2; ++i) { const int idx = t + 512 * i; vreg[i] = *(const u32x4*)(vt + (idx >> 4) * 128 + (idx & 15) * 8); }
}

__device__ __forceinline__ void scan_phase(const Params& p, LAS unsigned char* lds) {
    LAS float* wls = (LAS float*)(lds + 113152);
    LAS float* scs = (LAS float*)(lds + 113152 + 17408);
    const int t = threadIdx.x, wid = t >> 6, lane = t & 63, fr = lane & 15, fq = lane >> 4;
    bf16_t* CP = (bf16_t*)(p.ws + WS_XN); float* MP = (float*)(p.ws + WS_MPREV);
    const float* G = (const float*)(p.ws + WS_G);
    for (int u = blockIdx.x; u < 256; u += gridDim.x) {
        const int chain = u >> 2, slice = u & 3, dir = chain & 1, bh = chain >> 1, h = bh & 3, b = bh >> 2;
        u32x4 kreg[4], vreg[2];
        scan_issue(p, 0, dir, b, h, slice, kreg, vreg);
        for (int s = wid; s < 34; s += 8) {
            const int ck = scan_chunk(s, dir, b);
            const int p0 = 2 * lane, t0 = dir ? 127 - p0 : p0, t1 = dir ? 126 - p0 : p0 + 1;
            const float* g = G + (size_t)ck * 128 * 16 + dir * 8 + h;
            const float gi0 = g[t0 * 16], gi1 = g[t1 * 16], gf0 = g[t0 * 16 + 4], gf1 = g[t1 * 16 + 4];
            const float P = wave_scan_sum(gf0 + gf1, lane);
            const float total = __shfl(P, 63);
            const float g0 = total - (P - gf1) + gi0, g1 = total - P + gi1;
            const float mloc = wave_max(fmaxf(g0, g1));
            wls[s * 128 + t0] = g0; wls[s * 128 + t1] = g1;
            if (lane == 0) { scs[s * 4 + 2] = total; scs[s * 4 + 3] = mloc; }
        }
        __syncthreads();
        if (t == 0) {
            float m = 0.f;
            for (int s = 0; s < 34; ++s) { const float total = scs[s * 4 + 2], mloc = scs[s * 4 + 3]; const float m_new = fmaxf(total + m, mloc);
                scs[s * 4 + 0] = __expf(total + m - m_new); scs[s * 4 + 1] = m; scs[s * 4 + 2] = m_new; m = m_new; }
        }
        __syncthreads();
        for (int idx = t; idx < 34 * 128; idx += 512) wls[idx] = __expf(wls[idx] - scs[(idx >> 7) * 4 + 2]);
        __syncthreads();
        f32x4 st[5];
#pragma unroll
        for (int nb = 0; nb < 5; ++nb) st[nb] = (f32x4){0.f, 0.f, 0.f, 0.f};
        for (int s = 0; s < 34; ++s) {
            LAS bf16_t* kT = (LAS bf16_t*)(lds + (s & 1) * 56576);
            LAS bf16_t* wvT = (LAS bf16_t*)(lds + (s & 1) * 56576 + 34816);
            LAS float* wb = wls + s * 128;
#pragma unroll
            for (int i = 0; i < 4; ++i) { const int idx = t + 512 * i; *(LAS u32x4*)(kT + (idx >> 4) * 136 + (idx & 15) * 8) = kreg[i]; }
#pragma unroll
            for (int i = 0; i < 2; ++i) { const int idx = t + 512 * i, r = idx >> 4, c8 = (idx & 15) * 8;
                const f32x4 w0 = *(const LAS f32x4*)(wb + c8), w1 = *(const LAS f32x4*)(wb + c8 + 4);
                u32x4 o; o.x = cvt_pk_bf16(bflo(vreg[i].x) * w0[0], bfhi(vreg[i].x) * w0[1]); o.y = cvt_pk_bf16(bflo(vreg[i].y) * w0[2], bfhi(vreg[i].y) * w0[3]);
                o.z = cvt_pk_bf16(bflo(vreg[i].z) * w1[0], bfhi(vreg[i].z) * w1[1]); o.w = cvt_pk_bf16(bflo(vreg[i].w) * w1[2], bfhi(vreg[i].w) * w1[3]);
                *(LAS u32x4*)(wvT + r * 136 + c8) = o; }
            if (t < 256) { const int r = 64 + (t >> 4), c8 = (t & 15) * 8; u32x4 o = (u32x4){0u, 0u, 0u, 0u};
                if (r == 64) { const f32x4 w0 = *(const LAS f32x4*)(wb + c8), w1 = *(const LAS f32x4*)(wb + c8 + 4);
                    o.x = cvt_pk_bf16(w0[0], w0[1]); o.y = cvt_pk_bf16(w0[2], w0[3]); o.z = cvt_pk_bf16(w1[0], w1[1]); o.w = cvt_pk_bf16(w1[2], w1[3]); }
                *(LAS u32x4*)(wvT + r * 136 + c8) = o; }
            const int ck = scan_chunk(s, dir, b);
            if (s + 1 < 34) scan_issue(p, s + 1, dir, b, h, slice, kreg, vreg);
            __syncthreads();
            const float decay = scs[s * 4];
            if (s >= 2) {
                const int cc = ck - 32 * b;
                bf16_t* cp = CP + (size_t)(chain * 32 + cc) * (272 * 128);
                const int col = 16 * wid + 4 * fq;
#pragma unroll
                for (int nb = 0; nb < 4; ++nb) { u32x2 o; o.x = cvt_pk_bf16(st[nb][0], st[nb][1]); o.y = cvt_pk_bf16(st[nb][2], st[nb][3]); *(u32x2*)(cp + (size_t)(slice * 64 + nb * 16 + fr) * 128 + col) = o; }
                if (slice == 0) { u32x2 o; o.x = cvt_pk_bf16(st[4][0], st[4][1]); o.y = cvt_pk_bf16(st[4][2], st[4][3]); *(u32x2*)(cp + (size_t)(256 + fr) * 128 + col) = o;
                    if (t == 0) MP[chain * 32 + cc] = scs[s * 4 + 1]; }
            }
            f32x4 acc[5];
#pragma unroll
            for (int nb = 0; nb < 5; ++nb) acc[nb] = (f32x4){0.f, 0.f, 0.f, 0.f};
#pragma unroll
            for (int kk = 0; kk < 4; ++kk) { const bf16x8 a = *(const LAS bf16x8*)(kT + (16 * wid + fr) * 136 + kk * 32 + fq * 8);
#pragma unroll
                for (int nb = 0; nb < 5; ++nb) { const bf16x8 bv = *(const LAS bf16x8*)(wvT + (nb * 16 + fr) * 136 + kk * 32 + fq * 8);
                    acc[nb] = __builtin_amdgcn_mfma_f32_16x16x32_bf16(a, bv, acc[nb], 0, 0, 0); } }
#pragma unroll
            for (int nb = 0; nb < 5; ++nb) st[nb] = st[nb] * decay + acc[nb];
        }
        __syncthreads();
    }
}

__device__ __forceinline__ void mout_issue(const Params& p, int u, u32x4 (&kreg)[4], bf16x8 (&qf)[4], float (&gg)[5]) {
    const int t = threadIdx.x, wid = t >> 6, lane = t & 63, fr = lane & 15, fq = lane >> 4;
    const int dir = u & 1, cc = (u >> 1) & 31, bh = u >> 6, h = bh & 3, b = bh >> 2, chain = bh * 2 + dir, ck = 32 * b + cc, r0 = ck * 128;
    const bf16_t* Q = (const bf16_t*)(p.ws + WS_Q); const bf16_t* Kn = (const bf16_t*)(p.ws + WS_K);
#pragma unroll
    for (int i = 0; i < 4; ++i) { const int idx = t + 512 * i, r = idx >> 4, c8 = (idx & 15) * 8; kreg[i] = *(const u32x4*)(Kn + (size_t)(r0 + r) * 512 + h * 128 + c8); }
#pragma unroll
    for (int kk = 0; kk < 4; ++kk) qf[kk] = *(const bf16x8*)(Q + (size_t)(r0 + 16 * wid + fr) * 512 + h * 128 + kk * 32 + fq * 8);
    if (wid == 0) {
        const int p0 = 2 * lane, t0 = dir ? 127 - p0 : p0, t1 = dir ? 126 - p0 : p0 + 1;
        const float* g = (const float*)(p.ws + WS_G) + (size_t)r0 * 16 + dir * 8 + h;
        gg[0] = g[t0 * 16]; gg[1] = g[t1 * 16]; gg[2] = g[t0 * 16 + 4]; gg[3] = g[t1 * 16 + 4];
        gg[4] = ((const float*)(p.ws + WS_MPREV))[chain * 32 + cc];
    }
}

__device__ __forceinline__ void mout_phase(const Params& p, LAS unsigned char* lds) {
    LAS bf16_t* T = (LAS bf16_t*)lds;
    LAS bf16_t* sb = (LAS bf16_t*)(lds + 73984);
    LAS float* fv = (LAS float*)(lds + 73984 + 34816);
    const int t = threadIdx.x, wid = t >> 6, lane = t & 63, fr = lane & 15, fq = lane >> 4;
    const bf16_t* CP = (const bf16_t*)(p.ws + WS_XN);
    const bf16_t* VT = (const bf16_t*)(p.ws + WS_VT);
    u32x4 kreg[4]; bf16x8 qf[4]; float gg[5] = {0.f, 0.f, 0.f, 0.f, 0.f};
    int u = 2 * blockIdx.x;
    if (u < 2048) mout_issue(p, u, kreg, qf, gg);
    for (; u < 2048; u = (u & 1) ? u - 1 + 2 * (int)gridDim.x : u + 1) {
        const int dir = u & 1, cc = (u >> 1) & 31, bh = u >> 6, h = bh & 3, b = bh >> 2, chain = bh * 2 + dir, ck = 32 * b + cc, r0 = ck * 128;
        if (wid == 0) {
            const int p0 = 2 * lane, t0 = dir ? 127 - p0 : p0, t1 = dir ? 126 - p0 : p0 + 1;
            const float gi0 = gg[0], gi1 = gg[1], gf0 = gg[2], gf1 = gg[3], mst = gg[4];
            const float P = wave_scan_sum(gf0 + gf1, lane);
            const float b1 = P, b0 = P - gf1;
            const float c0 = gi0 - b0, c1 = gi1 - b1;
            const float Mi = wave_scan_max(fmaxf(c0, c1), lane);
            float Me = __shfl_up(Mi, 1); if (lane == 0) Me = -INFINITY;
            const float pm0 = fmaxf(Me, c0), pm1 = Mi;
            const float mt0 = fmaxf(b0 + mst, b0 + pm0), mt1 = fmaxf(b1 + mst, b1 + pm1);
            fv[t0] = b0 - mt0; fv[t1] = b1 - mt1;
            fv[128 + t0] = c0; fv[128 + t1] = c1;
            fv[256 + t0] = __expf(b0 + mst - mt0); fv[256 + t1] = __expf(b1 + mst - mt1);
            fv[384 + t0] = __expf(-mt0); fv[384 + t1] = __expf(-mt1);
        }
#pragma unroll
        for (int i = 0; i < 4; ++i) { const int idx = t + 512 * i, r = idx >> 4, c8 = (idx & 15) * 8; *(LAS u32x4*)(T + r * 136 + c8) = kreg[i]; }
        u32x4 creg[9];
        { const bf16_t* cp = CP + (size_t)(chain * 32 + cc) * (272 * 128);
#pragma unroll
          for (int i = 0; i < 9; ++i) { const int idx = t + 512 * i; creg[i] = (u32x4){0u, 0u, 0u, 0u}; if (idx < 272 * 16) creg[i] = *(const u32x4*)(cp + (size_t)(idx >> 4) * 128 + (idx & 15) * 8); } }
        __syncthreads();
        const int j = 16 * wid + fr;
        {
            f32x4 S[8];
#pragma unroll
            for (int nb = 0; nb < 8; ++nb) S[nb] = (f32x4){0.f, 0.f, 0.f, 0.f};
#pragma unroll
            for (int kk = 0; kk < 4; ++kk)
#pragma unroll
                for (int nb = 0; nb < 8; ++nb) { const bf16x8 kf = *(const LAS bf16x8*)(T + (nb * 16 + fr) * 136 + kk * 32 + fq * 8);
                    S[nb] = __builtin_amdgcn_mfma_f32_16x16x32_bf16(kf, qf[kk], S[nb], 0, 0, 0); }
            const float rb = fv[j];
#pragma unroll
            for (int nb = 0; nb < 8; ++nb) { const int l0 = nb * 16 + 4 * fq; const f32x4 cw = *(const LAS f32x4*)(fv + 128 + l0);
                float sv[4];
#pragma unroll
                for (int i = 0; i < 4; ++i) { const int l = l0 + i; const bool valid = dir ? (l >= j) : (l <= j); sv[i] = valid ? S[nb][i] * __expf(rb + cw[i]) : 0.f; }
                u32x2 o; o.x = cvt_pk_bf16(sv[0], sv[1]); o.y = cvt_pk_bf16(sv[2], sv[3]); *(LAS u32x2*)(sb + j * 136 + l0) = o; }
        }
        __syncthreads();
#pragma unroll
        for (int i = 0; i < 9; ++i) { const int idx = t + 512 * i; if (idx < 272 * 16) *(LAS u32x4*)(T + (idx >> 4) * 136 + (idx & 15) * 8) = creg[i]; }
        u32x4 vreg[8];
        { const bf16_t* vt = VT + (size_t)(ck * 4 + h) * 256 * 128;
#pragma unroll
          for (int i = 0; i < 8; ++i) { const int idx = t + 512 * i; vreg[i] = *(const u32x4*)(vt + (size_t)(idx >> 4) * 128 + (idx & 15) * 8); } }
        __syncthreads();
        f32x4 acc[17];
#pragma unroll
        for (int nb = 0; nb < 17; ++nb) acc[nb] = (f32x4){0.f, 0.f, 0.f, 0.f};
#pragma unroll
        for (int kk = 0; kk < 4; ++kk)
#pragma unroll
            for (int nb = 0; nb < 17; ++nb) { const bf16x8 cf = *(const LAS bf16x8*)(T + (nb * 16 + fr) * 136 + kk * 32 + fq * 8);
                acc[nb] = __builtin_amdgcn_mfma_f32_16x16x32_bf16(cf, qf[kk], acc[nb], 0, 0, 0); }
        { const float aj = fv[256 + j];
#pragma unroll
          for (int nb = 0; nb < 17; ++nb) acc[nb] = acc[nb] * aj; }
        __syncthreads();
#pragma unroll
        for (int i = 0; i < 8; ++i) { const int idx = t + 512 * i; *(LAS u32x4*)(T + (idx >> 4) * 136 + (idx & 15) * 8) = vreg[i]; }
        if (t < 256) { const int r = 256 + (t >> 4), c8 = (t & 15) * 8; const unsigned one = (r == 256) ? 0x3F803F80u : 0u; *(LAS u32x4*)(T + r * 136 + c8) = (u32x4){one, one, one, one}; }
        const float einv = fv[384 + j];
        { const int un = (u & 1) ? u - 1 + 2 * (int)gridDim.x : u + 1; if (un < 2048) mout_issue(p, un, kreg, qf, gg); }
        __syncthreads();
#pragma unroll
        for (int kk = 0; kk < 4; ++kk) { const bf16x8 sf = *(const LAS bf16x8*)(sb + j * 136 + kk * 32 + fq * 8);
#pragma unroll
            for (int nb = 0; nb < 17; ++nb) { const bf16x8 vf = *(const LAS bf16x8*)(T + (nb * 16 + fr) * 136 + kk * 32 + fq * 8);
                acc[nb] = __builtin_amdgcn_mfma_f32_16x16x32_bf16(vf, sf, acc[nb], 0, 0, 0); } }
        const float nq = __shfl(acc[16][0], fr);
        const float inv = 1.f / fmaxf(fabsf(nq), einv);
        bf16_t* hd = (bf16_t*)(p.ws + WS_HDIR) + (size_t)(r0 + j) * 1024 + h * 256;
        if (dir == 0) {
#pragma unroll
            for (int nb = 0; nb < 16; ++nb) { u32x2 o; o.x = cvt_pk_bf16(acc[nb][0] * inv, acc[nb][1] * inv); o.y = cvt_pk_bf16(acc[nb][2] * inv, acc[nb][3] * inv); *(u32x2*)(hd + nb * 16 + 4 * fq) = o; }
        } else {
            float ss = 0.f;
#pragma unroll
            for (int nb = 0; nb < 16; ++nb) { const u32x2 hv = *(const u32x2*)(hd + nb * 16 + 4 * fq);
                acc[nb][0] = acc[nb][0] * inv + bflo(hv.x); acc[nb][1] = acc[nb][1] * inv + bfhi(hv.x); acc[nb][2] = acc[nb][2] * inv + bflo(hv.y); acc[nb][3] = acc[nb][3] * inv + bfhi(hv.y);
                ss += acc[nb][0] * acc[nb][0] + acc[nb][1] * acc[nb][1] + acc[nb][2] * acc[nb][2] + acc[nb][3] * acc[nb][3]; }
            ss += __shfl_xor(ss, 16); ss += __shfl_xor(ss, 32);
            const float rstd = rsqrtf(ss * (1.f / 256.f) + 1e-6f);
            const float* ng = p.in[15] + h * 256;
            const bf16_t* og = (const bf16_t*)(p.ws + WS_O) + (size_t)(r0 + j) * 1024 + h * 256;
            bf16_t* cat = (bf16_t*)(p.ws + WS_CAT) + (size_t)(r0 + j) * 2048 + h * 256;
#pragma unroll
            for (int nb = 0; nb < 16; ++nb) { const int dv = nb * 16 + 4 * fq; const f32x4 gn = *(const f32x4*)(ng + dv); const u32x2 ov = *(const u32x2*)(og + dv);
                u32x2 o; o.x = cvt_pk_bf16(acc[nb][0] * rstd * gn[0] * bflo(ov.x), acc[nb][1] * rstd * gn[1] * bfhi(ov.x));
                o.y = cvt_pk_bf16(acc[nb][2] * rstd * gn[2] * bflo(ov.y), acc[nb][3] * rstd * gn[3] * bfhi(ov.y));
                *(u32x2*)(cat + dv) = o;
                if ((nb & 3) == 3) asm volatile("" ::: "memory"); }
        }
        __syncthreads();
    }
}

__device__ __forceinline__ void finish_phase(const Params& p) {
    const int wid = threadIdx.x >> 6, lane = threadIdx.x & 63;
    const bf16_t* HD = (const bf16_t*)(p.ws + WS_HDIR); const bf16_t* O = (const bf16_t*)(p.ws + WS_O); bf16_t* CAT = (bf16_t*)(p.ws + WS_CAT);
    const float* ng = p.in[15];
    for (int row = blockIdx.x * 8 + wid; row < ML; row += gridDim.x * 8) {
        const int e0 = lane * 16;
        float hs[16]; float ss = 0.f;
#pragma unroll
        for (int i = 0; i < 2; ++i) { const u32x4 a = *(const u32x4*)(HD + (size_t)row * 1024 + e0 + i * 8), bq = *(const u32x4*)(HD + (size_t)ML * 1024 + (size_t)row * 1024 + e0 + i * 8);
#pragma unroll
            for (int c = 0; c < 8; ++c) { const float f = bfel(a, c) + bfel(bq, c); hs[i * 8 + c] = f; ss += f * f; } }
        ss += __shfl_xor(ss, 1); ss += __shfl_xor(ss, 2); ss += __shfl_xor(ss, 4); ss += __shfl_xor(ss, 8);
        const float rstd = rsqrtf(ss * (1.f / 256.f) + 1e-6f);
#pragma unroll
        for (int i = 0; i < 2; ++i) { const u32x4 ov = *(const u32x4*)(O + (size_t)row * 1024 + e0 + i * 8);
            float y[8];
#pragma unroll
            for (int c = 0; c < 8; ++c) y[c] = hs[i * 8 + c] * rstd * ng[e0 + i * 8 + c] * bfel(ov, c);
            u32x4 o; o.x = cvt_pk_bf16(y[0], y[1]); o.y = cvt_pk_bf16(y[2], y[3]); o.z = cvt_pk_bf16(y[4], y[5]); o.w = cvt_pk_bf16(y[6], y[7]);
            *(u32x4*)(CAT + (size_t)row * 2048 + e0 + i * 8) = o; }
    }
}

template <int ph> __device__ __forceinline__ void run_phase(const Params& p, LAS unsigned char* lds) {
    unsigned char* ws = p.ws;
    const float* mod = (const float*)(ws + WS_MOD);
    bf16_t* const XN = (bf16_t*)(ws + WS_XN); bf16_t* const Hb = (bf16_t*)(ws + WS_H);
    if (ph == 0) { for (int u = blockIdx.x; u < 288 + 10304; u += gridDim.x) { if (u < 288) adaln_unit(p, (LAS float*)lds, u); else wtile_unit(p, (LAS float*)lds, u - 288); } }
    else if (ph == 1) norm_phase(p.in[0], p.in[2], nullptr, nullptr, nullptr, M1, p.in[6], mod, 0 * D, 1 * D, XN, nullptr);
    else if (ph == 2) gemm_phase(lds, p, XN, (const bf16_t*)(ws + WS_WF1IN), M1, 2 * DFF, D, EPI_SWIGLU, 1, Hb, 0, 0.f);
    else if (ph == 3) gemm_phase(lds, p, Hb, (const bf16_t*)(ws + WS_WF1OUT), M1, D, DFF, EPI_RESID, 1, XN, 2 * D, 0.5f);
    else if (ph == 4) norm_phase(p.in[0], p.in[2], XN, (const bf16_t*)(ws + WS_CAT), p.out, M1, p.in[9], mod, 3 * D, 4 * D, XN, nullptr);
    else if (ph == 5) gemm_phase(lds, p, XN, (const bf16_t*)(ws + WS_WIN), M1, INP, D, EPI_INPROJ, 1, Hb, 0, 0.f);
    else if (ph == 6) { for (int u = blockIdx.x; u < 256 + 2176; u += gridDim.x) { if (u < 256) gmlp_unit(p, lds, u); else conv_unit(p, u - 256); } }
    else if (ph == 7) scan_phase(p, lds);
    else if (ph == 8) mout_phase(p, lds);
    else if (ph == 9) { }
    else if (ph == 10) gemm_phase(lds, p, (const bf16_t*)(ws + WS_CAT), (const bf16_t*)(ws + WS_WOUT), ML, D, D, EPI_RESID, 1, XN, 5 * D, 1.0f);
    else if (ph == 11) norm_phase(p.out, p.out, XN, nullptr, p.out, ML, p.in[20], mod, 6 * D, 7 * D, XN, nullptr);
    else if (ph == 12) gemm_phase(lds, p, XN, (const bf16_t*)(ws + WS_WF2IN), ML, 2 * DFF, D, EPI_SWIGLU, 1, Hb, 0, 0.f);
    else if (ph == 13) gemm_phase(lds, p, Hb, (const bf16_t*)(ws + WS_WF2OUT), ML, D, DFF, EPI_RESID, 1, XN, 8 * D, 0.5f);
    else if (ph == 14) norm_phase(p.out, p.out, XN, nullptr, nullptr, ML, p.in[23], nullptr, 0, 0, nullptr, p.out);
}

#define RUNPH(n) if (p.ph_lo <= n && n < p.ph_hi) { run_phase<n>(p, lds); if (n + 1 < p.ph_hi) xcd_barrier(xb); }
__global__ void __launch_bounds__(512, 2) hymba_megakernel(Params p) {
    extern __shared__ __attribute__((aligned(16))) unsigned char shm[];
    LAS unsigned char* lds = (LAS unsigned char*)shm;
    cg::grid_group grid = cg::this_grid();
    unsigned* barw = (unsigned*)(p.ws + WS_BAR);
    volatile LAS unsigned* stw = (volatile LAS unsigned*)(lds + LDS_BYTES - 16);
    if (blockIdx.x == 0) for (int i = threadIdx.x; i < XCD_BAR_WORDS; i += 512) barw[i] = 0u;
    run_phase<0>(p, lds);
    grid.sync();
    if (threadIdx.x == 0) { stw[0] = 0u; stw[1] = 0u; }
    __syncthreads();
    XcdBarrier xb = xcd_barrier_post(barw, stw);
    RUNPH(1) RUNPH(2) RUNPH(3) RUNPH(4) RUNPH(5) RUNPH(6) RUNPH(7) RUNPH(8) RUNPH(10) RUNPH(11) RUNPH(12) RUNPH(13) RUNPH(14)
}

extern "C" void kernel_launch(void* const* d_in, const int* in_sizes, int n_in, void* d_out, int out_size, void* d_ws, size_t ws_size, hipStream_t stream) {
    static int grid = 0;
    if (grid == 0) {
        if (n_in != 24 || out_size != ML * D || ws_size < WS_END) { fprintf(stderr, "kernel_launch: unexpected shapes (n_in %d out %d ws %zu need %zu)\n", n_in, out_size, ws_size, (size_t)WS_END); grid = -1; return; }
        int dev = 0, cus = 0, per_cu = 0;
        hipGetDevice(&dev);
        hipDeviceGetAttribute(&cus, hipDeviceAttributeMultiprocessorCount, dev);
        if (hipFuncSetAttribute((const void*)hymba_megakernel, hipFuncAttributeMaxDynamicSharedMemorySize, LDS_BYTES) != hipSuccess) { fprintf(stderr, "kernel_launch: hipFuncSetAttribute failed\n"); }
        if (hipOccupancyMaxActiveBlocksPerMultiprocessor(&per_cu, (const void*)hymba_megakernel, 512, LDS_BYTES) != hipSuccess || per_cu < 1) per_cu = 1;
        (void)hipGetLastError();
        grid = cus * per_cu;
        fprintf(stderr, "kernel_launch: cus %d per_cu %d grid %d\n", cus, per_cu, grid);
    }
    if (grid < 0) return;
    Params p{};
    for (int i = 0; i < 24; ++i) p.in[i] = (const float*)d_in[i];
    p.out = (float*)d_out; p.ws = (unsigned char*)d_ws;
#if MK_MULTI
    for (int ph = 0; ph < NPH; ++ph) { p.ph_lo = ph; p.ph_hi = ph + 1; hipLaunchKernelGGL(hymba_megakernel, dim3(grid), dim3(512), LDS_BYTES, stream, p); }
#else
    p.ph_lo = 0; p.ph_hi = NPH;
    void* args[] = {&p};
    hipError_t e = hipLaunchCooperativeKernel((const void*)hymba_megakernel, dim3(grid), dim3(512), args, LDS_BYTES, stream);
    if (e != hipSuccess) fprintf(stderr, "cooperative launch failed: %s (grid %d)\n", hipGetErrorString(e), grid);
#endif
}
```

```cpp
#include <hip/hip_runtime.h>
#include <hip/hip_cooperative_groups.h>
#include <cstdio>
namespace cg = cooperative_groups;

#ifndef MK_MULTI
#define MK_MULTI 0
#endif

#ifndef PHSEL
#define PHSEL 0xffff
#endif
#define PHON(n) ((PHSEL >> (n)) & 1)
#define LAS __attribute__((address_space(3)))
typedef unsigned short bf16_t;
typedef short bf16x8 __attribute__((ext_vector_type(8)));
typedef float f32x4 __attribute__((ext_vector_type(4)));
typedef unsigned u32x4 __attribute__((ext_vector_type(4)));
typedef unsigned u32x2 __attribute__((ext_vector_type(2)));

constexpr int D = 2048, ML = 32768, MC = 2048, M1 = ML + MC, DFF = 5632, NMODC = 9 * 2048, INP = 5376;
constexpr int NPH = 15;
constexpr int LDS_BYTES = 147456;

constexpr size_t al256(size_t x) { return (x + 255) & ~(size_t)255; }
constexpr size_t WS_WF1IN = 0;
constexpr size_t WS_WF1OUT = WS_WF1IN + (size_t)11264 * 2048 * 2;
constexpr size_t WS_WIN = WS_WF1OUT + (size_t)2048 * 5632 * 2;
constexpr size_t WS_WOUT = WS_WIN + (size_t)INP * 2048 * 2;
constexpr size_t WS_WF2IN = WS_WOUT + (size_t)2048 * 2048 * 2;
constexpr size_t WS_WF2OUT = WS_WF2IN + (size_t)11264 * 2048 * 2;
constexpr size_t WS_MOD = WS_WF2OUT + (size_t)2048 * 5632 * 2;
constexpr size_t WS_XN = al256(WS_MOD + (size_t)9 * NMODC * 4);
constexpr size_t WS_MPREV = WS_XN + (size_t)M1 * 2048 * 2;
constexpr size_t WS_H = al256(WS_MPREV + 64 * 32 * 4);
constexpr size_t WS_ZQK = WS_H;
constexpr size_t WS_V = WS_ZQK + (size_t)M1 * 1024 * 2;
constexpr size_t WS_O = WS_V + (size_t)M1 * 1024 * 2;
constexpr size_t WS_U = WS_O + (size_t)ML * 1024 * 2;
constexpr size_t WS_GV = WS_U + (size_t)ML * 1024 * 2;
constexpr size_t WS_HDIR = WS_U;
constexpr size_t WS_G = WS_GV + (size_t)ML * 1024 * 2;
constexpr size_t WS_Q = WS_G + (size_t)M1 * 16 * 4;
constexpr size_t WS_X1C = al256(WS_H + (size_t)M1 * DFF * 2);
constexpr size_t WS_CAT = WS_X1C + (size_t)MC * 2048 * 4;
constexpr size_t WS_K = WS_CAT + (size_t)ML * 2048 * 2;
constexpr size_t WS_KT = WS_K + (size_t)ML * 512 * 2;
constexpr size_t WS_VT = WS_KT + (size_t)272 * 4 * 128 * 128 * 2;
constexpr size_t WS_BAR = WS_VT + (size_t)272 * 4 * 256 * 128 * 2;
constexpr size_t WS_END = WS_BAR + 16384;
static_assert(WS_Q + (size_t)ML * 512 * 2 <= WS_X1C, "in-proj outputs overflow the H region");

struct Params {
    const float* in[24];
    float* out;
    unsigned char* ws;
    int ph_lo, ph_hi;
};

__device__ __forceinline__ unsigned cvt_pk_bf16(float lo, float hi) { unsigned r; asm volatile("v_cvt_pk_bf16_f32 %0, %1, %2" : "=v"(r) : "v"(lo), "v"(hi)); return r; }
__device__ __forceinline__ float bflo(unsigned u) { return __uint_as_float(u << 16); }
__device__ __forceinline__ float bfhi(unsigned u) { return __uint_as_float(u & 0xffff0000u); }
__device__ __forceinline__ float bfel(const u32x4& v, int c) { const unsigned w = (c >> 1) == 0 ? v.x : (c >> 1) == 1 ? v.y : (c >> 1) == 2 ? v.z : v.w; return (c & 1) ? bfhi(w) : bflo(w); }
__device__ __forceinline__ unsigned us16(const u32x4& v, int c) { const unsigned w = (c >> 1) == 0 ? v.x : (c >> 1) == 1 ? v.y : (c >> 1) == 2 ? v.z : v.w; return (c & 1) ? (w >> 16) : (w & 0xffffu); }
__device__ __forceinline__ float wave_sum(float v) {
#pragma unroll
    for (int o = 32; o; o >>= 1) v += __shfl_xor(v, o);
    return v; }
__device__ __forceinline__ float wave_max(float v) {
#pragma unroll
    for (int o = 32; o; o >>= 1) v = fmaxf(v, __shfl_xor(v, o));
    return v; }
__device__ __forceinline__ float wave_scan_sum(float v, int lane) {
#pragma unroll
    for (int o = 1; o < 64; o <<= 1) { const float t = __shfl_up(v, o); if (lane >= o) v += t; }
    return v; }
__device__ __forceinline__ float wave_scan_max(float v, int lane) {
#pragma unroll
    for (int o = 1; o < 64; o <<= 1) { const float t = __shfl_up(v, o); if (lane >= o) v = fmaxf(v, t); }
    return v; }
__device__ __forceinline__ float fexp2_(float x) { return __builtin_amdgcn_exp2f(x); }
__device__ __forceinline__ float sigmoidf_(float x) { return __builtin_amdgcn_rcpf(1.f + fexp2_(-1.4426950408889634f * x)); }
__device__ __forceinline__ float siluf_(float x) { return x * __builtin_amdgcn_rcpf(1.f + fexp2_(-1.4426950408889634f * x)); }
__device__ __forceinline__ float geluf_(float x) { const float y = x * (-2.3022082f + -0.1029432f * x * x); return x * __builtin_amdgcn_rcpf(1.f + fexp2_(y)); }

#define XB_TMO      128
#define XB_XCNT(j)  (256  + 64 * (j))
#define XB_XSUB(j)  (1280 + 64 * (j))
#define XB_XGEN(j)  (2304 + 64 * (j))
#define XB_TOP      3328
#define XB_TOPGEN   3392
#define XCD_BAR_WORDS 3456
#define XB_SPIN_CAP (1u << 22)
__device__ __forceinline__ unsigned xb_ld(unsigned* p)              { return __hip_atomic_load(p, __ATOMIC_RELAXED, __HIP_MEMORY_SCOPE_AGENT); }
__device__ __forceinline__ unsigned xb_add(unsigned* p, unsigned v) { return __hip_atomic_fetch_add(p, v, __ATOMIC_RELAXED, __HIP_MEMORY_SCOPE_AGENT); }
__device__ __forceinline__ unsigned xb_xcc_id() { return (unsigned)__builtin_amdgcn_s_getreg((3 << 11) | 20) & 0xFu; }
#define XB_SPIN(cond, bar) do { unsigned _sp = 0; while (cond) { __builtin_amdgcn_s_sleep(1); \
    if ((++_sp & 255u) == 0u) { if (xb_ld(&(bar)[XB_TMO])) break; if (_sp > XB_SPIN_CAP) { atomicAdd(&(bar)[XB_TMO], 1u); break; } } } } while (0)
struct XcdBarrier { unsigned* bar; unsigned x; volatile LAS unsigned* st; };
__device__ __forceinline__ XcdBarrier xcd_barrier_post(unsigned* bar, volatile LAS unsigned* st) {
    XcdBarrier b; b.bar = bar; b.x = xb_xcc_id(); b.st = st;
    if (threadIdx.x == 0) (void)xb_add(&bar[XB_XCNT(b.x)], 1u);
    return b;
}
__device__ __forceinline__ void xcd_barrier_complete(unsigned* bar, unsigned x, unsigned& nloc, unsigned& nx) {
    const unsigned G = gridDim.x * gridDim.y * gridDim.z;
    unsigned sum, cnt, mine, sp = 0u;
    for (;;) {
        sum = 0u; cnt = 0u; mine = 0u;
#pragma unroll
        for (unsigned j = 0; j < 16; ++j) { const unsigned c = xb_ld(&bar[XB_XCNT(j)]); sum += c; cnt += (c > 0u) ? 1u : 0u; mine = (j == x) ? c : mine; }
        if (sum == G) break;
        __builtin_amdgcn_s_sleep(1);
        if ((++sp & 255u) == 0u) { if (xb_ld(&bar[XB_TMO])) break; if (sp > XB_SPIN_CAP) { atomicAdd(&bar[XB_TMO], 1u); break; } }
    }
    nloc = mine > 0u ? mine : 1u; nx = cnt > 0u ? cnt : 1u;
}
__device__ __forceinline__ void xcd_barrier(const XcdBarrier& b) {
    asm volatile("s_waitcnt vmcnt(0)" ::: "memory");
    __syncthreads();
    if (threadIdx.x == 0) {
        unsigned* bar = b.bar;
        __builtin_amdgcn_s_waitcnt(0);
        unsigned nloc = b.st[0], nx = b.st[1];
        if (nloc == 0u) { xcd_barrier_complete(bar, b.x, nloc, nx); b.st[0] = nloc; b.st[1] = nx; }
        const unsigned old = xb_add(&bar[XB_XSUB(b.x)], 1u);
        const unsigned gen = old / nloc;
        if (old + 1u == (gen + 1u) * nloc) {
            __builtin_amdgcn_fence(__ATOMIC_RELEASE, "agent");
            asm volatile("s_waitcnt vmcnt(0)" ::: "memory");
            const unsigned og = xb_add(&bar[XB_TOP], 1u);
            const unsigned tg = og / nx;
            if (og + 1u == (tg + 1u) * nx) xb_add(&bar[XB_TOPGEN], 1u);
            else XB_SPIN(xb_ld(&bar[XB_TOPGEN]) == tg, bar);
            __builtin_amdgcn_fence(__ATOMIC_ACQUIRE, "agent");
            xb_add(&bar[XB_XGEN(b.x)], 1u);
            asm volatile("s_waitcnt vmcnt(0)" ::: "memory");
        } else {
            XB_SPIN(xb_ld(&bar[XB_XGEN(b.x)]) == gen, bar);
            __builtin_amdgcn_fence(__ATOMIC_ACQUIRE, "agent");
            asm volatile("s_waitcnt vmcnt(0)" ::: "memory");
        }
    }
    __syncthreads();
}

namespace pg8 {
constexpr int BM = 256, BK = 64, HALF = 128, HTB = HALF * BK * 2, NXCD = 8, WGM = 8;
__device__ __forceinline__ int lds_byte(int r, int c) { const int st = (r >> 4) * 2 + (c >> 5), rr = r & 15, cc = c & 31, ob = rr * 64 + cc * 2; return st * 1024 + (ob ^ (((ob >> 9) & 1) << 5)); }
__device__ __forceinline__ void stage_rc(int b, int& R, int& C) { const int st = b / 1024, sb = b % 1024, swz = sb ^ (((sb >> 9) & 1) << 5); R = (st >> 1) * 16 + swz / 64; C = (st & 1) * 32 + (swz % 64) / 2; }
__device__ __forceinline__ int perm32(int rho) { const int n = rho >> 4, i = rho & 15; return 8 * (i >> 2) + 4 * n + (i & 3); }
struct Unit { int pm, pn, ks; };
struct StaticOrder {
    int nM, nN, nwg, G, c;
    __device__ void init(int M, int N, int G_, int c_) { nM = M / BM; nN = N / BM; nwg = nM * nN; G = G_; c = c_; extra = 0; pre = 0; }
    int extra;
    int pre;
    __device__ bool next(int i, Unit& u) const {
        long L = (long)i * G + c; u.ks = -1;
        if (L < pre) { const int t = (int)L & 63; u.ks = (int)L >> 6; u.pm = nM + (t >> 3); u.pn = t & 7; return true; }
        L -= pre;
        if (L >= nwg + extra) return false;
        if (L >= nwg) { const int j = (int)(L - nwg); const int q = j >> 3; u.pm = nM + (j & 7); u.pn = q < 6 ? q + 2 : 20; return true; }
        int wgid = (int)L; { const int q = nwg / NXCD, r = nwg % NXCD, xcd = wgid % NXCD, off = wgid / NXCD; wgid = (xcd < r ? xcd * (q + 1) : r * (q + 1) + (xcd - r) * q) + off; }
        const int wgm = nN <= 8 ? 4 : WGM;
        const int nig = wgm * nN, gid = wgid / nig, fm = gid * wgm, gsz = (nM - fm) < wgm ? (nM - fm) : wgm;
        u.pm = fm + ((wgid % nig) % gsz); u.pn = (wgid % nig) / gsz; return true;
    }
};
}

enum { EPI_SWIGLU = 0, EPI_RESID = 1, EPI_INPROJ = 2 };
__device__ __forceinline__ void gemm_epilogue(const Params& p, const int epi, bf16_t* const Hp, const int goff, const float coef, const f32x4 (&acc)[2][2][4][2], const pg8::Unit& u, int wr, int wc, int fr, int fq) {
    if (epi == EPI_SWIGLU) {
        const int col0 = u.pn * 128 + wc * 32 + fq * 8;
#pragma unroll
        for (int ai = 0; ai < 2; ++ai)
#pragma unroll
            for (int m = 0; m < 4; ++m) {
                const int row = u.pm * 256 + ai * 128 + wr * 64 + m * 16 + fr;
                float h[8];
#pragma unroll
                for (int n = 0; n < 2; ++n)
#pragma unroll
                    for (int i = 0; i < 4; ++i) h[n * 4 + i] = siluf_(acc[ai][0][m][n][i]) * acc[ai][1][m][n][i];
                u32x4 o; o.x = cvt_pk_bf16(h[0], h[1]); o.y = cvt_pk_bf16(h[2], h[3]); o.z = cvt_pk_bf16(h[4], h[5]); o.w = cvt_pk_bf16(h[6], h[7]);
                *(u32x4*)(Hp + (size_t)row * DFF + col0) = o;
            }
    } else if (epi == EPI_RESID) {
        const bool lat = u.pm < 128;
        const int b = lat ? (u.pm >> 4) : 8;
        const float* gate = (const float*)(p.ws + WS_MOD) + (size_t)b * NMODC + goff;
#pragma unroll
        for (int bj = 0; bj < 2; ++bj) {
            const int col = u.pn * 256 + bj * 128 + wc * 32 + fq * 8;
            const f32x4 g0 = *(const f32x4*)(gate + col) * coef, g1 = *(const f32x4*)(gate + col + 4) * coef;
#pragma unroll
            for (int ai = 0; ai < 2; ++ai)
#pragma unroll
                for (int m = 0; m < 4; ++m) {
                    const int row = u.pm * 256 + ai * 128 + wr * 64 + m * 16 + fr;
                    const f32x4 v0 = acc[ai][bj][m][0] * g0, v1 = acc[ai][bj][m][1] * g1;
                    u32x4 o; o.x = cvt_pk_bf16(v0[0], v0[1]); o.y = cvt_pk_bf16(v0[2], v0[3]); o.z = cvt_pk_bf16(v1[0], v1[1]); o.w = cvt_pk_bf16(v1[2], v1[3]);
                    *(u32x4*)((u.ks >= 0 ? (bf16_t*)(p.ws + WS_CAT) + (size_t)u.ks * MC * D + (size_t)(row - ML) * D : Hp + (size_t)row * D) + col) = o;
                }
        }
    } else {
        const int seg = u.pn >> 2;
        const bool lat = u.pm < 128;
        if (seg < 5) {
            if (seg >= 2 && !lat) return;
            bf16_t* dst = (bf16_t*)(p.ws + (seg == 0 ? WS_ZQK : seg == 1 ? WS_V : seg == 2 ? WS_O : seg == 3 ? WS_U : WS_GV));
#pragma unroll
            for (int ai = 0; ai < 2; ++ai)
#pragma unroll
                for (int m = 0; m < 4; ++m) {
                    const int row = u.pm * 256 + ai * 128 + wr * 64 + m * 16 + fr;
#pragma unroll
                    for (int bj = 0; bj < 2; ++bj) {
                        const int cl = (u.pn & 3) * 256 + bj * 128 + wc * 32 + fq * 8;
                        float h[8];
#pragma unroll
                        for (int n = 0; n < 2; ++n)
#pragma unroll
                            for (int i = 0; i < 4; ++i) { const float a = acc[ai][bj][m][n][i]; h[n * 4 + i] = seg < 2 ? a : seg == 2 ? sigmoidf_(a) : geluf_(a); }
                        u32x4 o; o.x = cvt_pk_bf16(h[0], h[1]); o.y = cvt_pk_bf16(h[2], h[3]); o.z = cvt_pk_bf16(h[4], h[5]); o.w = cvt_pk_bf16(h[6], h[7]);
                        *(u32x4*)(dst + (size_t)row * 1024 + cl) = o;
                    }
                }
        } else if (wc == 0 && fq < 2) {
            const f32x4 bi = *(const f32x4*)(p.in[13] + fq * 4), bfv = *(const f32x4*)(p.in[14] + fq * 4);
#pragma unroll
            for (int ai = 0; ai < 2; ++ai)
#pragma unroll
                for (int m = 0; m < 4; ++m) {
                    const int row = u.pm * 256 + ai * 128 + wr * 64 + m * 16 + fr;
                    const f32x4 li = acc[ai][0][m][0] + bi;
                    const f32x4 xf = acc[ai][0][m][1] + bfv;
                    f32x4 lf;
#pragma unroll
                    for (int i = 0; i < 4; ++i) lf[i] = fminf(xf[i], 0.f) - log1pf(expf(-fabsf(xf[i])));
                    *(f32x4*)((float*)(p.ws + WS_G) + (size_t)row * 16 + fq * 8) = li;
                    *(f32x4*)((float*)(p.ws + WS_G) + (size_t)row * 16 + fq * 8 + 4) = lf;
                }
        }
    }
}

__device__ __forceinline__ void gemm_phase(LAS unsigned char* lds, const Params& p, const bf16_t* gA, const bf16_t* gBt, const int gM, const int gN, const int gK, const int epi, const int perm, bf16_t* const Hp, const int goff, const float coef) {
    using namespace pg8;
    const int tid = threadIdx.x, wid = __builtin_amdgcn_readfirstlane(tid >> 6), lane = tid & 63, wr = wid >> 2, wc = wid & 3, fr = lane & 15, fq = lane >> 4;
    const int K = gK, ntf = K / BK;
    const size_t ksl = (size_t)(K / 4) * 2;
    StaticOrder S; S.init(gM, gN, (int)gridDim.x, (int)blockIdx.x);
    if (epi == EPI_INPROJ) { S.init(ML, gN, (int)gridDim.x, (int)blockIdx.x); S.extra = 56; }
    if (epi == EPI_RESID && gM == M1) { S.init(ML, gN, (int)gridDim.x, (int)blockIdx.x); S.pre = 256; }
    unsigned voffA[2], voffB[2];
#pragma unroll
    for (int i = 0; i < 2; ++i) { int R, C; stage_rc(tid * 16 + i * 8192, R, C); const int Rb = perm ? ((R & ~31) + perm32(R & 31)) : R;
        voffA[i] = (unsigned)(R * K + C) * 2u; voffB[i] = (unsigned)(Rb * K + C) * 2u; }
    const size_t kstep = (size_t)(BK * 2);
    const size_t hstep = (size_t)HALF * K * 2;
    const size_t tstep = 2 * hstep;
    const unsigned ldsw = (unsigned)wid * 1024u;
    const int aoff = lds_byte(wr * 64 + fr, fq * 8), boff = lds_byte(wc * 32 + fr, fq * 8);
#define PG8_SA(b, h) (((b) * 2 + (h)) * HTB)
#define PG8_SB(b, h) ((4 + (b) * 2 + (h)) * HTB)
#define PG8_STAGE(bufoff, gbase, voff) do { _Pragma("unroll") for (int _i = 0; _i < 2; ++_i) \
        __builtin_amdgcn_global_load_lds((const unsigned*)((const char*)(gbase) + (voff)[_i]), (LAS unsigned*)(lds + (bufoff) + ldsw + _i * 8192), 16, 0, 0); } while (0)
#define PG8_LDA(dst, b, h) do { _Pragma("unroll") for (int m = 0; m < 4; ++m) _Pragma("unroll") for (int k = 0; k < 2; ++k) dst[m][k] = *(const LAS bf16x8*)(lds + PG8_SA(b, h) + aoff + m * 2048 + k * 1024); } while (0)
#define PG8_LDB(dst, b, h) do { _Pragma("unroll") for (int n = 0; n < 2; ++n) _Pragma("unroll") for (int k = 0; k < 2; ++k) dst[n][k] = *(const LAS bf16x8*)(lds + PG8_SB(b, h) + boff + n * 2048 + k * 1024); } while (0)
#define PG8_MMA(ai, bj, At, Bt) do { __builtin_amdgcn_s_setprio(1); _Pragma("unroll") for (int m = 0; m < 4; ++m) _Pragma("unroll") for (int n = 0; n < 2; ++n) _Pragma("unroll") for (int k = 0; k < 2; ++k) \
        acc[ai][bj][m][n] = __builtin_amdgcn_mfma_f32_16x16x32_bf16(Bt[n][k], At[m][k], acc[ai][bj][m][n], 0, 0, 0); __builtin_amdgcn_s_setprio(0); } while (0)
#define PG8_WAIT_V(n) asm volatile("s_waitcnt vmcnt(" #n ")" ::: "memory")
#define PG8_WAIT_L(n) asm volatile("s_waitcnt lgkmcnt(" #n ")" ::: "memory")
#define PG8_BAR __builtin_amdgcn_s_barrier()
#define PG8_SCHED __builtin_amdgcn_sched_barrier(0)
    Unit cur, nxt; int ui = 0;
    if (!S.next(0, cur)) return;
    f32x4 acc[2][2][4][2];
#pragma unroll
    for (int a = 0; a < 2; ++a)
#pragma unroll
        for (int b = 0; b < 2; ++b)
#pragma unroll
            for (int m = 0; m < 4; ++m)
#pragma unroll
                for (int n = 0; n < 2; ++n) acc[a][b][m][n] = (f32x4){0.f, 0.f, 0.f, 0.f};
    bf16x8 At[4][2], B0[2][2], B1[2][2];
    const char* cA = (const char*)gA + (size_t)cur.pm * tstep + (cur.ks > 0 ? cur.ks * ksl : 0); const char* cB = (const char*)gBt + (size_t)cur.pn * tstep + (cur.ks > 0 ? cur.ks * ksl : 0);
    PG8_STAGE(PG8_SB(0, 0), cB, voffB); PG8_STAGE(PG8_SB(0, 1), cB + hstep, voffB); PG8_STAGE(PG8_SA(0, 0), cA, voffA); PG8_STAGE(PG8_SA(0, 1), cA + hstep, voffA);
    if (wr == 1) PG8_BAR;
    PG8_WAIT_V(2); PG8_BAR;
    PG8_STAGE(PG8_SB(1, 0), cB + kstep, voffB); PG8_STAGE(PG8_SA(1, 0), cA + kstep, voffA); PG8_STAGE(PG8_SB(1, 1), cB + hstep + kstep, voffB);
    PG8_WAIT_V(6); PG8_BAR;
    for (;;) {
        const bool has_next = S.next(ui + 1, nxt);
        const char* nA = has_next ? (const char*)gA + (size_t)nxt.pm * tstep + (nxt.ks > 0 ? nxt.ks * ksl : 0) : cA; const char* nB = has_next ? (const char*)gBt + (size_t)nxt.pn * tstep + (nxt.ks > 0 ? nxt.ks * ksl : 0) : cB;
        const int nt = cur.ks >= 0 ? ntf / 4 : ntf;
        for (int t = 0; t < nt; t += 2) {
            const bool last = (t == nt - 2);
            const char* a1 = cA + (size_t)(t + 1) * kstep;
            const char* a2 = last ? nA : cA + (size_t)(t + 2) * kstep; const char* b2 = last ? nB : cB + (size_t)(t + 2) * kstep;
            const char* a3 = a2 + kstep; const char* b3 = b2 + kstep;
            PG8_LDB(B0, 0, 0); PG8_LDB(B1, 0, 1); PG8_SCHED; PG8_LDA(At, 0, 0); PG8_STAGE(PG8_SA(1, 1), a1 + hstep, voffA);
            PG8_WAIT_V(8); PG8_WAIT_L(0); PG8_BAR; PG8_MMA(0, 0, At, B0); PG8_MMA(0, 1, At, B1); PG8_BAR; PG8_SCHED;
            PG8_LDA(At, 0, 1); PG8_STAGE(PG8_SB(0, 0), b2, voffB); PG8_STAGE(PG8_SB(0, 1), b2 + hstep, voffB); PG8_STAGE(PG8_SA(0, 0), a2, voffA);
            PG8_WAIT_V(8); PG8_WAIT_L(0); PG8_BAR; PG8_MMA(1, 0, At, B0); PG8_MMA(1, 1, At, B1); PG8_BAR; PG8_SCHED;
            PG8_LDB(B0, 1, 0); PG8_LDB(B1, 1, 1); PG8_SCHED; PG8_LDA(At, 1, 0); PG8_STAGE(PG8_SA(0, 1), a2 + hstep, voffA);
            PG8_WAIT_V(8); PG8_WAIT_L(0); PG8_BAR; PG8_MMA(0, 0, At, B0); PG8_MMA(0, 1, At, B1); PG8_BAR; PG8_SCHED;
            PG8_LDA(At, 1, 1); PG8_STAGE(PG8_SB(1, 0), b3, voffB); PG8_STAGE(PG8_SB(1, 1), b3 + hstep, voffB); PG8_STAGE(PG8_SA(1, 0), a3, voffA);
            PG8_WAIT_V(8); PG8_WAIT_L(0); PG8_BAR; PG8_MMA(1, 0, At, B0); PG8_MMA(1, 1, At, B1); PG8_BAR; PG8_SCHED;
        }
        if (wr == 0) PG8_BAR;
        gemm_epilogue(p, epi, Hp, goff, coef, acc, cur, wr, wc, fr, fq);
        if (!has_next) break;
#pragma unroll
        for (int a = 0; a < 2; ++a)
#pragma unroll
            for (int b = 0; b < 2; ++b)
#pragma unroll
                for (int m = 0; m < 4; ++m)
#pragma unroll
                    for (int n = 0; n < 2; ++n) acc[a][b][m][n] = (f32x4){0.f, 0.f, 0.f, 0.f};
        cur = nxt; cA = nA; cB = nB; ++ui;
        if (wr == 1) PG8_BAR;
    }
    PG8_WAIT_V(0);
    PG8_BAR;
#undef PG8_SA
#undef PG8_SB
#undef PG8_STAGE
#undef PG8_LDA
#undef PG8_LDB
#undef PG8_MMA
#undef PG8_WAIT_V
#undef PG8_WAIT_L
#undef PG8_BAR
#undef PG8_SCHED
}

__device__ __forceinline__ void adaln_unit(const Params& p, LAS float* sm, int unit) {
    const int t = threadIdx.x;
    for (int idx = t; idx < 9 * 2048; idx += 512) { const int i = idx >> 11, k = idx & 2047; const float v = (i < 8) ? p.in[1][i * 2048 + k] : p.in[3][k]; sm[k * 9 + i] = siluf_(v); }
    __syncthreads();
    const int cg4 = (t % 18) * 4, ksub = t / 18;
    const float* w = p.in[4] + (size_t)unit * 72 + cg4;
    float acc[9][4];
#pragma unroll
    for (int i = 0; i < 9; ++i)
#pragma unroll
        for (int j = 0; j < 4; ++j) acc[i][j] = 0.f;
    if (t < 504) {
#pragma unroll 4
        for (int k = ksub; k < 2048; k += 28) {
            const f32x4 wv = *(const f32x4*)(w + (size_t)k * NMODC);
#pragma unroll
            for (int i = 0; i < 9; ++i) { const float s = sm[k * 9 + i];
#pragma unroll
                for (int j = 0; j < 4; ++j) acc[i][j] += s * wv[j]; }
        }
    }
    __syncthreads();
    if (t < 504) {
#pragma unroll
        for (int i = 0; i < 9; ++i)
#pragma unroll
            for (int j = 0; j < 4; ++j) sm[(ksub * 9 + i) * 72 + cg4 + j] = acc[i][j];
    }
    __syncthreads();
    float* mod = (float*)(p.ws + WS_MOD);
    for (int o = t; o < 9 * 72; o += 512) { const int i = o / 72, c = o - i * 72; float s = 0.f;
        for (int ks = 0; ks < 28; ++ks) s += sm[(ks * 9 + i) * 72 + c];
        mod[(size_t)i * NMODC + unit * 72 + c] = s + p.in[5][unit * 72 + c]; }
    __syncthreads();
}

__device__ __forceinline__ int colmap(int map, int n) {
    if (map == 0) return n;
    if (map == 1) { const int pn = n >> 8, rem = n & 255; return (rem >> 7) * DFF + pn * 128 + (rem & 127); }
    return n < 3072 ? n : (n < 5120 ? n + 16 : (n < 5136 ? n - 2048 : -1));
}

__device__ __forceinline__ void wtile_unit(const Params& p, LAS float* sm, int tile) {
    const float* src; bf16_t* dst; int K, ldw, map, local;
    if (tile < 2816) { src = p.in[7]; dst = (bf16_t*)(p.ws + WS_WF1IN); K = 2048; ldw = 11264; map = 1; local = tile; }
    else if (tile < 4224) { src = p.in[8]; dst = (bf16_t*)(p.ws + WS_WF1OUT); K = 5632; ldw = 2048; map = 0; local = tile - 2816; }
    else if (tile < 5568) { src = p.in[10]; dst = (bf16_t*)(p.ws + WS_WIN); K = 2048; ldw = 5136; map = 2; local = tile - 4224; }
    else if (tile < 6080) { src = p.in[19]; dst = (bf16_t*)(p.ws + WS_WOUT); K = 2048; ldw = 2048; map = 0; local = tile - 5568; }
    else if (tile < 8896) { src = p.in[21]; dst = (bf16_t*)(p.ws + WS_WF2IN); K = 2048; ldw = 11264; map = 1; local = tile - 6080; }
    else { src = p.in[22]; dst = (bf16_t*)(p.ws + WS_WF2OUT); K = 5632; ldw = 2048; map = 0; local = tile - 8896; }
    const int nkt = K >> 7, ntile = local / nkt, kt = local - ntile * nkt;
    const int n0 = ntile * 64, k0 = kt * 128;
    const int t = threadIdx.x;
    {
        const int n4 = (t & 15) * 4, kr = t >> 4;
        const int col = colmap(map, n0 + n4);
#pragma unroll
        for (int i = 0; i < 4; ++i) { const int k = kr + 32 * i;
            f32x4 v = (f32x4){0.f, 0.f, 0.f, 0.f};
            if (col >= 0) v = *(const f32x4*)(src + (size_t)(k0 + k) * ldw + col);
#pragma unroll
            for (int j = 0; j < 4; ++j) sm[k * 65 + n4 + j] = v[j]; }
    }
    __syncthreads();
#pragma unroll
    for (int it = 0; it < 2; ++it) {
        const int n = t >> 3, k8 = (t & 7) * 8 + 64 * it;
        float f[8];
#pragma unroll
        for (int j = 0; j < 8; ++j) f[j] = sm[(k8 + j) * 65 + n];
        u32x4 o; o.x = cvt_pk_bf16(f[0], f[1]); o.y = cvt_pk_bf16(f[2], f[3]); o.z = cvt_pk_bf16(f[4], f[5]); o.w = cvt_pk_bf16(f[6], f[7]);
        *(u32x4*)(dst + (size_t)(n0 + n) * K + k0 + k8) = o;
    }
    __syncthreads();
}

__device__ __forceinline__ void norm_phase(const float* lat, const float* ctxp, const bf16_t* dbuf, const bf16_t* dpart, float* xout, int nrows, const float* gw, const float* mod, int shift_off, int scale_off, bf16_t* outb, float* outf) {
    const int wid = threadIdx.x >> 6, lane = threadIdx.x & 63;
    const int nw = gridDim.x * 8, gwv = blockIdx.x * 8 + wid, per = (nrows + nw - 1) / nw;
    const int rb = gwv * per, re = (rb + per < nrows) ? rb + per : nrows;
    if (rb >= re) return;
    int cur_b = -1;
    f32x4 ca[8], cb[8], v[8]; u32x2 dv[8];
    { const float* src = rb < ML ? lat + (size_t)rb * D : ctxp + (size_t)(rb - ML) * D;
#pragma unroll
      for (int i = 0; i < 8; ++i) { v[i] = __builtin_nontemporal_load((const f32x4*)(src + i * 256 + lane * 4)); dv[i] = (u32x2){0u, 0u}; if (dbuf && !dpart) dv[i] = *(const u32x2*)(dbuf + (size_t)rb * D + i * 256 + lane * 4); } }
    for (int row = rb; row < re; ++row) {
        const int b = row < ML ? (row >> 12) : 8;
        if (b != cur_b) {
            cur_b = b;
#pragma unroll
            for (int i = 0; i < 8; ++i) { const int col = i * 256 + lane * 4; ca[i] = *(const f32x4*)(gw + col); cb[i] = (f32x4){0.f, 0.f, 0.f, 0.f};
                if (mod) { const f32x4 sc = *(const f32x4*)(mod + (size_t)b * NMODC + scale_off + col); cb[i] = *(const f32x4*)(mod + (size_t)b * NMODC + shift_off + col); ca[i] = ca[i] * (sc + 1.f); } }
        }
        f32x4 nv[8]; u32x2 nd[8];
        if (row + 1 < re) { const int r1 = row + 1; const float* src = r1 < ML ? lat + (size_t)r1 * D : ctxp + (size_t)(r1 - ML) * D;
#pragma unroll
            for (int i = 0; i < 8; ++i) { nv[i] = __builtin_nontemporal_load((const f32x4*)(src + i * 256 + lane * 4)); nd[i] = (u32x2){0u, 0u}; if (dbuf && !dpart) nd[i] = *(const u32x2*)(dbuf + (size_t)r1 * D + i * 256 + lane * 4); } }
        else {
#pragma unroll
            for (int i = 0; i < 8; ++i) { nv[i] = (f32x4){0.f, 0.f, 0.f, 0.f}; nd[i] = (u32x2){0u, 0u}; } }
        if (dpart && row < ML) {
#pragma unroll
            for (int i = 0; i < 8; ++i) { const u32x2 e = *(const u32x2*)(dbuf + (size_t)row * D + i * 256 + lane * 4);
                v[i][0] += bflo(e.x); v[i][1] += bfhi(e.x); v[i][2] += bflo(e.y); v[i][3] += bfhi(e.y); }
        }
        if (dpart && row >= ML) {
#pragma unroll
            for (int ks = 0; ks < 4; ++ks)
#pragma unroll
                for (int i = 0; i < 8; ++i) { const u32x2 e = *(const u32x2*)(dpart + (size_t)ks * MC * D + (size_t)(row - ML) * D + i * 256 + lane * 4);
                    v[i][0] += bflo(e.x); v[i][1] += bfhi(e.x); v[i][2] += bflo(e.y); v[i][3] += bfhi(e.y); if (i == 7) asm volatile("" ::: "memory"); }
        }
        float ss = 0.f;
#pragma unroll
        for (int i = 0; i < 8; ++i) {
            v[i][0] += bflo(dv[i].x); v[i][1] += bfhi(dv[i].x); v[i][2] += bflo(dv[i].y); v[i][3] += bfhi(dv[i].y);
            ss += v[i][0] * v[i][0] + v[i][1] * v[i][1] + v[i][2] * v[i][2] + v[i][3] * v[i][3]; }
        ss = wave_sum(ss);
        const float rstd = rsqrtf(ss * (1.f / 2048.f) + 1e-6f);
#pragma unroll
        for (int i = 0; i < 8; ++i) {
            const int col = i * 256 + lane * 4;
            if (xout && row < ML) __builtin_nontemporal_store(v[i], (f32x4*)(xout + (size_t)row * D + col));
            const f32x4 y = v[i] * rstd * ca[i] + cb[i];
            if (outb) { u32x2 o; o.x = cvt_pk_bf16(y[0], y[1]); o.y = cvt_pk_bf16(y[2], y[3]); *(u32x2*)(outb + (size_t)row * D + col) = o; }
            else __builtin_nontemporal_store(y, (f32x4*)(outf + (size_t)row * D + col));
        }
#pragma unroll
        for (int i = 0; i < 8; ++i) { v[i] = nv[i]; dv[i] = nd[i]; }
    }
}

__device__ __forceinline__ void conv_unit(const Params& p, int unit) {
    const int t = threadIdx.x, c8 = t & 31, t8 = t >> 5;
    const int ck = unit >> 3, cb = unit & 7;
    const int ch0 = cb * 256 + c8 * 8;
    const int row0 = ck * 128 + t8 * 8;
    const bool lat = ck < 256;
    const bf16_t* ZQK = (const bf16_t*)(p.ws + WS_ZQK);
    const bf16_t* V = (const bf16_t*)(p.ws + WS_V);
    bf16_t* Q = (bf16_t*)(p.ws + WS_Q); bf16_t* Kn = (bf16_t*)(p.ws + WS_K); bf16_t* KT = (bf16_t*)(p.ws + WS_KT); bf16_t* VT = (bf16_t*)(p.ws + WS_VT);
    if (cb < 4) {
        if (!lat && cb < 2) return;
        int seq_lo, seq_hi;
        if (lat) { seq_lo = (ck >> 5) * 4096; seq_hi = seq_lo + 4096; } else { seq_lo = ML + ((ck - 256) >> 1) * 256; seq_hi = seq_lo + 256; }
        u32x4 z[12];
#pragma unroll
        for (int i = 0; i < 12; ++i) { const int r = row0 - 2 + i; z[i] = (u32x4){0u, 0u, 0u, 0u}; if (r >= seq_lo && r < seq_hi) z[i] = *(const u32x4*)(ZQK + (size_t)r * 1024 + ch0); }
        const float* cw = p.in[11]; const float* cbias = p.in[12];
        float y[8][8];
#pragma unroll
        for (int c = 0; c < 8; ++c) {
            const float w0 = cw[0 * 1024 + ch0 + c], w1 = cw[1 * 1024 + ch0 + c], w2 = cw[2 * 1024 + ch0 + c], w3 = cw[3 * 1024 + ch0 + c], w4 = cw[4 * 1024 + ch0 + c], bb = cbias[ch0 + c];
#pragma unroll
            for (int r = 0; r < 8; ++r) {
                float a = bb + bfel(z[r], c) * w0 + bfel(z[r + 1], c) * w1 + bfel(z[r + 2], c) * w2 + bfel(z[r + 3], c) * w3 + bfel(z[r + 4], c) * w4;
                a = siluf_(a);
                y[r][c] = (cb < 2) ? a * 0.08838834764831845f : a;
            }
        }
        if (lat) {
            bf16_t* dn = (cb < 2) ? Q + (size_t)row0 * 512 + ch0 : Kn + (size_t)row0 * 512 + (ch0 - 512);
#pragma unroll
            for (int r = 0; r < 8; ++r) { u32x4 o; o.x = cvt_pk_bf16(y[r][0], y[r][1]); o.y = cvt_pk_bf16(y[r][2], y[r][3]); o.z = cvt_pk_bf16(y[r][4], y[r][5]); o.w = cvt_pk_bf16(y[r][6], y[r][7]);
                *(u32x4*)(dn + (size_t)r * 512) = o; }
        }
        if (cb >= 2) {
            const int kc = ch0 - 512, h = kc >> 7, dk = kc & 127;
            bf16_t* dt = KT + ((size_t)(ck * 4 + h) * 128 + dk) * 128 + t8 * 8;
#pragma unroll
            for (int c = 0; c < 8; ++c) { u32x4 o; o.x = cvt_pk_bf16(y[0][c], y[1][c]); o.y = cvt_pk_bf16(y[2][c], y[3][c]); o.z = cvt_pk_bf16(y[4][c], y[5][c]); o.w = cvt_pk_bf16(y[6][c], y[7][c]);
                *(u32x4*)(dt + (size_t)c * 128) = o; }
        }
    } else {
        const int vch = ch0 - 1024, h = vch >> 8, dv = vch & 255;
        u32x4 z[8];
#pragma unroll
        for (int r = 0; r < 8; ++r) z[r] = *(const u32x4*)(V + (size_t)(row0 + r) * 1024 + vch);
        bf16_t* dt = VT + ((size_t)(ck * 4 + h) * 256 + dv) * 128 + t8 * 8;
#pragma unroll
        for (int c = 0; c < 8; ++c) { u32x4 o;
            o.x = us16(z[0], c) | (us16(z[1], c) << 16); o.y = us16(z[2], c) | (us16(z[3], c) << 16); o.z = us16(z[4], c) | (us16(z[5], c) << 16); o.w = us16(z[6], c) | (us16(z[7], c) << 16);
            *(u32x4*)(dt + (size_t)c * 128) = o; }
    }
}

__device__ __forceinline__ void gmlp_unit(const Params& p, LAS unsigned char* lds, int unit) {
    LAS bf16_t* Wt = (LAS bf16_t*)lds;
    LAS bf16_t* vnT = (LAS bf16_t*)(lds + 34816);
    LAS float* rstd = (LAS float*)(lds + 69632);
    const int t = threadIdx.x, wid = t >> 6, lane = t & 63, fr = lane & 15, fq = lane >> 4;
    const int r0 = unit * 128;
    const bf16_t* U = (const bf16_t*)(p.ws + WS_U); const bf16_t* GV = (const bf16_t*)(p.ws + WS_GV); bf16_t* CAT = (bf16_t*)(p.ws + WS_CAT);
    for (int q = wid; q < 128; q += 8) {
        float ss = 0.f;
#pragma unroll
        for (int i = 0; i < 2; ++i) { const u32x4 v = *(const u32x4*)(GV + (size_t)(r0 + q) * 1024 + i * 512 + lane * 8);
#pragma unroll
            for (int c = 0; c < 8; ++c) { const float f = bfel(v, c); ss += f * f; } }
        ss = wave_sum(ss);
        if (lane == 0) rstd[q] = rsqrtf(ss * (1.f / 1024.f) + 1e-6f);
    }
    __syncthreads();
    for (int g = 0; g < 8; ++g) {
        const float* ws_ = p.in[17] + (size_t)g * 128 * 128;
#pragma unroll
        for (int i = 0; i < 8; ++i) { const int idx = t + 512 * i, pr = idx >> 5, q4 = (idx & 31) * 4; const f32x4 v = *(const f32x4*)(ws_ + pr * 128 + q4);
            u32x2 o; o.x = cvt_pk_bf16(v[0], v[1]); o.y = cvt_pk_bf16(v[2], v[3]); *(LAS u32x2*)(Wt + pr * 136 + q4) = o; }
        const float* gn = p.in[16] + g * 128;
#pragma unroll
        for (int i = 0; i < 4; ++i) { const int d8 = (t & 15) * 8, q = (t >> 4) + 32 * i; const u32x4 v = *(const u32x4*)(GV + (size_t)(r0 + q) * 1024 + g * 128 + d8); const float rs = rstd[q];
#pragma unroll
            for (int c = 0; c < 8; ++c) { const float f = bfel(v, c) * rs * gn[d8 + c]; vnT[(d8 + c) * 136 + q] = (bf16_t)(cvt_pk_bf16(f, 0.f) & 0xffffu); } }
        __syncthreads();
        f32x4 acc[8];
#pragma unroll
        for (int nb = 0; nb < 8; ++nb) acc[nb] = (f32x4){0.f, 0.f, 0.f, 0.f};
#pragma unroll
        for (int kk = 0; kk < 4; ++kk) { const bf16x8 a = *(const LAS bf16x8*)(Wt + (16 * wid + fr) * 136 + kk * 32 + fq * 8);
#pragma unroll
            for (int nb = 0; nb < 8; ++nb) { const bf16x8 bv = *(const LAS bf16x8*)(vnT + (nb * 16 + fr) * 136 + kk * 32 + fq * 8);
                acc[nb] = __builtin_amdgcn_mfma_f32_16x16x32_bf16(bv, a, acc[nb], 0, 0, 0); } }
        const int pp = 16 * wid + fr; const float bs = p.in[18][g * 128 + pp];
#pragma unroll
        for (int nb = 0; nb < 8; ++nb) { const int d = nb * 16 + fq * 4; const u32x2 uu = *(const u32x2*)(U + (size_t)(r0 + pp) * 1024 + g * 128 + d);
            u32x2 o; o.x = cvt_pk_bf16(bflo(uu.x) * (acc[nb][0] + bs), bfhi(uu.x) * (acc[nb][1] + bs)); o.y = cvt_pk_bf16(bflo(uu.y) * (acc[nb][2] + bs), bfhi(uu.y) * (acc[nb][3] + bs));
            *(u32x2*)(CAT + (size_t)(r0 + pp) * 2048 + 1024 + g * 128 + d) = o; }
        __syncthreads();
    }
}

__device__ __forceinline__ int scan_chunk(int s, int dir, int b) { if (s < 2) return 256 + 2 * b + (dir ? 1 - s : s); const int li = s - 2; return 32 * b + (dir ? 31 - li : li); }

__device__ __forceinline__ void scan_issue(const Params& p, int s, int dir, int b, int h, int slice, u32x4 (&kreg)[4], u32x4 (&vreg)[2]) {
    const int t = threadIdx.x;
    const int ck = scan_chunk(s, dir, b);
    const bf16_t* kt = (const bf16_t*)(p.ws + WS_KT) + (size_t)(ck * 4 + h) * 128 * 128;
#pragma unroll
    for (int i = 0; i < 4; ++i) { const int idx = t + 512 * i; kreg[i] = *(const u32x4*)(kt + (idx >> 4) * 128 + (idx & 15) * 8); }
    const bf16_t* vt = (const bf16_t*)(p.ws + WS_VT) + ((size_t)(ck * 4 + h) * 256 + slice * 64) * 128;
#pragma unroll
    for (int i = 0; i < 2; ++i) { const int idx = t + 512 * i; vreg[i] = *(const u32x4*)(vt + (idx >> 4) * 128 + (idx & 15) * 8); }
}

__device__ __forceinline__ void scan_phase(const Params& p, LAS unsigned char* lds) {
    LAS float* wls = (LAS float*)(lds + 113152);
    LAS float* scs = (LAS float*)(lds + 113152 + 17408);
    const int t = threadIdx.x, wid = t >> 6, lane = t & 63, fr = lane & 15, fq = lane >> 4;
    bf16_t* CP = (bf16_t*)(p.ws + WS_XN); float* MP = (float*)(p.ws + WS_MPREV);
    const float* G = (const float*)(p.ws + WS_G);
    for (int u = blockIdx.x; u < 256; u += gridDim.x) {
        const int chain = u >> 2, slice = u & 3, dir = chain & 1, bh = chain >> 1, h = bh & 3, b = bh >> 2;
        u32x4 kreg[4], vreg[2];
        scan_issue(p, 0, dir, b, h, slice, kreg, vreg);
        for (int s = wid; s < 34; s += 8) {
            const int ck = scan_chunk(s, dir, b);
            const int p0 = 2 * lane, t0 = dir ? 127 - p0 : p0, t1 = dir ? 126 - p0 : p0 + 1;
            const float* g = G + (size_t)ck * 128 * 16 + dir * 8 + h;
            const float gi0 = g[t0 * 16], gi1 = g[t1 * 16], gf0 = g[t0 * 16 + 4], gf1 = g[t1 * 16 + 4];
            const float P = wave_scan_sum(gf0 + gf1, lane);
            const float total = __shfl(P, 63);
            const float g0 = total - (P - gf1) + gi0, g1 = total - P + gi1;
            const float mloc = wave_max(fmaxf(g0, g1));
            wls[s * 128 + t0] = g0; wls[s * 128 + t1] = g1;
            if (lane == 0) { scs[s * 4 + 2] = total; scs[s * 4 + 3] = mloc; }
        }
        __syncthreads();
        if (t == 0) {
            float m = 0.f;
            for (int s = 0; s < 34; ++s) { const float total = scs[s * 4 + 2], mloc = scs[s * 4 + 3]; const float m_new = fmaxf(total + m, mloc);
                scs[s * 4 + 0] = __expf(total + m - m_new); scs[s * 4 + 1] = m; scs[s * 4 + 2] = m_new; m = m_new; }
        }
        __syncthreads();
        for (int idx = t; idx < 34 * 128; idx += 512) wls[idx] = __expf(wls[idx] - scs[(idx >> 7) * 4 + 2]);
        __syncthreads();
        f32x4 st[5];
#pragma unroll
        for (int nb = 0; nb < 5; ++nb) st[nb] = (f32x4){0.f, 0.f, 0.f, 0.f};
        for (int s = 0; s < 34; ++s) {
            LAS bf16_t* kT = (LAS bf16_t*)(lds + (s & 1) * 56576);
            LAS bf16_t* wvT = (LAS bf16_t*)(lds + (s & 1) * 56576 + 34816);
            LAS float* wb = wls + s * 128;
#pragma unroll
            for (int i = 0; i < 4; ++i) { const int idx = t + 512 * i; *(LAS u32x4*)(kT + (idx >> 4) * 136 + (idx & 15) * 8) = kreg[i]; }
#pragma unroll
            for (int i = 0; i < 2; ++i) { const int idx = t + 512 * i, r = idx >> 4, c8 = (idx & 15) * 8;
                const f32x4 w0 = *(const LAS f32x4*)(wb + c8), w1 = *(const LAS f32x4*)(wb + c8 + 4);
                u32x4 o; o.x = cvt_pk_bf16(bflo(vreg[i].x) * w0[0], bfhi(vreg[i].x) * w0[1]); o.y = cvt_pk_bf16(bflo(vreg[i].y) * w0[2], bfhi(vreg[i].y) * w0[3]);
                o.z = cvt_pk_bf16(bflo(vreg[i].z) * w1[0], bfhi(vreg[i].z) * w1[1]); o.w = cvt_pk_bf16(bflo(vreg[i].w) * w1[2], bfhi(vreg[i].w) * w1[3]);
                *(LAS u32x4*)(wvT + r * 136 + c8) = o; }
            if (t < 256) { const int r = 64 + (t >> 4), c8 = (t & 15) * 8; u32x4 o = (u32x4){0u, 0u, 0u, 0u};
                if (r == 64) { const f32x4 w0 = *(const LAS f32x4*)(wb + c8), w1 = *(const LAS f32x4*)(wb + c8 + 4);
                    o.x = cvt_pk_bf16(w0[0], w0[1]); o.y = cvt_pk_bf16(w0[2], w0[3]); o.z = cvt_pk_bf16(w1[0], w1[1]); o.w = cvt_pk_bf16(w1[2], w1[3]); }
                *(LAS u32x4*)(wvT + r * 136 + c8) = o; }
            const int ck = scan_chunk(s, dir, b);
            if (s + 1 < 34) scan_issue(p, s + 1, dir, b, h, slice, kreg, vreg);
            __syncthreads();
            const float decay = scs[s * 4];
            if (s >= 2) {
                const int cc = ck - 32 * b;
                bf16_t* cp = CP + (size_t)(chain * 32 + cc) * (272 * 128);
                const int col = 16 * wid + 4 * fq;
#pragma unroll
                for (int nb = 0; nb < 4; ++nb) { u32x2 o; o.x = cvt_pk_bf16(st[nb][0], st[nb][1]); o.y = cvt_pk_bf16(st[nb][2], st[nb][3]); *(u32x2*)(cp + (size_t)(slice * 64 + nb * 16 + fr) * 128 + col) = o; }
                if (slice == 0) { u32x2 o; o.x = cvt_pk_bf16(st[4][0], st[4][1]); o.y = cvt_pk_bf16(st[4][2], st[4][3]); *(u32x2*)(cp + (size_t)(256 + fr) * 128 + col) = o;
                    if (t == 0) MP[chain * 32 + cc] = scs[s * 4 + 1]; }
            }
            f32x4 acc[5];
#pragma unroll
            for (int nb = 0; nb < 5; ++nb) acc[nb] = (f32x4){0.f, 0.f, 0.f, 0.f};
#pragma unroll
            for (int kk = 0; kk < 4; ++kk) { const bf16x8 a = *(const LAS bf16x8*)(kT + (16 * wid + fr) * 136 + kk * 32 + fq * 8);
#pragma unroll
                for (int nb = 0; nb < 5; ++nb) { const bf16x8 bv = *(const LAS bf16x8*)(wvT + (nb * 16 + fr) * 136 + kk * 32 + fq * 8);
                    acc[nb] = __builtin_amdgcn_mfma_f32_16x16x32_bf16(a, bv, acc[nb], 0, 0, 0); } }
#pragma unroll
            for (int nb = 0; nb < 5; ++nb) st[nb] = st[nb] * decay + acc[nb];
        }
        __syncthreads();
    }
}

__device__ __forceinline__ void mout_issue(const Params& p, int u, u32x4 (&kreg)[4], bf16x8 (&qf)[4], float (&gg)[5]) {
    const int t = threadIdx.x, wid = t >> 6, lane = t & 63, fr = lane & 15, fq = lane >> 4;
    const int dir = u & 1, cc = (u >> 1) & 31, bh = u >> 6, h = bh & 3, b = bh >> 2, chain = bh * 2 + dir, ck = 32 * b + cc, r0 = ck * 128;
    const bf16_t* Q = (const bf16_t*)(p.ws + WS_Q); const bf16_t* Kn = (const bf16_t*)(p.ws + WS_K);
#pragma unroll
    for (int i = 0; i < 4; ++i) { const int idx = t + 512 * i, r = idx >> 4, c8 = (idx & 15) * 8; kreg[i] = *(const u32x4*)(Kn + (size_t)(r0 + r) * 512 + h * 128 + c8); }
#pragma unroll
    for (int kk = 0; kk < 4; ++kk) qf[kk] = *(const bf16x8*)(Q + (size_t)(r0 + 16 * wid + fr) * 512 + h * 128 + kk * 32 + fq * 8);
    if (wid == 0) {
        const int p0 = 2 * lane, t0 = dir ? 127 - p0 : p0, t1 = dir ? 126 - p0 : p0 + 1;
        const float* g = (const float*)(p.ws + WS_G) + (size_t)r0 * 16 + dir * 8 + h;
        gg[0] = g[t0 * 16]; gg[1] = g[t1 * 16]; gg[2] = g[t0 * 16 + 4]; gg[3] = g[t1 * 16 + 4];
        gg[4] = ((const float*)(p.ws + WS_MPREV))[chain * 32 + cc];
    }
}

__device__ __forceinline__ void mout_phase(const Params& p, LAS unsigned char* lds) {
    LAS bf16_t* T = (LAS bf16_t*)lds;
    LAS bf16_t* sb = (LAS bf16_t*)(lds + 73984);
    LAS float* fv = (LAS float*)(lds + 73984 + 34816);
    const int t = threadIdx.x, wid = t >> 6, lane = t & 63, fr = lane & 15, fq = lane >> 4;
    const bf16_t* CP = (const bf16_t*)(p.ws + WS_XN);
    const bf16_t* VT = (const bf16_t*)(p.ws + WS_VT);
    u32x4 kreg[4]; bf16x8 qf[4]; float gg[5] = {0.f, 0.f, 0.f, 0.f, 0.f};
    int u = 2 * blockIdx.x;
    if (u < 2048) mout_issue(p, u, kreg, qf, gg);
    for (; u < 2048; u = (u & 1) ? u - 1 + 2 * (int)gridDim.x : u + 1) {
        const int dir = u & 1, cc = (u >> 1) & 31, bh = u >> 6, h = bh & 3, b = bh >> 2, chain = bh * 2 + dir, ck = 32 * b + cc, r0 = ck * 128;
        if (wid == 0) {
            const int p0 = 2 * lane, t0 = dir ? 127 - p0 : p0, t1 = dir ? 126 - p0 : p0 + 1;
            const float gi0 = gg[0], gi1 = gg[1], gf0 = gg[2], gf1 = gg[3], mst = gg[4];
            const float P = wave_scan_sum(gf0 + gf1, lane);
            const float b1 = P, b0 = P - gf1;
            const float c0 = gi0 - b0, c1 = gi1 - b1;
            const float Mi = wave_scan_max(fmaxf(c0, c1), lane);
            float Me = __shfl_up(Mi, 1); if (lane == 0) Me = -INFINITY;
            const float pm0 = fmaxf(Me, c0), pm1 = Mi;
            const float mt0 = fmaxf(b0 + mst, b0 + pm0), mt1 = fmaxf(b1 + mst, b1 + pm1);
            fv[t0] = b0 - mt0; fv[t1] = b1 - mt1;
            fv[128 + t0] = c0; fv[128 + t1] = c1;
            fv[256 + t0] = __expf(b0 + mst - mt0); fv[256 + t1] = __expf(b1 + mst - mt1);
            fv[384 + t0] = __expf(-mt0); fv[384 + t1] = __expf(-mt1);
        }
#pragma unroll
        for (int i = 0; i < 4; ++i) { const int idx = t + 512 * i, r = idx >> 4, c8 = (idx & 15) * 8; *(LAS u32x4*)(T + r * 136 + c8) = kreg[i]; }
        u32x4 creg[9];
        { const bf16_t* cp = CP + (size_t)(chain * 32 + cc) * (272 * 128);
#pragma unroll
          for (int i = 0; i < 9; ++i) { const int idx = t + 512 * i; creg[i] = (u32x4){0u, 0u, 0u, 0u}; if (idx < 272 * 16) creg[i] = *(const u32x4*)(cp + (size_t)(idx >> 4) * 128 + (idx & 15) * 8); } }
        __syncthreads();
        const int j = 16 * wid + fr;
        {
            f32x4 S[8];
#pragma unroll
            for (int nb = 0; nb < 8; ++nb) S[nb] = (f32x4){0.f, 0.f, 0.f, 0.f};
#pragma unroll
            for (int kk = 0; kk < 4; ++kk)
#pragma unroll
                for (int nb = 0; nb < 8; ++nb) { const bf16x8 kf = *(const LAS bf16x8*)(T + (nb * 16 + fr) * 136 + kk * 32 + fq * 8);
                    S[nb] = __builtin_amdgcn_mfma_f32_16x16x32_bf16(kf, qf[kk], S[nb], 0, 0, 0); }
            const float rb = fv[j];
#pragma unroll
            for (int nb = 0; nb < 8; ++nb) { const int l0 = nb * 16 + 4 * fq; const f32x4 cw = *(const LAS f32x4*)(fv + 128 + l0);
                float sv[4];
#pragma unroll
                for (int i = 0; i < 4; ++i) { const int l = l0 + i; const bool valid = dir ? (l >= j) : (l <= j); sv[i] = valid ? S[nb][i] * __expf(rb + cw[i]) : 0.f; }
                u32x2 o; o.x = cvt_pk_bf16(sv[0], sv[1]); o.y = cvt_pk_bf16(sv[2], sv[3]); *(LAS u32x2*)(sb + j * 136 + l0) = o; }
        }
        __syncthreads();
#pragma unroll
        for (int i = 0; i < 9; ++i) { const int idx = t + 512 * i; if (idx < 272 * 16) *(LAS u32x4*)(T + (idx >> 4) * 136 + (idx & 15) * 8) = creg[i]; }
        u32x4 vreg[8];
        { const bf16_t* vt = VT + (size_t)(ck * 4 + h) * 256 * 128;
#pragma unroll
          for (int i = 0; i < 8; ++i) { const int idx = t + 512 * i; vreg[i] = *(const u32x4*)(vt + (size_t)(idx >> 4) * 128 + (idx & 15) * 8); } }
        __syncthreads();
        f32x4 acc[17];
#pragma unroll
        for (int nb = 0; nb < 17; ++nb) acc[nb] = (f32x4){0.f, 0.f, 0.f, 0.f};
#pragma unroll
        for (int kk = 0; kk < 4; ++kk)
#pragma unroll
            for (int nb = 0; nb < 17; ++nb) { const bf16x8 cf = *(const LAS bf16x8*)(T + (nb * 16 + fr) * 136 + kk * 32 + fq * 8);
                acc[nb] = __builtin_amdgcn_mfma_f32_16x16x32_bf16(cf, qf[kk], acc[nb], 0, 0, 0); }
        { const float aj = fv[256 + j];
#pragma unroll
          for (int nb = 0; nb < 17; ++nb) acc[nb] = acc[nb] * aj; }
        __syncthreads();
#pragma unroll
        for (int i = 0; i < 8; ++i) { const int idx = t + 512 * i; *(LAS u32x4*)(T + (idx >> 4) * 136 + (idx & 15) * 8) = vreg[i]; }
        if (t < 256) { const int r = 256 + (t >> 4), c8 = (t & 15) * 8; const unsigned one = (r == 256) ? 0x3F803F80u : 0u; *(LAS u32x4*)(T + r * 136 + c8) = (u32x4){one, one, one, one}; }
        const float einv = fv[384 + j];
        { const int un = (u & 1) ? u - 1 + 2 * (int)gridDim.x : u + 1; if (un < 2048) mout_issue(p, un, kreg, qf, gg); }
        __syncthreads();
#pragma unroll
        for (int kk = 0; kk < 4; ++kk) { const bf16x8 sf = *(const LAS bf16x8*)(sb + j * 136 + kk * 32 + fq * 8);
#pragma unroll
            for (int nb = 0; nb < 17; ++nb) { const bf16x8 vf = *(const LAS bf16x8*)(T + (nb * 16 + fr) * 136 + kk * 32 + fq * 8);
                acc[nb] = __builtin_amdgcn_mfma_f32_16x16x32_bf16(vf, sf, acc[nb], 0, 0, 0); } }
        const float nq = __shfl(acc[16][0], fr);
        const float inv = 1.f / fmaxf(fabsf(nq), einv);
        bf16_t* hd = (bf16_t*)(p.ws + WS_HDIR) + (size_t)(r0 + j) * 1024 + h * 256;
        if (dir == 0) {
#pragma unroll
            for (int nb = 0; nb < 16; ++nb) { u32x2 o; o.x = cvt_pk_bf16(acc[nb][0] * inv, acc[nb][1] * inv); o.y = cvt_pk_bf16(acc[nb][2] * inv, acc[nb][3] * inv); *(u32x2*)(hd + nb * 16 + 4 * fq) = o; }
        } else {
            float ss = 0.f;
#pragma unroll
            for (int nb = 0; nb < 16; ++nb) { const u32x2 hv = *(const u32x2*)(hd + nb * 16 + 4 * fq);
                acc[nb][0] = acc[nb][0] * inv + bflo(hv.x); acc[nb][1] = acc[nb][1] * inv + bfhi(hv.x); acc[nb][2] = acc[nb][2] * inv + bflo(hv.y); acc[nb][3] = acc[nb][3] * inv + bfhi(hv.y);
                ss += acc[nb][0] * acc[nb][0] + acc[nb][1] * acc[nb][1] + acc[nb][2] * acc[nb][2] + acc[nb][3] * acc[nb][3]; }
            ss += __shfl_xor(ss, 16); ss += __shfl_xor(ss, 32);
            const float rstd = rsqrtf(ss * (1.f / 256.f) + 1e-6f);
            const float* ng = p.in[15] + h * 256;
            const bf16_t* og = (const bf16_t*)(p.ws + WS_O) + (size_t)(r0 + j) * 1024 + h * 256;
            bf16_t* cat = (bf16_t*)(p.ws + WS_CAT) + (size_t)(r0 + j) * 2048 + h * 256;
#pragma unroll
            for (int nb = 0; nb < 16; ++nb) { const int dv = nb * 16 + 4 * fq; const f32x4 gn = *(const f32x4*)(ng + dv); const u32x2 ov = *(const u32x2*)(og + dv);
                u32x2 o; o.x = cvt_pk_bf16(acc[nb][0] * rstd * gn[0] * bflo(ov.x), acc[nb][1] * rstd * gn[1] * bfhi(ov.x));
                o.y = cvt_pk_bf16(acc[nb][2] * rstd * gn[2] * bflo(ov.y), acc[nb][3] * rstd * gn[3] * bfhi(ov.y));
                *(u32x2*)(cat + dv) = o;
                if ((nb & 3) == 3) asm volatile("" ::: "memory"); }
        }
        __syncthreads();
    }
}

__device__ __forceinline__ void finish_phase(const Params& p) {
    const int wid = threadIdx.x >> 6, lane = threadIdx.x & 63;
    const bf16_t* HD = (const bf16_t*)(p.ws + WS_HDIR); const bf16_t* O = (const bf16_t*)(p.ws + WS_O); bf16_t* CAT = (bf16_t*)(p.ws + WS_CAT);
    const float* ng = p.in[15];
    for (int row = blockIdx.x * 8 + wid; row < ML; row += gridDim.x * 8) {
        const int e0 = lane * 16;
        float hs[16]; float ss = 0.f;
#pragma unroll
        for (int i = 0; i < 2; ++i) { const u32x4 a = *(const u32x4*)(HD + (size_t)row * 1024 + e0 + i * 8), bq = *(const u32x4*)(HD + (size_t)ML * 1024 + (size_t)row * 1024 + e0 + i * 8);
#pragma unroll
            for (int c = 0; c < 8; ++c) { const float f = bfel(a, c) + bfel(bq, c); hs[i * 8 + c] = f; ss += f * f; } }
        ss += __shfl_xor(ss, 1); ss += __shfl_xor(ss, 2); ss += __shfl_xor(ss, 4); ss += __shfl_xor(ss, 8);
        const float rstd = rsqrtf(ss * (1.f / 256.f) + 1e-6f);
#pragma unroll
        for (int i = 0; i < 2; ++i) { const u32x4 ov = *(const u32x4*)(O + (size_t)row * 1024 + e0 + i * 8);
            float y[8];
#pragma unroll
            for (int c = 0; c < 8; ++c) y[c] = hs[i * 8 + c] * rstd * ng[e0 + i * 8 + c] * bfel(ov, c);
            u32x4 o; o.x = cvt_pk_bf16(y[0], y[1]); o.y = cvt_pk_bf16(y[2], y[3]); o.z = cvt_pk_bf16(y[4], y[5]); o.w = cvt_pk_bf16(y[6], y[7]);
            *(u32x4*)(CAT + (size_t)row * 2048 + e0 + i * 8) = o; }
    }
}

template <int ph> __device__ __forceinline__ void run_phase(const Params& p, LAS unsigned char* lds) {
    unsigned char* ws = p.ws;
    const float* mod = (const float*)(ws + WS_MOD);
    bf16_t* const XN = (bf16_t*)(ws + WS_XN); bf16_t* const Hb = (bf16_t*)(ws + WS_H);
    if (ph == 0) { for (int u = blockIdx.x; u < 256 + 10304; u += gridDim.x) { if (u < 256) adaln_unit(p, (LAS float*)lds, u); else wtile_unit(p, (LAS float*)lds, u - 256); } }
    else if (ph == 1) norm_phase(p.in[0], p.in[2], nullptr, nullptr, nullptr, M1, p.in[6], mod, 0 * D, 1 * D, XN, nullptr);
    else if (ph == 2) gemm_phase(lds, p, XN, (const bf16_t*)(ws + WS_WF1IN), M1, 2 * DFF, D, EPI_SWIGLU, 1, Hb, 0, 0.f);
    else if (ph == 3) gemm_phase(lds, p, Hb, (const bf16_t*)(ws + WS_WF1OUT), M1, D, DFF, EPI_RESID, 1, XN, 2 * D, 0.5f);
    else if (ph == 4) norm_phase(p.in[0], p.in[2], XN, (const bf16_t*)(ws + WS_CAT), p.out, M1, p.in[9], mod, 3 * D, 4 * D, XN, nullptr);
    else if (ph == 5) gemm_phase(lds, p, XN, (const bf16_t*)(ws + WS_WIN), M1, INP, D, EPI_INPROJ, 1, Hb, 0, 0.f);
    else if (ph == 6) { for (int u = blockIdx.x; u < 256 + 2176; u += gridDim.x) { if (u < 256) gmlp_unit(p, lds, u); else conv_unit(p, u - 256); } }
    else if (ph == 7) scan_phase(p, lds);
    else if (ph == 8) mout_phase(p, lds);
    else if (ph == 9) { }
    else if (ph == 10) gemm_phase(lds, p, (const bf16_t*)(ws + WS_CAT), (const bf16_t*)(ws + WS_WOUT), ML, D, D, EPI_RESID, 1, XN, 5 * D, 1.0f);
    else if (ph == 11) norm_phase(p.out, p.out, XN, nullptr, p.out, ML, p.in[20], mod, 6 * D, 7 * D, XN, nullptr);
    else if (ph == 12) gemm_phase(lds, p, XN, (const bf16_t*)(ws + WS_WF2IN), ML, 2 * DFF, D, EPI_SWIGLU, 1, Hb, 0, 0.f);
    else if (ph == 13) gemm_phase(lds, p, Hb, (const bf16_t*)(ws + WS_WF2OUT), ML, D, DFF, EPI_RESID, 1, XN, 8 * D, 0.5f);
    else if (ph == 14) norm_phase(p.out, p.out, XN, nullptr, nullptr, ML, p.in[23], nullptr, 0, 0, nullptr, p.out);
}

#define RUNPH(n) if (p.ph_lo <= n && n < p.ph_hi) { run_phase<n>(p, lds); if (n + 1 < p.ph_hi) xcd_barrier(xb); }
__global__ void __launch_bounds__(512, 2) hymba_megakernel(Params p) {
    extern __shared__ __attribute__((aligned(16))) unsigned char shm[];
    LAS unsigned char* lds = (LAS unsigned char*)shm;
    cg::grid_group grid = cg::this_grid();
    unsigned* barw = (unsigned*)(p.ws + WS_BAR);
    volatile LAS unsigned* stw = (volatile LAS unsigned*)(lds + LDS_BYTES - 16);
    if (threadIdx.x == 0) { stw[0] = 0u; stw[1] = 0u; }
    __syncthreads();
    XcdBarrier xb = xcd_barrier_post(barw, stw);
    if (p.ph_hi < 0) grid.sync();
    RUNPH(0)
    RUNPH(1) RUNPH(2) RUNPH(3) RUNPH(4) RUNPH(5) RUNPH(6) RUNPH(7) RUNPH(8) RUNPH(10) RUNPH(11) RUNPH(12) RUNPH(13) RUNPH(14)
}

extern "C" void kernel_launch(void* const* d_in, const int* in_sizes, int n_in, void* d_out, int out_size, void* d_ws, size_t ws_size, hipStream_t stream) {
    static int grid = 0;
    if (grid == 0) {
        if (n_in != 24 || out_size != ML * D || ws_size < WS_END) { fprintf(stderr, "kernel_launch: unexpected shapes (n_in %d out %d ws %zu need %zu)\n", n_in, out_size, ws_size, (size_t)WS_END); grid = -1; return; }
        int dev = 0, cus = 0, per_cu = 0;
        hipGetDevice(&dev);
        hipDeviceGetAttribute(&cus, hipDeviceAttributeMultiprocessorCount, dev);
        if (hipFuncSetAttribute((const void*)hymba_megakernel, hipFuncAttributeMaxDynamicSharedMemorySize, LDS_BYTES) != hipSuccess) { fprintf(stderr, "kernel_launch: hipFuncSetAttribute failed\n"); }
        if (hipOccupancyMaxActiveBlocksPerMultiprocessor(&per_cu, (const void*)hymba_megakernel, 512, LDS_BYTES) != hipSuccess || per_cu < 1) per_cu = 1;
        (void)hipGetLastError();
        grid = cus * per_cu;
        fprintf(stderr, "kernel_launch: cus %d per_cu %d grid %d\n", cus, per_cu, grid);
    }
    if (grid < 0) return;
    Params p{};
    for (int i = 0; i < 24; ++i) p.in[i] = (const float*)d_in[i];
    p.out = (float*)d_out; p.ws = (unsigned char*)d_ws;
#if MK_MULTI
    for (int ph = 0; ph < NPH; ++ph) { p.ph_lo = ph; p.ph_hi = ph + 1; hipLaunchKernelGGL(hymba_megakernel, dim3(grid), dim3(512), LDS_BYTES, stream, p); }
#else
    p.ph_lo = 0; p.ph_hi = NPH;
    if (hipMemsetAsync((char*)d_ws + WS_BAR, 0, 16384, stream) != hipSuccess) fprintf(stderr, "kernel_launch: memset of the barrier words failed\n");
    void* args[] = {&p};
    hipError_t e = hipLaunchCooperativeKernel((const void*)hymba_megakernel, dim3(grid), dim3(512), args, LDS_BYTES, stream);
    if (e != hipSuccess) fprintf(stderr, "cooperative launch failed: %s (grid %d)\n", hipGetErrorString(e), grid);
#endif
}
```

```cpp
#include <hip/hip_runtime.h>
#include <hip/hip_cooperative_groups.h>
#include <cstdio>
namespace cg = cooperative_groups;

#ifndef MK_MULTI
#define MK_MULTI 0
#endif

#ifndef PHSEL
#define PHSEL 0xffff
#endif
#define PHON(n) ((PHSEL >> (n)) & 1)
#define LAS __attribute__((address_space(3)))
typedef unsigned short bf16_t;
typedef short bf16x8 __attribute__((ext_vector_type(8)));
typedef float f32x4 __attribute__((ext_vector_type(4)));
typedef unsigned u32x4 __attribute__((ext_vector_type(4)));
typedef unsigned u32x2 __attribute__((ext_vector_type(2)));

constexpr int D = 2048, ML = 32768, MC = 2048, M1 = ML + MC, DFF = 5632, NMODC = 9 * 2048, INP = 5376;
constexpr int NPH = 15;
constexpr int LDS_BYTES = 147456;

constexpr size_t al256(size_t x) { return (x + 255) & ~(size_t)255; }
constexpr size_t WS_WF1IN = 0;
constexpr size_t WS_WF1OUT = WS_WF1IN + (size_t)11264 * 2048 * 2;
constexpr size_t WS_WIN = WS_WF1OUT + (size_t)2048 * 5632 * 2;
constexpr size_t WS_WOUT = WS_WIN + (size_t)INP * 2048 * 2;
constexpr size_t WS_WF2IN = WS_WOUT + (size_t)2048 * 2048 * 2;
constexpr size_t WS_WF2OUT = WS_WF2IN + (size_t)11264 * 2048 * 2;
constexpr size_t WS_MOD = WS_WF2OUT + (size_t)2048 * 5632 * 2;
constexpr size_t WS_XN = al256(WS_MOD + (size_t)9 * NMODC * 4);
constexpr size_t WS_MPREV = WS_XN + (size_t)M1 * 2048 * 2;
constexpr size_t WS_H = al256(WS_MPREV + 64 * 32 * 4);
constexpr size_t WS_ZQK = WS_H;
constexpr size_t WS_V = WS_ZQK + (size_t)M1 * 1024 * 2;
constexpr size_t WS_O = WS_V + (size_t)M1 * 1024 * 2;
constexpr size_t WS_U = WS_O + (size_t)ML * 1024 * 2;
constexpr size_t WS_GV = WS_U + (size_t)ML * 1024 * 2;
constexpr size_t WS_HDIR = WS_U;
constexpr size_t WS_G = WS_GV + (size_t)ML * 1024 * 2;
constexpr size_t WS_Q = WS_G + (size_t)M1 * 16 * 4;
constexpr size_t WS_X1C = al256(WS_H + (size_t)M1 * DFF * 2);
constexpr size_t WS_CAT = WS_X1C + (size_t)MC * 2048 * 4;
constexpr size_t WS_K = WS_CAT + (size_t)ML * 2048 * 2;
constexpr size_t WS_KT = WS_K + (size_t)ML * 512 * 2;
constexpr size_t WS_VT = WS_KT + (size_t)272 * 4 * 128 * 128 * 2;
constexpr size_t WS_BAR = WS_VT + (size_t)272 * 4 * 256 * 128 * 2;
constexpr size_t WS_END = WS_BAR + 16384;
static_assert(WS_Q + (size_t)ML * 512 * 2 <= WS_X1C, "in-proj outputs overflow the H region");

struct Params {
    const float* in[24];
    float* out;
    unsigned char* ws;
    int ph_lo, ph_hi;
};

__device__ __forceinline__ unsigned cvt_pk_bf16(float lo, float hi) { unsigned r; asm volatile("v_cvt_pk_bf16_f32 %0, %1, %2" : "=v"(r) : "v"(lo), "v"(hi)); return r; }
__device__ __forceinline__ float bflo(unsigned u) { return __uint_as_float(u << 16); }
__device__ __forceinline__ float bfhi(unsigned u) { return __uint_as_float(u & 0xffff0000u); }
__device__ __forceinline__ float bfel(const u32x4& v, int c) { const unsigned w = (c >> 1) == 0 ? v.x : (c >> 1) == 1 ? v.y : (c >> 1) == 2 ? v.z : v.w; return (c & 1) ? bfhi(w) : bflo(w); }
__device__ __forceinline__ unsigned us16(const u32x4& v, int c) { const unsigned w = (c >> 1) == 0 ? v.x : (c >> 1) == 1 ? v.y : (c >> 1) == 2 ? v.z : v.w; return (c & 1) ? (w >> 16) : (w & 0xffffu); }
__device__ __forceinline__ float wave_sum(float v) {
#pragma unroll
    for (int o = 32; o; o >>= 1) v += __shfl_xor(v, o);
    return v; }
__device__ __forceinline__ float wave_max(float v) {
#pragma unroll
    for (int o = 32; o; o >>= 1) v = fmaxf(v, __shfl_xor(v, o));
    return v; }
__device__ __forceinline__ float wave_scan_sum(float v, int lane) {
#pragma unroll
    for (int o = 1; o < 64; o <<= 1) { const float t = __shfl_up(v, o); if (lane >= o) v += t; }
    return v; }
__device__ __forceinline__ float wave_scan_max(float v, int lane) {
#pragma unroll
    for (int o = 1; o < 64; o <<= 1) { const float t = __shfl_up(v, o); if (lane >= o) v = fmaxf(v, t); }
    return v; }
__device__ __forceinline__ float fexp2_(float x) { return __builtin_amdgcn_exp2f(x); }
__device__ __forceinline__ float sigmoidf_(float x) { return __builtin_amdgcn_rcpf(1.f + fexp2_(-1.4426950408889634f * x)); }
__device__ __forceinline__ float siluf_(float x) { return x * __builtin_amdgcn_rcpf(1.f + fexp2_(-1.4426950408889634f * x)); }
__device__ __forceinline__ float geluf_(float x) { const float y = x * (-2.3022082f + -0.1029432f * x * x); return x * __builtin_amdgcn_rcpf(1.f + fexp2_(y)); }

#define XB_TMO      128
#define XB_XCNT(j)  (256  + 64 * (j))
#define XB_XSUB(j)  (1280 + 64 * (j))
#define XB_XGEN(j)  (2304 + 64 * (j))
#define XB_TOP      3328
#define XB_TOPGEN   3392
#define XCD_BAR_WORDS 3456
#define XB_SPIN_CAP (1u << 22)
__device__ __forceinline__ unsigned xb_ld(unsigned* p)              { return __hip_atomic_load(p, __ATOMIC_RELAXED, __HIP_MEMORY_SCOPE_AGENT); }
__device__ __forceinline__ unsigned xb_add(unsigned* p, unsigned v) { return __hip_atomic_fetch_add(p, v, __ATOMIC_RELAXED, __HIP_MEMORY_SCOPE_AGENT); }
__device__ __forceinline__ unsigned xb_xcc_id() { return (unsigned)__builtin_amdgcn_s_getreg((3 << 11) | 20) & 0xFu; }
#define XB_SPIN(cond, bar) do { unsigned _sp = 0; while (cond) { __builtin_amdgcn_s_sleep(1); \
    if ((++_sp & 255u) == 0u) { if (xb_ld(&(bar)[XB_TMO])) break; if (_sp > XB_SPIN_CAP) { atomicAdd(&(bar)[XB_TMO], 1u); break; } } } } while (0)
struct XcdBarrier { unsigned* bar; unsigned x; volatile LAS unsigned* st; };
__device__ __forceinline__ XcdBarrier xcd_barrier_post(unsigned* bar, volatile LAS unsigned* st) {
    XcdBarrier b; b.bar = bar; b.x = xb_xcc_id(); b.st = st;
    if (threadIdx.x == 0) (void)xb_add(&bar[XB_XCNT(b.x)], 1u);
    return b;
}
__device__ __forceinline__ void xcd_barrier_complete(unsigned* bar, unsigned x, unsigned& nloc, unsigned& nx) {
    const unsigned G = gridDim.x * gridDim.y * gridDim.z;
    unsigned sum, cnt, mine, sp = 0u;
    for (;;) {
        sum = 0u; cnt = 0u; mine = 0u;
#pragma unroll
        for (unsigned j = 0; j < 16; ++j) { const unsigned c = xb_ld(&bar[XB_XCNT(j)]); sum += c; cnt += (c > 0u) ? 1u : 0u; mine = (j == x) ? c : mine; }
        if (sum == G) break;
        __builtin_amdgcn_s_sleep(1);
        if ((++sp & 255u) == 0u) { if (xb_ld(&bar[XB_TMO])) break; if (sp > XB_SPIN_CAP) { atomicAdd(&bar[XB_TMO], 1u); break; } }
    }
    nloc = mine > 0u ? mine : 1u; nx = cnt > 0u ? cnt : 1u;
}
__device__ __forceinline__ void xcd_barrier(const XcdBarrier& b) {
    asm volatile("s_waitcnt vmcnt(0)" ::: "memory");
    __syncthreads();
    if (threadIdx.x == 0) {
        unsigned* bar = b.bar;
        __builtin_amdgcn_s_waitcnt(0);
        unsigned nloc = b.st[0], nx = b.st[1];
        if (nloc == 0u) { xcd_barrier_complete(bar, b.x, nloc, nx); b.st[0] = nloc; b.st[1] = nx; }
        const unsigned old = xb_add(&bar[XB_XSUB(b.x)], 1u);
        const unsigned gen = old / nloc;
        if (old + 1u == (gen + 1u) * nloc) {
            __builtin_amdgcn_fence(__ATOMIC_RELEASE, "agent");
            asm volatile("s_waitcnt vmcnt(0)" ::: "memory");
            const unsigned og = xb_add(&bar[XB_TOP], 1u);
            const unsigned tg = og / nx;
            if (og + 1u == (tg + 1u) * nx) xb_add(&bar[XB_TOPGEN], 1u);
            else XB_SPIN(xb_ld(&bar[XB_TOPGEN]) == tg, bar);
            __builtin_amdgcn_fence(__ATOMIC_ACQUIRE, "agent");
            xb_add(&bar[XB_XGEN(b.x)], 1u);
            asm volatile("s_waitcnt vmcnt(0)" ::: "memory");
        } else {
            XB_SPIN(xb_ld(&bar[XB_XGEN(b.x)]) == gen, bar);
            __builtin_amdgcn_fence(__ATOMIC_ACQUIRE, "agent");
            asm volatile("s_waitcnt vmcnt(0)" ::: "memory");
        }
    }
    __syncthreads();
}

namespace pg8 {
constexpr int BM = 256, BK = 64, HALF = 128, HTB = HALF * BK * 2, NXCD = 8, WGM = 8;
__device__ __forceinline__ int lds_byte(int r, int c) { const int st = (r >> 4) * 2 + (c >> 5), rr = r & 15, cc = c & 31, ob = rr * 64 + cc * 2; return st * 1024 + (ob ^ (((ob >> 9) & 1) << 5)); }
__device__ __forceinline__ void stage_rc(int b, int& R, int& C) { const int st = b / 1024, sb = b % 1024, swz = sb ^ (((sb >> 9) & 1) << 5); R = (st >> 1) * 16 + swz / 64; C = (st & 1) * 32 + (swz % 64) / 2; }
__device__ __forceinline__ int perm32(int rho) { const int n = rho >> 4, i = rho & 15; return 8 * (i >> 2) + 4 * n + (i & 3); }
struct Unit { int pm, pn, ks; };
struct StaticOrder {
    int nM, nN, nwg, G, c;
    __device__ void init(int M, int N, int G_, int c_) { nM = M / BM; nN = N / BM; nwg = nM * nN; G = G_; c = c_; extra = 0; pre = 0; }
    int extra;
    int pre;
    __device__ bool next(int i, Unit& u) const {
        long L = (long)i * G + c; u.ks = -1;
        if (L < pre) { const int t = (int)L & 63; u.ks = (int)L >> 6; u.pm = nM + (t >> 3); u.pn = t & 7; return true; }
        L -= pre;
        if (L >= nwg + extra) return false;
        if (L >= nwg) { const int j = (int)(L - nwg); const int q = j >> 3; u.pm = nM + (j & 7); u.pn = q < 6 ? q + 2 : 20; return true; }
        int wgid = (int)L; { const int q = nwg / NXCD, r = nwg % NXCD, xcd = wgid % NXCD, off = wgid / NXCD; wgid = (xcd < r ? xcd * (q + 1) : r * (q + 1) + (xcd - r) * q) + off; }
        const int wgm = nN <= 8 ? 4 : WGM;
        const int nig = wgm * nN, gid = wgid / nig, fm = gid * wgm, gsz = (nM - fm) < wgm ? (nM - fm) : wgm;
        u.pm = fm + ((wgid % nig) % gsz); u.pn = (wgid % nig) / gsz; return true;
    }
};
}

enum { EPI_SWIGLU = 0, EPI_RESID = 1, EPI_INPROJ = 2 };
__device__ __forceinline__ void gemm_epilogue(const Params& p, const int epi, bf16_t* const Hp, const int goff, const float coef, const f32x4 (&acc)[2][2][4][2], const pg8::Unit& u, int wr, int wc, int fr, int fq) {
    if (epi == EPI_SWIGLU) {
        const int col0 = u.pn * 128 + wc * 32 + fq * 8;
#pragma unroll
        for (int ai = 0; ai < 2; ++ai)
#pragma unroll
            for (int m = 0; m < 4; ++m) {
                const int row = u.pm * 256 + ai * 128 + wr * 64 + m * 16 + fr;
                float h[8];
#pragma unroll
                for (int n = 0; n < 2; ++n)
#pragma unroll
                    for (int i = 0; i < 4; ++i) h[n * 4 + i] = siluf_(acc[ai][0][m][n][i]) * acc[ai][1][m][n][i];
                u32x4 o; o.x = cvt_pk_bf16(h[0], h[1]); o.y = cvt_pk_bf16(h[2], h[3]); o.z = cvt_pk_bf16(h[4], h[5]); o.w = cvt_pk_bf16(h[6], h[7]);
                *(u32x4*)(Hp + (size_t)row * DFF + col0) = o;
            }
    } else if (epi == EPI_RESID) {
        const bool lat = u.pm < 128;
        const int b = lat ? (u.pm >> 4) : 8;
        const float* gate = (const float*)(p.ws + WS_MOD) + (size_t)b * NMODC + goff;
#pragma unroll
        for (int bj = 0; bj < 2; ++bj) {
            const int col = u.pn * 256 + bj * 128 + wc * 32 + fq * 8;
            const f32x4 g0 = *(const f32x4*)(gate + col) * coef, g1 = *(const f32x4*)(gate + col + 4) * coef;
#pragma unroll
            for (int ai = 0; ai < 2; ++ai)
#pragma unroll
                for (int m = 0; m < 4; ++m) {
                    const int row = u.pm * 256 + ai * 128 + wr * 64 + m * 16 + fr;
                    const f32x4 v0 = acc[ai][bj][m][0] * g0, v1 = acc[ai][bj][m][1] * g1;
                    u32x4 o; o.x = cvt_pk_bf16(v0[0], v0[1]); o.y = cvt_pk_bf16(v0[2], v0[3]); o.z = cvt_pk_bf16(v1[0], v1[1]); o.w = cvt_pk_bf16(v1[2], v1[3]);
                    *(u32x4*)((u.ks >= 0 ? (bf16_t*)(p.ws + WS_CAT) + (size_t)u.ks * MC * D + (size_t)(row - ML) * D : Hp + (size_t)row * D) + col) = o;
                }
        }
    } else {
        const int seg = u.pn >> 2;
        const bool lat = u.pm < 128;
        if (seg < 5) {
            if (seg >= 2 && !lat) return;
            bf16_t* dst = (bf16_t*)(p.ws + (seg == 0 ? WS_ZQK : seg == 1 ? WS_V : seg == 2 ? WS_O : seg == 3 ? WS_U : WS_GV));
#pragma unroll
            for (int ai = 0; ai < 2; ++ai)
#pragma unroll
                for (int m = 0; m < 4; ++m) {
                    const int row = u.pm * 256 + ai * 128 + wr * 64 + m * 16 + fr;
#pragma unroll
                    for (int bj = 0; bj < 2; ++bj) {
                        const int cl = (u.pn & 3) * 256 + bj * 128 + wc * 32 + fq * 8;
                        float h[8];
#pragma unroll
                        for (int n = 0; n < 2; ++n)
#pragma unroll
                            for (int i = 0; i < 4; ++i) { const float a = acc[ai][bj][m][n][i]; h[n * 4 + i] = seg < 2 ? a : seg == 2 ? sigmoidf_(a) : geluf_(a); }
                        u32x4 o; o.x = cvt_pk_bf16(h[0], h[1]); o.y = cvt_pk_bf16(h[2], h[3]); o.z = cvt_pk_bf16(h[4], h[5]); o.w = cvt_pk_bf16(h[6], h[7]);
                        *(u32x4*)(dst + (size_t)row * 1024 + cl) = o;
                    }
                }
        } else if (wc == 0 && fq < 2) {
            const f32x4 bi = *(const f32x4*)(p.in[13] + fq * 4), bfv = *(const f32x4*)(p.in[14] + fq * 4);
#pragma unroll
            for (int ai = 0; ai < 2; ++ai)
#pragma unroll
                for (int m = 0; m < 4; ++m) {
                    const int row = u.pm * 256 + ai * 128 + wr * 64 + m * 16 + fr;
                    const f32x4 li = acc[ai][0][m][0] + bi;
                    const f32x4 xf = acc[ai][0][m][1] + bfv;
                    f32x4 lf;
#pragma unroll
                    for (int i = 0; i < 4; ++i) lf[i] = fminf(xf[i], 0.f) - log1pf(expf(-fabsf(xf[i])));
                    *(f32x4*)((float*)(p.ws + WS_G) + (size_t)row * 16 + fq * 8) = li;
                    *(f32x4*)((float*)(p.ws + WS_G) + (size_t)row * 16 + fq * 8 + 4) = lf;
                }
        }
    }
}

__device__ __forceinline__ void gemm_phase(LAS unsigned char* lds, const Params& p, const bf16_t* gA, const bf16_t* gBt, const int gM, const int gN, const int gK, const int epi, const int perm, bf16_t* const Hp, const int goff, const float coef) {
    using namespace pg8;
    const int tid = threadIdx.x, wid = __builtin_amdgcn_readfirstlane(tid >> 6), lane = tid & 63, wr = wid >> 2, wc = wid & 3, fr = lane & 15, fq = lane >> 4;
    const int K = gK, ntf = K / BK;
    const size_t ksl = (size_t)(K / 4) * 2;
    StaticOrder S; S.init(gM, gN, (int)gridDim.x, (int)blockIdx.x);
    if (epi == EPI_INPROJ) { S.init(ML, gN, (int)gridDim.x, (int)blockIdx.x); S.extra = 56; }
    if (epi == EPI_RESID && gM == M1) { S.init(ML, gN, (int)gridDim.x, (int)blockIdx.x); S.pre = 256; }
    unsigned voffA[2], voffB[2];
#pragma unroll
    for (int i = 0; i < 2; ++i) { int R, C; stage_rc(tid * 16 + i * 8192, R, C); const int Rb = perm ? ((R & ~31) + perm32(R & 31)) : R;
        voffA[i] = (unsigned)(R * K + C) * 2u; voffB[i] = (unsigned)(Rb * K + C) * 2u; }
    const size_t kstep = (size_t)(BK * 2);
    const size_t hstep = (size_t)HALF * K * 2;
    const size_t tstep = 2 * hstep;
    const unsigned ldsw = (unsigned)wid * 1024u;
    const int aoff = lds_byte(wr * 64 + fr, fq * 8), boff = lds_byte(wc * 32 + fr, fq * 8);
#define PG8_SA(b, h) (((b) * 2 + (h)) * HTB)
#define PG8_SB(b, h) ((4 + (b) * 2 + (h)) * HTB)
#define PG8_STAGE(bufoff, gbase, voff) do { _Pragma("unroll") for (int _i = 0; _i < 2; ++_i) \
        __builtin_amdgcn_global_load_lds((const unsigned*)((const char*)(gbase) + (voff)[_i]), (LAS unsigned*)(lds + (bufoff) + ldsw + _i * 8192), 16, 0, 0); } while (0)
#define PG8_LDA(dst, b, h) do { _Pragma("unroll") for (int m = 0; m < 4; ++m) _Pragma("unroll") for (int k = 0; k < 2; ++k) dst[m][k] = *(const LAS bf16x8*)(lds + PG8_SA(b, h) + aoff + m * 2048 + k * 1024); } while (0)
#define PG8_LDB(dst, b, h) do { _Pragma("unroll") for (int n = 0; n < 2; ++n) _Pragma("unroll") for (int k = 0; k < 2; ++k) dst[n][k] = *(const LAS bf16x8*)(lds + PG8_SB(b, h) + boff + n * 2048 + k * 1024); } while (0)
#define PG8_MMA(ai, bj, At, Bt) do { __builtin_amdgcn_s_setprio(1); _Pragma("unroll") for (int m = 0; m < 4; ++m) _Pragma("unroll") for (int n = 0; n < 2; ++n) _Pragma("unroll") for (int k = 0; k < 2; ++k) \
        acc[ai][bj][m][n] = __builtin_amdgcn_mfma_f32_16x16x32_bf16(Bt[n][k], At[m][k], acc[ai][bj][m][n], 0, 0, 0); __builtin_amdgcn_s_setprio(0); } while (0)
#define PG8_WAIT_V(n) asm volatile("s_waitcnt vmcnt(" #n ")" ::: "memory")
#define PG8_WAIT_L(n) asm volatile("s_waitcnt lgkmcnt(" #n ")" ::: "memory")
#define PG8_BAR __builtin_amdgcn_s_barrier()
#define PG8_SCHED __builtin_amdgcn_sched_barrier(0)
    Unit cur, nxt; int ui = 0;
    if (!S.next(0, cur)) return;
    f32x4 acc[2][2][4][2];
#pragma unroll
    for (int a = 0; a < 2; ++a)
#pragma unroll
        for (int b = 0; b < 2; ++b)
#pragma unroll
            for (int m = 0; m < 4; ++m)
#pragma unroll
                for (int n = 0; n < 2; ++n) acc[a][b][m][n] = (f32x4){0.f, 0.f, 0.f, 0.f};
    bf16x8 At[4][2], B0[2][2], B1[2][2];
    const char* cA = (const char*)gA + (size_t)cur.pm * tstep + (cur.ks > 0 ? cur.ks * ksl : 0); const char* cB = (const char*)gBt + (size_t)cur.pn * tstep + (cur.ks > 0 ? cur.ks * ksl : 0);
    PG8_STAGE(PG8_SB(0, 0), cB, voffB); PG8_STAGE(PG8_SB(0, 1), cB + hstep, voffB); PG8_STAGE(PG8_SA(0, 0), cA, voffA); PG8_STAGE(PG8_SA(0, 1), cA + hstep, voffA);
    if (wr == 1) PG8_BAR;
    PG8_WAIT_V(2); PG8_BAR;
    PG8_STAGE(PG8_SB(1, 0), cB + kstep, voffB); PG8_STAGE(PG8_SA(1, 0), cA + kstep, voffA); PG8_STAGE(PG8_SB(1, 1), cB + hstep + kstep, voffB);
    PG8_WAIT_V(6); PG8_BAR;
    for (;;) {
        const bool has_next = S.next(ui + 1, nxt);
        const char* nA = has_next ? (const char*)gA + (size_t)nxt.pm * tstep + (nxt.ks > 0 ? nxt.ks * ksl : 0) : cA; const char* nB = has_next ? (const char*)gBt + (size_t)nxt.pn * tstep + (nxt.ks > 0 ? nxt.ks * ksl : 0) : cB;
        const int nt = cur.ks >= 0 ? ntf / 4 : ntf;
        for (int t = 0; t < nt; t += 2) {
            const bool last = (t == nt - 2);
            const char* a1 = cA + (size_t)(t + 1) * kstep;
            const char* a2 = last ? nA : cA + (size_t)(t + 2) * kstep; const char* b2 = last ? nB : cB + (size_t)(t + 2) * kstep;
            const char* a3 = a2 + kstep; const char* b3 = b2 + kstep;
            PG8_LDB(B0, 0, 0); PG8_LDB(B1, 0, 1); PG8_SCHED; PG8_LDA(At, 0, 0); PG8_STAGE(PG8_SA(1, 1), a1 + hstep, voffA);
            PG8_WAIT_V(8); PG8_WAIT_L(0); PG8_BAR; PG8_MMA(0, 0, At, B0); PG8_MMA(0, 1, At, B1); PG8_BAR; PG8_SCHED;
            PG8_LDA(At, 0, 1); PG8_STAGE(PG8_SB(0, 0), b2, voffB); PG8_STAGE(PG8_SB(0, 1), b2 + hstep, voffB); PG8_STAGE(PG8_SA(0, 0), a2, voffA);
            PG8_WAIT_V(8); PG8_WAIT_L(0); PG8_BAR; PG8_MMA(1, 0, At, B0); PG8_MMA(1, 1, At, B1); PG8_BAR; PG8_SCHED;
            PG8_LDB(B0, 1, 0); PG8_LDB(B1, 1, 1); PG8_SCHED; PG8_LDA(At, 1, 0); PG8_STAGE(PG8_SA(0, 1), a2 + hstep, voffA);
            PG8_WAIT_V(8); PG8_WAIT_L(0); PG8_BAR; PG8_MMA(0, 0, At, B0); PG8_MMA(0, 1, At, B1); PG8_BAR; PG8_SCHED;
            PG8_LDA(At, 1, 1); PG8_STAGE(PG8_SB(1, 0), b3, voffB); PG8_STAGE(PG8_SB(1, 1), b3 + hstep, voffB); PG8_STAGE(PG8_SA(1, 0), a3, voffA);
            PG8_WAIT_V(8); PG8_WAIT_L(0); PG8_BAR; PG8_MMA(1, 0, At, B0); PG8_MMA(1, 1, At, B1); PG8_BAR; PG8_SCHED;
        }
        if (wr == 0) PG8_BAR;
        gemm_epilogue(p, epi, Hp, goff, coef, acc, cur, wr, wc, fr, fq);
        if (!has_next) break;
#pragma unroll
        for (int a = 0; a < 2; ++a)
#pragma unroll
            for (int b = 0; b < 2; ++b)
#pragma unroll
                for (int m = 0; m < 4; ++m)
#pragma unroll
                    for (int n = 0; n < 2; ++n) acc[a][b][m][n] = (f32x4){0.f, 0.f, 0.f, 0.f};
        cur = nxt; cA = nA; cB = nB; ++ui;
        if (wr == 1) PG8_BAR;
    }
    PG8_WAIT_V(0);
    PG8_BAR;
#undef PG8_SA
#undef PG8_SB
#undef PG8_STAGE
#undef PG8_LDA
#undef PG8_LDB
#undef PG8_MMA
#undef PG8_WAIT_V
#undef PG8_WAIT_L
#undef PG8_BAR
#undef PG8_SCHED
}

__device__ __forceinline__ void adaln_unit(const Params& p, LAS float* sm, int unit) {
    const int t = threadIdx.x;
    for (int idx = t; idx < 9 * 2048; idx += 512) { const int i = idx >> 11, k = idx & 2047; const float v = (i < 8) ? p.in[1][i * 2048 + k] : p.in[3][k]; sm[k * 9 + i] = siluf_(v); }
    __syncthreads();
    const int cg4 = (t % 18) * 4, ksub = t / 18;
    const float* w = p.in[4] + (size_t)unit * 72 + cg4;
    float acc[9][4];
#pragma unroll
    for (int i = 0; i < 9; ++i)
#pragma unroll
        for (int j = 0; j < 4; ++j) acc[i][j] = 0.f;
    if (t < 504) {
#pragma unroll 4
        for (int k = ksub; k < 2048; k += 28) {
            const f32x4 wv = *(const f32x4*)(w + (size_t)k * NMODC);
#pragma unroll
            for (int i = 0; i < 9; ++i) { const float s = sm[k * 9 + i];
#pragma unroll
                for (int j = 0; j < 4; ++j) acc[i][j] += s * wv[j]; }
        }
    }
    __syncthreads();
    if (t < 504) {
#pragma unroll
        for (int i = 0; i < 9; ++i)
#pragma unroll
            for (int j = 0; j < 4; ++j) sm[(ksub * 9 + i) * 72 + cg4 + j] = acc[i][j];
    }
    __syncthreads();
    float* mod = (float*)(p.ws + WS_MOD);
    for (int o = t; o < 9 * 72; o += 512) { const int i = o / 72, c = o - i * 72; float s = 0.f;
        for (int ks = 0; ks < 28; ++ks) s += sm[(ks * 9 + i) * 72 + c];
        mod[(size_t)i * NMODC + unit * 72 + c] = s + p.in[5][unit * 72 + c]; }
    __syncthreads();
}

__device__ __forceinline__ int colmap(int map, int n) {
    if (map == 0) return n;
    if (map == 1) { const int pn = n >> 8, rem = n & 255; return (rem >> 7) * DFF + pn * 128 + (rem & 127); }
    return n < 3072 ? n : (n < 5120 ? n + 16 : (n < 5136 ? n - 2048 : -1));
}

__device__ __forceinline__ void wtile_unit(const Params& p, LAS float* sm, int tile) {
    const float* src; bf16_t* dst; int K, ldw, map, local;
    if (tile < 2816) { src = p.in[7]; dst = (bf16_t*)(p.ws + WS_WF1IN); K = 2048; ldw = 11264; map = 1; local = tile; }
    else if (tile < 4224) { src = p.in[8]; dst = (bf16_t*)(p.ws + WS_WF1OUT); K = 5632; ldw = 2048; map = 0; local = tile - 2816; }
    else if (tile < 5568) { src = p.in[10]; dst = (bf16_t*)(p.ws + WS_WIN); K = 2048; ldw = 5136; map = 2; local = tile - 4224; }
    else if (tile < 6080) { src = p.in[19]; dst = (bf16_t*)(p.ws + WS_WOUT); K = 2048; ldw = 2048; map = 0; local = tile - 5568; }
    else if (tile < 8896) { src = p.in[21]; dst = (bf16_t*)(p.ws + WS_WF2IN); K = 2048; ldw = 11264; map = 1; local = tile - 6080; }
    else { src = p.in[22]; dst = (bf16_t*)(p.ws + WS_WF2OUT); K = 5632; ldw = 2048; map = 0; local = tile - 8896; }
    const int nkt = K >> 7, ntile = local / nkt, kt = local - ntile * nkt;
    const int n0 = ntile * 64, k0 = kt * 128;
    const int t = threadIdx.x;
    {
        const int n4 = (t & 15) * 4, kr = t >> 4;
        const int col = colmap(map, n0 + n4);
#pragma unroll
        for (int i = 0; i < 4; ++i) { const int k = kr + 32 * i;
            f32x4 v = (f32x4){0.f, 0.f, 0.f, 0.f};
            if (col >= 0) v = *(const f32x4*)(src + (size_t)(k0 + k) * ldw + col);
#pragma unroll
            for (int j = 0; j < 4; ++j) sm[k * 65 + n4 + j] = v[j]; }
    }
    __syncthreads();
#pragma unroll
    for (int it = 0; it < 2; ++it) {
        const int n = t >> 3, k8 = (t & 7) * 8 + 64 * it;
        float f[8];
#pragma unroll
        for (int j = 0; j < 8; ++j) f[j] = sm[(k8 + j) * 65 + n];
        u32x4 o; o.x = cvt_pk_bf16(f[0], f[1]); o.y = cvt_pk_bf16(f[2], f[3]); o.z = cvt_pk_bf16(f[4], f[5]); o.w = cvt_pk_bf16(f[6], f[7]);
        *(u32x4*)(dst + (size_t)(n0 + n) * K + k0 + k8) = o;
    }
    __syncthreads();
}

__device__ __forceinline__ void norm_phase(const float* lat, const float* ctxp, const bf16_t* dbuf, const bf16_t* dbuf2, const bf16_t* dpart, float* xout, int nrows, const float* gw, const float* mod, int shift_off, int scale_off, bf16_t* outb, float* outf) {
    const int wid = threadIdx.x >> 6, lane = threadIdx.x & 63;
    const int nw = gridDim.x * 8, gwv = blockIdx.x * 8 + wid, per = (nrows + nw - 1) / nw;
    const int rb = gwv * per, re = (rb + per < nrows) ? rb + per : nrows;
    if (rb >= re) return;
    int cur_b = -1;
    f32x4 ca[8], cb[8], v[8]; u32x2 dv[8], dw[8];
    { const float* src = rb < ML ? lat + (size_t)rb * D : ctxp + (size_t)(rb - ML) * D;
#pragma unroll
      for (int i = 0; i < 8; ++i) { v[i] = __builtin_nontemporal_load((const f32x4*)(src + i * 256 + lane * 4)); dv[i] = (u32x2){0u, 0u}; if (dbuf && !dpart) dv[i] = *(const u32x2*)(dbuf + (size_t)rb * D + i * 256 + lane * 4);
          dw[i] = (u32x2){0u, 0u}; if (dbuf2) dw[i] = __builtin_nontemporal_load((const u32x2*)(dbuf2 + (size_t)rb * D + i * 256 + lane * 4)); } }
    for (int row = rb; row < re; ++row) {
        const int b = row < ML ? (row >> 12) : 8;
        if (b != cur_b) {
            cur_b = b;
#pragma unroll
            for (int i = 0; i < 8; ++i) { const int col = i * 256 + lane * 4; ca[i] = *(const f32x4*)(gw + col); cb[i] = (f32x4){0.f, 0.f, 0.f, 0.f};
                if (mod) { const f32x4 sc = *(const f32x4*)(mod + (size_t)b * NMODC + scale_off + col); cb[i] = *(const f32x4*)(mod + (size_t)b * NMODC + shift_off + col); ca[i] = ca[i] * (sc + 1.f); } }
        }
        f32x4 nv[8]; u32x2 nd[8], nw2[8];
        if (row + 1 < re) { const int r1 = row + 1; const float* src = r1 < ML ? lat + (size_t)r1 * D : ctxp + (size_t)(r1 - ML) * D;
#pragma unroll
            for (int i = 0; i < 8; ++i) { nv[i] = __builtin_nontemporal_load((const f32x4*)(src + i * 256 + lane * 4)); nd[i] = (u32x2){0u, 0u}; if (dbuf && !dpart) nd[i] = *(const u32x2*)(dbuf + (size_t)r1 * D + i * 256 + lane * 4);
                nw2[i] = (u32x2){0u, 0u}; if (dbuf2) nw2[i] = __builtin_nontemporal_load((const u32x2*)(dbuf2 + (size_t)r1 * D + i * 256 + lane * 4)); } }
        else {
#pragma unroll
            for (int i = 0; i < 8; ++i) { nv[i] = (f32x4){0.f, 0.f, 0.f, 0.f}; nd[i] = (u32x2){0u, 0u}; nw2[i] = (u32x2){0u, 0u}; } }
        if (dpart && row < ML) {
#pragma unroll
            for (int i = 0; i < 8; ++i) { const u32x2 e = *(const u32x2*)(dbuf + (size_t)row * D + i * 256 + lane * 4);
                v[i][0] += bflo(e.x); v[i][1] += bfhi(e.x); v[i][2] += bflo(e.y); v[i][3] += bfhi(e.y); }
        }
        if (dpart && row >= ML) {
#pragma unroll
            for (int ks = 0; ks < 4; ++ks)
#pragma unroll
                for (int i = 0; i < 8; ++i) { const u32x2 e = *(const u32x2*)(dpart + (size_t)ks * MC * D + (size_t)(row - ML) * D + i * 256 + lane * 4);
                    v[i][0] += bflo(e.x); v[i][1] += bfhi(e.x); v[i][2] += bflo(e.y); v[i][3] += bfhi(e.y); if (i == 7) asm volatile("" ::: "memory"); }
        }
        float ss = 0.f;
#pragma unroll
        for (int i = 0; i < 8; ++i) {
            v[i][0] += bflo(dv[i].x) + bflo(dw[i].x); v[i][1] += bfhi(dv[i].x) + bfhi(dw[i].x); v[i][2] += bflo(dv[i].y) + bflo(dw[i].y); v[i][3] += bfhi(dv[i].y) + bfhi(dw[i].y);
            ss += v[i][0] * v[i][0] + v[i][1] * v[i][1] + v[i][2] * v[i][2] + v[i][3] * v[i][3]; }
        ss = wave_sum(ss);
        const float rstd = rsqrtf(ss * (1.f / 2048.f) + 1e-6f);
#pragma unroll
        for (int i = 0; i < 8; ++i) {
            const int col = i * 256 + lane * 4;
            if (xout && row < ML) __builtin_nontemporal_store(v[i], (f32x4*)(xout + (size_t)row * D + col));
            const f32x4 y = v[i] * rstd * ca[i] + cb[i];
            if (outb) { u32x2 o; o.x = cvt_pk_bf16(y[0], y[1]); o.y = cvt_pk_bf16(y[2], y[3]); *(u32x2*)(outb + (size_t)row * D + col) = o; }
            else __builtin_nontemporal_store(y, (f32x4*)(outf + (size_t)row * D + col));
        }
#pragma unroll
        for (int i = 0; i < 8; ++i) { v[i] = nv[i]; dv[i] = nd[i]; dw[i] = nw2[i]; }
    }
}

__device__ __forceinline__ void conv_unit(const Params& p, int unit) {
    const int t = threadIdx.x, c8 = t & 31, t8 = t >> 5;
    const int ck = unit >> 3, cb = unit & 7;
    const int ch0 = cb * 256 + c8 * 8;
    const int row0 = ck * 128 + t8 * 8;
    const bool lat = ck < 256;
    const bf16_t* ZQK = (const bf16_t*)(p.ws + WS_ZQK);
    const bf16_t* V = (const bf16_t*)(p.ws + WS_V);
    bf16_t* Q = (bf16_t*)(p.ws + WS_Q); bf16_t* Kn = (bf16_t*)(p.ws + WS_K); bf16_t* KT = (bf16_t*)(p.ws + WS_KT); bf16_t* VT = (bf16_t*)(p.ws + WS_VT);
    if (cb < 4) {
        if (!lat && cb < 2) return;
        int seq_lo, seq_hi;
        if (lat) { seq_lo = (ck >> 5) * 4096; seq_hi = seq_lo + 4096; } else { seq_lo = ML + ((ck - 256) >> 1) * 256; seq_hi = seq_lo + 256; }
        u32x4 z[12];
#pragma unroll
        for (int i = 0; i < 12; ++i) { const int r = row0 - 2 + i; z[i] = (u32x4){0u, 0u, 0u, 0u}; if (r >= seq_lo && r < seq_hi) z[i] = *(const u32x4*)(ZQK + (size_t)r * 1024 + ch0); }
        const float* cw = p.in[11]; const float* cbias = p.in[12];
        float y[8][8];
#pragma unroll
        for (int c = 0; c < 8; ++c) {
            const float w0 = cw[0 * 1024 + ch0 + c], w1 = cw[1 * 1024 + ch0 + c], w2 = cw[2 * 1024 + ch0 + c], w3 = cw[3 * 1024 + ch0 + c], w4 = cw[4 * 1024 + ch0 + c], bb = cbias[ch0 + c];
#pragma unroll
            for (int r = 0; r < 8; ++r) {
                float a = bb + bfel(z[r], c) * w0 + bfel(z[r + 1], c) * w1 + bfel(z[r + 2], c) * w2 + bfel(z[r + 3], c) * w3 + bfel(z[r + 4], c) * w4;
                a = siluf_(a);
                y[r][c] = (cb < 2) ? a * 0.08838834764831845f : a;
            }
        }
        if (lat) {
            bf16_t* dn = (cb < 2) ? Q + (size_t)row0 * 512 + ch0 : Kn + (size_t)row0 * 512 + (ch0 - 512);
#pragma unroll
            for (int r = 0; r < 8; ++r) { u32x4 o; o.x = cvt_pk_bf16(y[r][0], y[r][1]); o.y = cvt_pk_bf16(y[r][2], y[r][3]); o.z = cvt_pk_bf16(y[r][4], y[r][5]); o.w = cvt_pk_bf16(y[r][6], y[r][7]);
                *(u32x4*)(dn + (size_t)r * 512) = o; }
        }
        if (cb >= 2) {
            const int kc = ch0 - 512, h = kc >> 7, dk = kc & 127;
            bf16_t* dt = KT + ((size_t)(ck * 4 + h) * 128 + dk) * 128 + t8 * 8;
#pragma unroll
            for (int c = 0; c < 8; ++c) { u32x4 o; o.x = cvt_pk_bf16(y[0][c], y[1][c]); o.y = cvt_pk_bf16(y[2][c], y[3][c]); o.z = cvt_pk_bf16(y[4][c], y[5][c]); o.w = cvt_pk_bf16(y[6][c], y[7][c]);
                *(u32x4*)(dt + (size_t)c * 128) = o; }
        }
    } else {
        const int vch = ch0 - 1024, h = vch >> 8, dv = vch & 255;
        u32x4 z[8];
#pragma unroll
        for (int r = 0; r < 8; ++r) z[r] = *(const u32x4*)(V + (size_t)(row0 + r) * 1024 + vch);
        bf16_t* dt = VT + ((size_t)(ck * 4 + h) * 256 + dv) * 128 + t8 * 8;
#pragma unroll
        for (int c = 0; c < 8; ++c) { u32x4 o;
            o.x = us16(z[0], c) | (us16(z[1], c) << 16); o.y = us16(z[2], c) | (us16(z[3], c) << 16); o.z = us16(z[4], c) | (us16(z[5], c) << 16); o.w = us16(z[6], c) | (us16(z[7], c) << 16);
            *(u32x4*)(dt + (size_t)c * 128) = o; }
    }
}

__device__ __forceinline__ void gmlp_unit(const Params& p, LAS unsigned char* lds, int unit) {
    LAS bf16_t* Wt = (LAS bf16_t*)lds;
    LAS bf16_t* vnT = (LAS bf16_t*)(lds + 34816);
    LAS float* rstd = (LAS float*)(lds + 69632);
    const int t = threadIdx.x, wid = t >> 6, lane = t & 63, fr = lane & 15, fq = lane >> 4;
    const int r0 = unit * 128;
    const bf16_t* U = (const bf16_t*)(p.ws + WS_U); const bf16_t* GV = (const bf16_t*)(p.ws + WS_GV); bf16_t* CAT = (bf16_t*)(p.ws + WS_CAT);
    for (int q = wid; q < 128; q += 8) {
        float ss = 0.f;
#pragma unroll
        for (int i = 0; i < 2; ++i) { const u32x4 v = *(const u32x4*)(GV + (size_t)(r0 + q) * 1024 + i * 512 + lane * 8);
#pragma unroll
            for (int c = 0; c < 8; ++c) { const float f = bfel(v, c); ss += f * f; } }
        ss = wave_sum(ss);
        if (lane == 0) rstd[q] = rsqrtf(ss * (1.f / 1024.f) + 1e-6f);
    }
    __syncthreads();
    for (int g = 0; g < 8; ++g) {
        const float* ws_ = p.in[17] + (size_t)g * 128 * 128;
#pragma unroll
        for (int i = 0; i < 8; ++i) { const int idx = t + 512 * i, pr = idx >> 5, q4 = (idx & 31) * 4; const f32x4 v = *(const f32x4*)(ws_ + pr * 128 + q4);
            u32x2 o; o.x = cvt_pk_bf16(v[0], v[1]); o.y = cvt_pk_bf16(v[2], v[3]); *(LAS u32x2*)(Wt + pr * 136 + q4) = o; }
        const float* gn = p.in[16] + g * 128;
#pragma unroll
        for (int i = 0; i < 4; ++i) { const int d8 = (t & 15) * 8, q = (t >> 4) + 32 * i; const u32x4 v = *(const u32x4*)(GV + (size_t)(r0 + q) * 1024 + g * 128 + d8); const float rs = rstd[q];
#pragma unroll
            for (int c = 0; c < 8; ++c) { const float f = bfel(v, c) * rs * gn[d8 + c]; vnT[(d8 + c) * 136 + q] = (bf16_t)(cvt_pk_bf16(f, 0.f) & 0xffffu); } }
        __syncthreads();
        f32x4 acc[8];
#pragma unroll
        for (int nb = 0; nb < 8; ++nb) acc[nb] = (f32x4){0.f, 0.f, 0.f, 0.f};
#pragma unroll
        for (int kk = 0; kk < 4; ++kk) { const bf16x8 a = *(const LAS bf16x8*)(Wt + (16 * wid + fr) * 136 + kk * 32 + fq * 8);
#pragma unroll
            for (int nb = 0; nb < 8; ++nb) { const bf16x8 bv = *(const LAS bf16x8*)(vnT + (nb * 16 + fr) * 136 + kk * 32 + fq * 8);
                acc[nb] = __builtin_amdgcn_mfma_f32_16x16x32_bf16(bv, a, acc[nb], 0, 0, 0); } }
        const int pp = 16 * wid + fr; const float bs = p.in[18][g * 128 + pp];
#pragma unroll
        for (int nb = 0; nb < 8; ++nb) { const int d = nb * 16 + fq * 4; const u32x2 uu = *(const u32x2*)(U + (size_t)(r0 + pp) * 1024 + g * 128 + d);
            u32x2 o; o.x = cvt_pk_bf16(bflo(uu.x) * (acc[nb][0] + bs), bfhi(uu.x) * (acc[nb][1] + bs)); o.y = cvt_pk_bf16(bflo(uu.y) * (acc[nb][2] + bs), bfhi(uu.y) * (acc[nb][3] + bs));
            *(u32x2*)(CAT + (size_t)(r0 + pp) * 2048 + 1024 + g * 128 + d) = o; }
        __syncthreads();
    }
}

__device__ __forceinline__ int scan_chunk(int s, int dir, int b) { if (s < 2) return 256 + 2 * b + (dir ? 1 - s : s); const int li = s - 2; return 32 * b + (dir ? 31 - li : li); }

__device__ __forceinline__ void scan_issue(const Params& p, int s, int dir, int b, int h, int slice, u32x4 (&kreg)[4], u32x4 (&vreg)[2]) {
    const int t = threadIdx.x;
    const int ck = scan_chunk(s, dir, b);
    const bf16_t* kt = (const bf16_t*)(p.ws + WS_KT) + (size_t)(ck * 4 + h) * 128 * 128;
#pragma unroll
    for (int i = 0; i < 4; ++i) { const int idx = t + 512 * i; kreg[i] = *(const u32x4*)(kt + (idx >> 4) * 128 + (idx & 15) * 8); }
    const bf16_t* vt = (const bf16_t*)(p.ws + WS_VT) + ((size_t)(ck * 4 + h) * 256 + slice * 64) * 128;
#pragma unroll
    for (int i = 0; i < 2; ++i) { const int idx = t + 512 * i; vreg[i] = *(const u32x4*)(vt + (idx >> 4) * 128 + (idx & 15) * 8); }
}

__device__ __forceinline__ void scan_phase(const Params& p, LAS unsigned char* lds) {
    LAS float* wls = (LAS float*)(lds + 113152);
    LAS float* scs = (LAS float*)(lds + 113152 + 17408);
    const int t = threadIdx.x, wid = t >> 6, lane = t & 63, fr = lane & 15, fq = lane >> 4;
    bf16_t* CP = (bf16_t*)(p.ws + WS_XN); float* MP = (float*)(p.ws + WS_MPREV);
    const float* G = (const float*)(p.ws + WS_G);
    for (int u = blockIdx.x; u < 256; u += gridDim.x) {
        const int chain = u >> 2, slice = u & 3, dir = chain & 1, bh = chain >> 1, h = bh & 3, b = bh >> 2;
        u32x4 kreg[4], vreg[2];
        scan_issue(p, 0, dir, b, h, slice, kreg, vreg);
        for (int s = wid; s < 34; s += 8) {
            const int ck = scan_chunk(s, dir, b);
            const int p0 = 2 * lane, t0 = dir ? 127 - p0 : p0, t1 = dir ? 126 - p0 : p0 + 1;
            const float* g = G + (size_t)ck * 128 * 16 + dir * 8 + h;
            const float gi0 = g[t0 * 16], gi1 = g[t1 * 16], gf0 = g[t0 * 16 + 4], gf1 = g[t1 * 16 + 4];
            const float P = wave_scan_sum(gf0 + gf1, lane);
            const float total = __shfl(P, 63);
            const float g0 = total - (P - gf1) + gi0, g1 = total - P + gi1;
            const float mloc = wave_max(fmaxf(g0, g1));
            wls[s * 128 + t0] = g0; wls[s * 128 + t1] = g1;
            if (lane == 0) { scs[s * 4 + 2] = total; scs[s * 4 + 3] = mloc; }
        }
        __syncthreads();
        if (t == 0) {
            float m = 0.f;
            for (int s = 0; s < 34; ++s) { const float total = scs[s * 4 + 2], mloc = scs[s * 4 + 3]; const float m_new = fmaxf(total + m, mloc);
                scs[s * 4 + 0] = __expf(total + m - m_new); scs[s * 4 + 1] = m; scs[s * 4 + 2] = m_new; m = m_new; }
        }
        __syncthreads();
        for (int idx = t; idx < 34 * 128; idx += 512) wls[idx] = __expf(wls[idx] - scs[(idx >> 7) * 4 + 2]);
        __syncthreads();
        f32x4 st[5];
#pragma unroll
        for (int nb = 0; nb < 5; ++nb) st[nb] = (f32x4){0.f, 0.f, 0.f, 0.f};
        for (int s = 0; s < 34; ++s) {
            LAS bf16_t* kT = (LAS bf16_t*)(lds + (s & 1) * 56576);
            LAS bf16_t* wvT = (LAS bf16_t*)(lds + (s & 1) * 56576 + 34816);
            LAS float* wb = wls + s * 128;
#pragma unroll
            for (int i = 0; i < 4; ++i) { const int idx = t + 512 * i; *(LAS u32x4*)(kT + (idx >> 4) * 136 + (idx & 15) * 8) = kreg[i]; }
#pragma unroll
            for (int i = 0; i < 2; ++i) { const int idx = t + 512 * i, r = idx >> 4, c8 = (idx & 15) * 8;
                const f32x4 w0 = *(const LAS f32x4*)(wb + c8), w1 = *(const LAS f32x4*)(wb + c8 + 4);
                u32x4 o; o.x = cvt_pk_bf16(bflo(vreg[i].x) * w0[0], bfhi(vreg[i].x) * w0[1]); o.y = cvt_pk_bf16(bflo(vreg[i].y) * w0[2], bfhi(vreg[i].y) * w0[3]);
                o.z = cvt_pk_bf16(bflo(vreg[i].z) * w1[0], bfhi(vreg[i].z) * w1[1]); o.w = cvt_pk_bf16(bflo(vreg[i].w) * w1[2], bfhi(vreg[i].w) * w1[3]);
                *(LAS u32x4*)(wvT + r * 136 + c8) = o; }
            if (t < 256) { const int r = 64 + (t >> 4), c8 = (t & 15) * 8; u32x4 o = (u32x4){0u, 0u, 0u, 0u};
                if (r == 64) { const f32x4 w0 = *(const LAS f32x4*)(wb + c8), w1 = *(const LAS f32x4*)(wb + c8 + 4);
                    o.x = cvt_pk_bf16(w0[0], w0[1]); o.y = cvt_pk_bf16(w0[2], w0[3]); o.z = cvt_pk_bf16(w1[0], w1[1]); o.w = cvt_pk_bf16(w1[2], w1[3]); }
                *(LAS u32x4*)(wvT + r * 136 + c8) = o; }
            const int ck = scan_chunk(s, dir, b);
            if (s + 1 < 34) scan_issue(p, s + 1, dir, b, h, slice, kreg, vreg);
            __syncthreads();
            const float decay = scs[s * 4];
            if (s >= 2) {
                const int cc = ck - 32 * b;
                bf16_t* cp = CP + (size_t)(chain * 32 + cc) * (272 * 128);
                const int col = 16 * wid + 4 * fq;
#pragma unroll
                for (int nb = 0; nb < 4; ++nb) { u32x2 o; o.x = cvt_pk_bf16(st[nb][0], st[nb][1]); o.y = cvt_pk_bf16(st[nb][2], st[nb][3]); *(u32x2*)(cp + (size_t)(slice * 64 + nb * 16 + fr) * 128 + col) = o; }
                if (slice == 0) { u32x2 o; o.x = cvt_pk_bf16(st[4][0], st[4][1]); o.y = cvt_pk_bf16(st[4][2], st[4][3]); *(u32x2*)(cp + (size_t)(256 + fr) * 128 + col) = o;
                    if (t == 0) MP[chain * 32 + cc] = scs[s * 4 + 1]; }
            }
            f32x4 acc[5];
#pragma unroll
            for (int nb = 0; nb < 5; ++nb) acc[nb] = (f32x4){0.f, 0.f, 0.f, 0.f};
#pragma unroll
            for (int kk = 0; kk < 4; ++kk) { const bf16x8 a = *(const LAS bf16x8*)(kT + (16 * wid + fr) * 136 + kk * 32 + fq * 8);
#pragma unroll
                for (int nb = 0; nb < 5; ++nb) { const bf16x8 bv = *(const LAS bf16x8*)(wvT + (nb * 16 + fr) * 136 + kk * 32 + fq * 8);
                    acc[nb] = __builtin_amdgcn_mfma_f32_16x16x32_bf16(a, bv, acc[nb], 0, 0, 0); } }
#pragma unroll
            for (int nb = 0; nb < 5; ++nb) st[nb] = st[nb] * decay + acc[nb];
        }
        __syncthreads();
    }
}

__device__ __forceinline__ void mout_issue(const Params& p, int u, u32x4 (&kreg)[4], bf16x8 (&qf)[4], float (&gg)[5]) {
    const int t = threadIdx.x, wid = t >> 6, lane = t & 63, fr = lane & 15, fq = lane >> 4;
    const int dir = u & 1, cc = (u >> 1) & 31, bh = u >> 6, h = bh & 3, b = bh >> 2, chain = bh * 2 + dir, ck = 32 * b + cc, r0 = ck * 128;
    const bf16_t* Q = (const bf16_t*)(p.ws + WS_Q); const bf16_t* Kn = (const bf16_t*)(p.ws + WS_K);
#pragma unroll
    for (int i = 0; i < 4; ++i) { const int idx = t + 512 * i, r = idx >> 4, c8 = (idx & 15) * 8; kreg[i] = *(const u32x4*)(Kn + (size_t)(r0 + r) * 512 + h * 128 + c8); }
#pragma unroll
    for (int kk = 0; kk < 4; ++kk) qf[kk] = *(const bf16x8*)(Q + (size_t)(r0 + 16 * wid + fr) * 512 + h * 128 + kk * 32 + fq * 8);
    if (wid == 0) {
        const int p0 = 2 * lane, t0 = dir ? 127 - p0 : p0, t1 = dir ? 126 - p0 : p0 + 1;
        const float* g = (const float*)(p.ws + WS_G) + (size_t)r0 * 16 + dir * 8 + h;
        gg[0] = g[t0 * 16]; gg[1] = g[t1 * 16]; gg[2] = g[t0 * 16 + 4]; gg[3] = g[t1 * 16 + 4];
        gg[4] = ((const float*)(p.ws + WS_MPREV))[chain * 32 + cc];
    }
}

__device__ __forceinline__ void mout_phase(const Params& p, LAS unsigned char* lds) {
    LAS bf16_t* T = (LAS bf16_t*)lds;
    LAS bf16_t* sb = (LAS bf16_t*)(lds + 73984);
    LAS float* fv = (LAS float*)(lds + 73984 + 34816);
    const int t = threadIdx.x, wid = t >> 6, lane = t & 63, fr = lane & 15, fq = lane >> 4;
    const bf16_t* CP = (const bf16_t*)(p.ws + WS_XN);
    const bf16_t* VT = (const bf16_t*)(p.ws + WS_VT);
    u32x4 kreg[4]; bf16x8 qf[4]; float gg[5] = {0.f, 0.f, 0.f, 0.f, 0.f};
    int u = 2 * blockIdx.x;
    if (u < 2048) mout_issue(p, u, kreg, qf, gg);
    for (; u < 2048; u = (u & 1) ? u - 1 + 2 * (int)gridDim.x : u + 1) {
        const int dir = u & 1, cc = (u >> 1) & 31, bh = u >> 6, h = bh & 3, b = bh >> 2, chain = bh * 2 + dir, ck = 32 * b + cc, r0 = ck * 128;
        if (wid == 0) {
            const int p0 = 2 * lane, t0 = dir ? 127 - p0 : p0, t1 = dir ? 126 - p0 : p0 + 1;
            const float gi0 = gg[0], gi1 = gg[1], gf0 = gg[2], gf1 = gg[3], mst = gg[4];
            const float P = wave_scan_sum(gf0 + gf1, lane);
            const float b1 = P, b0 = P - gf1;
            const float c0 = gi0 - b0, c1 = gi1 - b1;
            const float Mi = wave_scan_max(fmaxf(c0, c1), lane);
            float Me = __shfl_up(Mi, 1); if (lane == 0) Me = -INFINITY;
            const float pm0 = fmaxf(Me, c0), pm1 = Mi;
            const float mt0 = fmaxf(b0 + mst, b0 + pm0), mt1 = fmaxf(b1 + mst, b1 + pm1);
            fv[t0] = b0 - mt0; fv[t1] = b1 - mt1;
            fv[128 + t0] = c0; fv[128 + t1] = c1;
            fv[256 + t0] = __expf(b0 + mst - mt0); fv[256 + t1] = __expf(b1 + mst - mt1);
            fv[384 + t0] = __expf(-mt0); fv[384 + t1] = __expf(-mt1);
        }
#pragma unroll
        for (int i = 0; i < 4; ++i) { const int idx = t + 512 * i, r = idx >> 4, c8 = (idx & 15) * 8; *(LAS u32x4*)(T + r * 136 + c8) = kreg[i]; }
        u32x4 creg[9];
        { const bf16_t* cp = CP + (size_t)(chain * 32 + cc) * (272 * 128);
#pragma unroll
          for (int i = 0; i < 9; ++i) { const int idx = t + 512 * i; creg[i] = (u32x4){0u, 0u, 0u, 0u}; if (idx < 272 * 16) creg[i] = *(const u32x4*)(cp + (size_t)(idx >> 4) * 128 + (idx & 15) * 8); } }
        __syncthreads();
        const int j = 16 * wid + fr;
        {
            f32x4 S[8];
#pragma unroll
            for (int nb = 0; nb < 8; ++nb) S[nb] = (f32x4){0.f, 0.f, 0.f, 0.f};
#pragma unroll
            for (int kk = 0; kk < 4; ++kk)
#pragma unroll
                for (int nb = 0; nb < 8; ++nb) { const bf16x8 kf = *(const LAS bf16x8*)(T + (nb * 16 + fr) * 136 + kk * 32 + fq * 8);
                    S[nb] = __builtin_amdgcn_mfma_f32_16x16x32_bf16(kf, qf[kk], S[nb], 0, 0, 0); }
            const float rb = fv[j];
#pragma unroll
            for (int nb = 0; nb < 8; ++nb) { const int l0 = nb * 16 + 4 * fq; const f32x4 cw = *(const LAS f32x4*)(fv + 128 + l0);
                float sv[4];
#pragma unroll
                for (int i = 0; i < 4; ++i) { const int l = l0 + i; const bool valid = dir ? (l >= j) : (l <= j); sv[i] = valid ? S[nb][i] * __expf(rb + cw[i]) : 0.f; }
                u32x2 o; o.x = cvt_pk_bf16(sv[0], sv[1]); o.y = cvt_pk_bf16(sv[2], sv[3]); *(LAS u32x2*)(sb + j * 136 + l0) = o; }
        }
        __syncthreads();
#pragma unroll
        for (int i = 0; i < 9; ++i) { const int idx = t + 512 * i; if (idx < 272 * 16) *(LAS u32x4*)(T + (idx >> 4) * 136 + (idx & 15) * 8) = creg[i]; }
        u32x4 vreg[8];
        { const bf16_t* vt = VT + (size_t)(ck * 4 + h) * 256 * 128;
#pragma unroll
          for (int i = 0; i < 8; ++i) { const int idx = t + 512 * i; vreg[i] = *(const u32x4*)(vt + (size_t)(idx >> 4) * 128 + (idx & 15) * 8); } }
        __syncthreads();
        f32x4 acc[17];
#pragma unroll
        for (int nb = 0; nb < 17; ++nb) acc[nb] = (f32x4){0.f, 0.f, 0.f, 0.f};
#pragma unroll
        for (int kk = 0; kk < 4; ++kk)
#pragma unroll
            for (int nb = 0; nb < 17; ++nb) { const bf16x8 cf = *(const LAS bf16x8*)(T + (nb * 16 + fr) * 136 + kk * 32 + fq * 8);
                acc[nb] = __builtin_amdgcn_mfma_f32_16x16x32_bf16(cf, qf[kk], acc[nb], 0, 0, 0); }
        { const float aj = fv[256 + j];
#pragma unroll
          for (int nb = 0; nb < 17; ++nb) acc[nb] = acc[nb] * aj; }
        __syncthreads();
#pragma unroll
        for (int i = 0; i < 8; ++i) { const int idx = t + 512 * i; *(LAS u32x4*)(T + (idx >> 4) * 136 + (idx & 15) * 8) = vreg[i]; }
        if (t < 256) { const int r = 256 + (t >> 4), c8 = (t & 15) * 8; const unsigned one = (r == 256) ? 0x3F803F80u : 0u; *(LAS u32x4*)(T + r * 136 + c8) = (u32x4){one, one, one, one}; }
        const float einv = fv[384 + j];
        { const int un = (u & 1) ? u - 1 + 2 * (int)gridDim.x : u + 1; if (un < 2048) mout_issue(p, un, kreg, qf, gg); }
        __syncthreads();
#pragma unroll
        for (int kk = 0; kk < 4; ++kk) { const bf16x8 sf = *(const LAS bf16x8*)(sb + j * 136 + kk * 32 + fq * 8);
#pragma unroll
            for (int nb = 0; nb < 17; ++nb) { const bf16x8 vf = *(const LAS bf16x8*)(T + (nb * 16 + fr) * 136 + kk * 32 + fq * 8);
                acc[nb] = __builtin_amdgcn_mfma_f32_16x16x32_bf16(vf, sf, acc[nb], 0, 0, 0); } }
        const float nq = __shfl(acc[16][0], fr);
        const float inv = 1.f / fmaxf(fabsf(nq), einv);
        bf16_t* hd = (bf16_t*)(p.ws + WS_HDIR) + (size_t)(r0 + j) * 1024 + h * 256;
        if (dir == 0) {
#pragma unroll
            for (int nb = 0; nb < 16; ++nb) { u32x2 o; o.x = cvt_pk_bf16(acc[nb][0] * inv, acc[nb][1] * inv); o.y = cvt_pk_bf16(acc[nb][2] * inv, acc[nb][3] * inv); *(u32x2*)(hd + nb * 16 + 4 * fq) = o; }
        } else {
            float ss = 0.f;
#pragma unroll
            for (int nb = 0; nb < 16; ++nb) { const u32x2 hv = *(const u32x2*)(hd + nb * 16 + 4 * fq);
                acc[nb][0] = acc[nb][0] * inv + bflo(hv.x); acc[nb][1] = acc[nb][1] * inv + bfhi(hv.x); acc[nb][2] = acc[nb][2] * inv + bflo(hv.y); acc[nb][3] = acc[nb][3] * inv + bfhi(hv.y);
                ss += acc[nb][0] * acc[nb][0] + acc[nb][1] * acc[nb][1] + acc[nb][2] * acc[nb][2] + acc[nb][3] * acc[nb][3]; }
            ss += __shfl_xor(ss, 16); ss += __shfl_xor(ss, 32);
            const float rstd = rsqrtf(ss * (1.f / 256.f) + 1e-6f);
            const float* ng = p.in[15] + h * 256;
            const bf16_t* og = (const bf16_t*)(p.ws + WS_O) + (size_t)(r0 + j) * 1024 + h * 256;
            bf16_t* cat = (bf16_t*)(p.ws + WS_CAT) + (size_t)(r0 + j) * 2048 + h * 256;
#pragma unroll
            for (int nb = 0; nb < 16; ++nb) { const int dv = nb * 16 + 4 * fq; const f32x4 gn = *(const f32x4*)(ng + dv); const u32x2 ov = *(const u32x2*)(og + dv);
                u32x2 o; o.x = cvt_pk_bf16(acc[nb][0] * rstd * gn[0] * bflo(ov.x), acc[nb][1] * rstd * gn[1] * bfhi(ov.x));
                o.y = cvt_pk_bf16(acc[nb][2] * rstd * gn[2] * bflo(ov.y), acc[nb][3] * rstd * gn[3] * bfhi(ov.y));
                *(u32x2*)(cat + dv) = o;
                if ((nb & 3) == 3) asm volatile("" ::: "memory"); }
        }
        __syncthreads();
    }
}

__device__ __forceinline__ void finish_phase(const Params& p) {
    const int wid = threadIdx.x >> 6, lane = threadIdx.x & 63;
    const bf16_t* HD = (const bf16_t*)(p.ws + WS_HDIR); const bf16_t* O = (const bf16_t*)(p.ws + WS_O); bf16_t* CAT = (bf16_t*)(p.ws + WS_CAT);
    const float* ng = p.in[15];
    for (int row = blockIdx.x * 8 + wid; row < ML; row += gridDim.x * 8) {
        const int e0 = lane * 16;
        float hs[16]; float ss = 0.f;
#pragma unroll
        for (int i = 0; i < 2; ++i) { const u32x4 a = *(const u32x4*)(HD + (size_t)row * 1024 + e0 + i * 8), bq = *(const u32x4*)(HD + (size_t)ML * 1024 + (size_t)row * 1024 + e0 + i * 8);
#pragma unroll
            for (int c = 0; c < 8; ++c) { const float f = bfel(a, c) + bfel(bq, c); hs[i * 8 + c] = f; ss += f * f; } }
        ss += __shfl_xor(ss, 1); ss += __shfl_xor(ss, 2); ss += __shfl_xor(ss, 4); ss += __shfl_xor(ss, 8);
        const float rstd = rsqrtf(ss * (1.f / 256.f) + 1e-6f);
#pragma unroll
        for (int i = 0; i < 2; ++i) { const u32x4 ov = *(const u32x4*)(O + (size_t)row * 1024 + e0 + i * 8);
            float y[8];
#pragma unroll
            for (int c = 0; c < 8; ++c) y[c] = hs[i * 8 + c] * rstd * ng[e0 + i * 8 + c] * bfel(ov, c);
            u32x4 o; o.x = cvt_pk_bf16(y[0], y[1]); o.y = cvt_pk_bf16(y[2], y[3]); o.z = cvt_pk_bf16(y[4], y[5]); o.w = cvt_pk_bf16(y[6], y[7]);
            *(u32x4*)(CAT + (size_t)row * 2048 + e0 + i * 8) = o; }
    }
}

template <int ph> __device__ __forceinline__ void run_phase(const Params& p, LAS unsigned char* lds) {
    unsigned char* ws = p.ws;
    const float* mod = (const float*)(ws + WS_MOD);
    bf16_t* const XN = (bf16_t*)(ws + WS_XN); bf16_t* const Hb = (bf16_t*)(ws + WS_H);
    if (ph == 0) { for (int u = blockIdx.x; u < 256 + 10304; u += gridDim.x) { if (u < 256) adaln_unit(p, (LAS float*)lds, u); else wtile_unit(p, (LAS float*)lds, u - 256); } }
    else if (ph == 1) norm_phase(p.in[0], p.in[2], nullptr, nullptr, nullptr, nullptr, M1, p.in[6], mod, 0 * D, 1 * D, XN, nullptr);
    else if (ph == 2) gemm_phase(lds, p, XN, (const bf16_t*)(ws + WS_WF1IN), M1, 2 * DFF, D, EPI_SWIGLU, 1, Hb, 0, 0.f);
    else if (ph == 3) gemm_phase(lds, p, Hb, (const bf16_t*)(ws + WS_WF1OUT), M1, D, DFF, EPI_RESID, 1, XN, 2 * D, 0.5f);
    else if (ph == 4) norm_phase(p.in[0], p.in[2], XN, nullptr, (const bf16_t*)(ws + WS_CAT), p.out, M1, p.in[9], mod, 3 * D, 4 * D, XN, nullptr);
    else if (ph == 5) gemm_phase(lds, p, XN, (const bf16_t*)(ws + WS_WIN), M1, INP, D, EPI_INPROJ, 1, Hb, 0, 0.f);
    else if (ph == 6) { for (int u = blockIdx.x; u < 256 + 2176; u += gridDim.x) { if (u < 256) gmlp_unit(p, lds, u); else conv_unit(p, u - 256); } }
    else if (ph == 7) scan_phase(p, lds);
    else if (ph == 8) mout_phase(p, lds);
    else if (ph == 9) { }
    else if (ph == 10) gemm_phase(lds, p, (const bf16_t*)(ws + WS_CAT), (const bf16_t*)(ws + WS_WOUT), ML, D, D, EPI_RESID, 1, (bf16_t*)(ws + WS_K), 5 * D, 1.0f);
    else if (ph == 11) norm_phase(p.out, p.out, (const bf16_t*)(ws + WS_K), nullptr, nullptr, nullptr, ML, p.in[20], mod, 6 * D, 7 * D, XN, nullptr);
    else if (ph == 12) gemm_phase(lds, p, XN, (const bf16_t*)(ws + WS_WF2IN), ML, 2 * DFF, D, EPI_SWIGLU, 1, Hb, 0, 0.f);
    else if (ph == 13) gemm_phase(lds, p, Hb, (const bf16_t*)(ws + WS_WF2OUT), ML, D, DFF, EPI_RESID, 1, XN, 8 * D, 0.5f);
    else if (ph == 14) norm_phase(p.out, p.out, XN, (const bf16_t*)(ws + WS_K), nullptr, nullptr, ML, p.in[23], nullptr, 0, 0, nullptr, p.out);
}

#define RUNPH(n) if (p.ph_lo <= n && n < p.ph_hi) { run_phase<n>(p, lds); if (n + 1 < p.ph_hi) xcd_barrier(xb); }
__global__ void __launch_bounds__(512, 2) hymba_megakernel(Params p) {
    extern __shared__ __attribute__((aligned(16))) unsigned char shm[];
    LAS unsigned char* lds = (LAS unsigned char*)shm;
    cg::grid_group grid = cg::this_grid();
    unsigned* barw = (unsigned*)(p.ws + WS_BAR);
    volatile LAS unsigned* stw = (volatile LAS unsigned*)(lds + LDS_BYTES - 16);
    if (threadIdx.x == 0) { stw[0] = 0u; stw[1] = 0u; }
    __syncthreads();
    XcdBarrier xb = xcd_barrier_post(barw, stw);
    if (p.ph_hi < 0) grid.sync();
    RUNPH(0)
    RUNPH(1) RUNPH(2) RUNPH(3) RUNPH(4) RUNPH(5) RUNPH(6) RUNPH(7) RUNPH(8) RUNPH(10) RUNPH(11) RUNPH(12) RUNPH(13) RUNPH(14)
}

extern "C" void kernel_launch(void* const* d_in, const int* in_sizes, int n_in, void* d_out, int out_size, void* d_ws, size_t ws_size, hipStream_t stream) {
    static int grid = 0;
    if (grid == 0) {
        if (n_in != 24 || out_size != ML * D || ws_size < WS_END) { fprintf(stderr, "kernel_launch: unexpected shapes (n_in %d out %d ws %zu need %zu)\n", n_in, out_size, ws_size, (size_t)WS_END); grid = -1; return; }
        int dev = 0, cus = 0, per_cu = 0;
        hipGetDevice(&dev);
        hipDeviceGetAttribute(&cus, hipDeviceAttributeMultiprocessorCount, dev);
        if (hipFuncSetAttribute((const void*)hymba_megakernel, hipFuncAttributeMaxDynamicSharedMemorySize, LDS_BYTES) != hipSuccess) { fprintf(stderr, "kernel_launch: hipFuncSetAttribute failed\n"); }
        if (hipOccupancyMaxActiveBlocksPerMultiprocessor(&per_cu, (const void*)hymba_megakernel, 512, LDS_BYTES) != hipSuccess || per_cu < 1) per_cu = 1;
        (void)hipGetLastError();
        grid = cus * per_cu;
        fprintf(stderr, "kernel_launch: cus %d per_cu %d grid %d\n", cus, per_cu, grid);
    }
    if (grid < 0) return;
    Params p{};
    for (int i = 0; i < 24; ++i) p.in[i] = (const float*)d_in[i];
    p.out = (float*)d_out; p.ws = (unsigned char*)d_ws;
#if MK_MULTI
    for (int ph = 0; ph < NPH; ++ph) { p.ph_lo = ph; p.ph_hi = ph + 1; hipLaunchKernelGGL(hymba_megakernel, dim3(grid), dim3(512), LDS_BYTES, stream, p); }
#else
    p.ph_lo = 0; p.ph_hi = NPH;
    if (hipMemsetAsync((char*)d_ws + WS_BAR, 0, 16384, stream) != hipSuccess) fprintf(stderr, "kernel_launch: memset of the barrier words failed\n");
    void* args[] = {&p};
    hipError_t e = hipLaunchCooperativeKernel((const void*)hymba_megakernel, dim3(grid), dim3(512), args, LDS_BYTES, stream);
    if (e != hipSuccess) fprintf(stderr, "cooperative launch failed: %s (grid %d)\n", hipGetErrorString(e), grid);
#endif
}
```

```cpp
#include <hip/hip_runtime.h>
#include <hip/hip_cooperative_groups.h>
#include <cstdio>
namespace cg = cooperative_groups;

#ifndef MK_MULTI
#define MK_MULTI 0
#endif

#ifndef PHSEL
#define PHSEL 0xffff
#endif
#define PHON(n) ((PHSEL >> (n)) & 1)
#define LAS __attribute__((address_space(3)))
typedef unsigned short bf16_t;
typedef short bf16x8 __attribute__((ext_vector_type(8)));
typedef float f32x4 __attribute__((ext_vector_type(4)));
typedef unsigned u32x4 __attribute__((ext_vector_type(4)));
typedef unsigned u32x2 __attribute__((ext_vector_type(2)));

constexpr int D = 2048, ML = 32768, MC = 2048, M1 = ML + MC, DFF = 5632, NMODC = 9 * 2048, INP = 5376;
constexpr int NPH = 15;
constexpr int LDS_BYTES = 147456;

constexpr size_t al256(size_t x) { return (x + 255) & ~(size_t)255; }
constexpr size_t WS_WF1IN = 0;
constexpr size_t WS_WF1OUT = WS_WF1IN + (size_t)11264 * 2048 * 2;
constexpr size_t WS_WIN = WS_WF1OUT + (size_t)2048 * 5632 * 2;
constexpr size_t WS_WOUT = WS_WIN + (size_t)INP * 2048 * 2;
constexpr size_t WS_WF2IN = WS_WOUT + (size_t)2048 * 2048 * 2;
constexpr size_t WS_WF2OUT = WS_WF2IN + (size_t)11264 * 2048 * 2;
constexpr size_t WS_MOD = WS_WF2OUT + (size_t)2048 * 5632 * 2;
constexpr size_t WS_XN = al256(WS_MOD + (size_t)9 * NMODC * 4);
constexpr size_t WS_MPREV = WS_XN + (size_t)M1 * 2048 * 2;
constexpr size_t WS_H = al256(WS_MPREV + 64 * 32 * 4);
constexpr size_t WS_ZQK = WS_H;
constexpr size_t WS_V = WS_ZQK + (size_t)M1 * 1024 * 2;
constexpr size_t WS_O = WS_V + (size_t)M1 * 1024 * 2;
constexpr size_t WS_U = WS_O + (size_t)ML * 1024 * 2;
constexpr size_t WS_GV = WS_U + (size_t)ML * 1024 * 2;
constexpr size_t WS_HDIR = WS_U;
constexpr size_t WS_G = WS_GV + (size_t)ML * 1024 * 2;
constexpr size_t WS_Q = WS_G + (size_t)M1 * 16 * 4;
constexpr size_t WS_X1C = al256(WS_H + (size_t)M1 * DFF * 2);
constexpr size_t WS_CAT = WS_X1C + (size_t)MC * 2048 * 4;
constexpr size_t WS_K = WS_CAT + (size_t)ML * 2048 * 2;
constexpr size_t WS_KT = WS_K + (size_t)ML * 512 * 2;
constexpr size_t WS_VT = WS_KT + (size_t)272 * 4 * 128 * 128 * 2;
constexpr size_t WS_BAR = WS_VT + (size_t)272 * 4 * 256 * 128 * 2;
constexpr size_t WS_END = WS_BAR + 16384;
static_assert(WS_Q + (size_t)ML * 512 * 2 <= WS_X1C, "in-proj outputs overflow the H region");

struct Params {
    const float* in[24];
    float* out;
    unsigned char* ws;
    int ph_lo, ph_hi;
};

__device__ __forceinline__ unsigned cvt_pk_bf16(float lo, float hi) { unsigned r; asm volatile("v_cvt_pk_bf16_f32 %0, %1, %2" : "=v"(r) : "v"(lo), "v"(hi)); return r; }
__device__ __forceinline__ float bflo(unsigned u) { return __uint_as_float(u << 16); }
__device__ __forceinline__ float bfhi(unsigned u) { return __uint_as_float(u & 0xffff0000u); }
__device__ __forceinline__ float bfel(const u32x4& v, int c) { const unsigned w = (c >> 1) == 0 ? v.x : (c >> 1) == 1 ? v.y : (c >> 1) == 2 ? v.z : v.w; return (c & 1) ? bfhi(w) : bflo(w); }
__device__ __forceinline__ unsigned us16(const u32x4& v, int c) { const unsigned w = (c >> 1) == 0 ? v.x : (c >> 1) == 1 ? v.y : (c >> 1) == 2 ? v.z : v.w; return (c & 1) ? (w >> 16) : (w & 0xffffu); }
__device__ __forceinline__ float wave_sum(float v) {
#pragma unroll
    for (int o = 32; o; o >>= 1) v += __shfl_xor(v, o);
    return v; }
__device__ __forceinline__ float wave_max(float v) {
#pragma unroll
    for (int o = 32; o; o >>= 1) v = fmaxf(v, __shfl_xor(v, o));
    return v; }
__device__ __forceinline__ float wave_scan_sum(float v, int lane) {
#pragma unroll
    for (int o = 1; o < 64; o <<= 1) { const float t = __shfl_up(v, o); if (lane >= o) v += t; }
    return v; }
__device__ __forceinline__ float wave_scan_max(float v, int lane) {
#pragma unroll
    for (int o = 1; o < 64; o <<= 1) { const float t = __shfl_up(v, o); if (lane >= o) v = fmaxf(v, t); }
    return v; }
__device__ __forceinline__ float fexp2_(float x) { return __builtin_amdgcn_exp2f(x); }
__device__ __forceinline__ float sigmoidf_(float x) { return __builtin_amdgcn_rcpf(1.f + fexp2_(-1.4426950408889634f * x)); }
__device__ __forceinline__ float siluf_(float x) { return x * __builtin_amdgcn_rcpf(1.f + fexp2_(-1.4426950408889634f * x)); }
__device__ __forceinline__ float geluf_(float x) { const float y = x * (-2.3022082f + -0.1029432f * x * x); return x * __builtin_amdgcn_rcpf(1.f + fexp2_(y)); }

#define XB_TMO      128
#define XB_XCNT(j)  (256  + 64 * (j))
#define XB_XSUB(j)  (1280 + 64 * (j))
#define XB_XGEN(j)  (2304 + 64 * (j))
#define XB_TOP      3328
#define XB_TOPGEN   3392
#define XCD_BAR_WORDS 3456
#define XB_SPIN_CAP (1u << 22)
__device__ __forceinline__ unsigned xb_ld(unsigned* p)              { return __hip_atomic_load(p, __ATOMIC_RELAXED, __HIP_MEMORY_SCOPE_AGENT); }
__device__ __forceinline__ unsigned xb_add(unsigned* p, unsigned v) { return __hip_atomic_fetch_add(p, v, __ATOMIC_RELAXED, __HIP_MEMORY_SCOPE_AGENT); }
__device__ __forceinline__ unsigned xb_xcc_id() { return (unsigned)__builtin_amdgcn_s_getreg((3 << 11) | 20) & 0xFu; }
#define XB_SPIN(cond, bar) do { unsigned _sp = 0; while (cond) { __builtin_amdgcn_s_sleep(1); \
    if ((++_sp & 255u) == 0u) { if (xb_ld(&(bar)[XB_TMO])) break; if (_sp > XB_SPIN_CAP) { atomicAdd(&(bar)[XB_TMO], 1u); break; } } } } while (0)
struct XcdBarrier { unsigned* bar; unsigned x; volatile LAS unsigned* st; };
__device__ __forceinline__ XcdBarrier xcd_barrier_post(unsigned* bar, volatile LAS unsigned* st) {
    XcdBarrier b; b.bar = bar; b.x = xb_xcc_id(); b.st = st;
    if (threadIdx.x == 0) (void)xb_add(&bar[XB_XCNT(b.x)], 1u);
    return b;
}
__device__ __forceinline__ void xcd_barrier_complete(unsigned* bar, unsigned x, unsigned& nloc, unsigned& nx) {
    const unsigned G = gridDim.x * gridDim.y * gridDim.z;
    unsigned sum, cnt, mine, sp = 0u;
    for (;;) {
        sum = 0u; cnt = 0u; mine = 0u;
#pragma unroll
        for (unsigned j = 0; j < 16; ++j) { const unsigned c = xb_ld(&bar[XB_XCNT(j)]); sum += c; cnt += (c > 0u) ? 1u : 0u; mine = (j == x) ? c : mine; }
        if (sum == G) break;
        __builtin_amdgcn_s_sleep(1);
        if ((++sp & 255u) == 0u) { if (xb_ld(&bar[XB_TMO])) break; if (sp > XB_SPIN_CAP) { atomicAdd(&bar[XB_TMO], 1u); break; } }
    }
    nloc = mine > 0u ? mine : 1u; nx = cnt > 0u ? cnt : 1u;
}
__device__ __forceinline__ void xcd_barrier(const XcdBarrier& b) {
    asm volatile("s_waitcnt vmcnt(0)" ::: "memory");
    __syncthreads();
    if (threadIdx.x == 0) {
        unsigned* bar = b.bar;
        __builtin_amdgcn_s_waitcnt(0);
        unsigned nloc = b.st[0], nx = b.st[1];
        if (nloc == 0u) { xcd_barrier_complete(bar, b.x, nloc, nx); b.st[0] = nloc; b.st[1] = nx; }
        const unsigned old = xb_add(&bar[XB_XSUB(b.x)], 1u);
        const unsigned gen = old / nloc;
        if (old + 1u == (gen + 1u) * nloc) {
            __builtin_amdgcn_fence(__ATOMIC_RELEASE, "agent");
            asm volatile("s_waitcnt vmcnt(0)" ::: "memory");
            const unsigned og = xb_add(&bar[XB_TOP], 1u);
            const unsigned tg = og / nx;
            if (og + 1u == (tg + 1u) * nx) xb_add(&bar[XB_TOPGEN], 1u);
            else XB_SPIN(xb_ld(&bar[XB_TOPGEN]) == tg, bar);
            __builtin_amdgcn_fence(__ATOMIC_ACQUIRE, "agent");
            xb_add(&bar[XB_XGEN(b.x)], 1u);
            asm volatile("s_waitcnt vmcnt(0)" ::: "memory");
        } else {
            XB_SPIN(xb_ld(&bar[XB_XGEN(b.x)]) == gen, bar);
            __builtin_amdgcn_fence(__ATOMIC_ACQUIRE, "agent");
            asm volatile("s_waitcnt vmcnt(0)" ::: "memory");
        }
    }
    __syncthreads();
}

namespace pg8 {
constexpr int BM = 256, BK = 64, HALF = 128, HTB = HALF * BK * 2, NXCD = 8, WGM = 8;
__device__ __forceinline__ int lds_byte(int r, int c) { const int st = (r >> 4) * 2 + (c >> 5), rr = r & 15, cc = c & 31, ob = rr * 64 + cc * 2; return st * 1024 + (ob ^ (((ob >> 9) & 1) << 5)); }
__device__ __forceinline__ void stage_rc(int b, int& R, int& C) { const int st = b / 1024, sb = b % 1024, swz = sb ^ (((sb >> 9) & 1) << 5); R = (st >> 1) * 16 + swz / 64; C = (st & 1) * 32 + (swz % 64) / 2; }
__device__ __forceinline__ int perm32(int rho) { const int n = rho >> 4, i = rho & 15; return 8 * (i >> 2) + 4 * n + (i & 3); }
struct Unit { int pm, pn, ks; };
struct StaticOrder {
    int nM, nN, nwg, G, c;
    __device__ void init(int M, int N, int G_, int c_) { nM = M / BM; nN = N / BM; nwg = nM * nN; G = G_; c = c_; extra = 0; pre = 0; }
    int extra;
    int pre;
    __device__ bool next(int i, Unit& u) const {
        long L = (long)i * G + c; u.ks = -1;
        if (L < pre) { const int t = (int)L & 63; u.ks = (int)L >> 6; u.pm = nM + (t >> 3); u.pn = t & 7; return true; }
        L -= pre;
        if (L >= nwg + extra) return false;
        if (L >= nwg) { const int j = (int)(L - nwg); const int q = j >> 3; u.pm = nM + (j & 7); u.pn = q < 6 ? q + 2 : 20; return true; }
        int wgid = (int)L; { const int q = nwg / NXCD, r = nwg % NXCD, xcd = wgid % NXCD, off = wgid / NXCD; wgid = (xcd < r ? xcd * (q + 1) : r * (q + 1) + (xcd - r) * q) + off; }
        const int wgm = nN <= 8 ? 4 : WGM;
        const int nig = wgm * nN, gid = wgid / nig, fm = gid * wgm, gsz = (nM - fm) < wgm ? (nM - fm) : wgm;
        u.pm = fm + ((wgid % nig) % gsz); u.pn = (wgid % nig) / gsz; return true;
    }
};
}

enum { EPI_SWIGLU = 0, EPI_RESID = 1, EPI_INPROJ = 2 };
__device__ __forceinline__ void gemm_epilogue(const Params& p, const int epi, bf16_t* const Hp, const int goff, const float coef, const f32x4 (&acc)[2][2][4][2], const pg8::Unit& u, int wr, int wc, int fr, int fq) {
    if (epi == EPI_SWIGLU) {
        const int col0 = u.pn * 128 + wc * 32 + fq * 8;
#pragma unroll
        for (int ai = 0; ai < 2; ++ai)
#pragma unroll
            for (int m = 0; m < 4; ++m) {
                const int row = u.pm * 256 + ai * 128 + wr * 64 + m * 16 + fr;
                float h[8];
#pragma unroll
                for (int n = 0; n < 2; ++n)
#pragma unroll
                    for (int i = 0; i < 4; ++i) h[n * 4 + i] = siluf_(acc[ai][0][m][n][i]) * acc[ai][1][m][n][i];
                u32x4 o; o.x = cvt_pk_bf16(h[0], h[1]); o.y = cvt_pk_bf16(h[2], h[3]); o.z = cvt_pk_bf16(h[4], h[5]); o.w = cvt_pk_bf16(h[6], h[7]);
                *(u32x4*)(Hp + (size_t)row * DFF + col0) = o;
            }
    } else if (epi == EPI_RESID) {
        const bool lat = u.pm < 128;
        const int b = lat ? (u.pm >> 4) : 8;
        const float* gate = (const float*)(p.ws + WS_MOD) + (size_t)b * NMODC + goff;
#pragma unroll
        for (int bj = 0; bj < 2; ++bj) {
            const int col = u.pn * 256 + bj * 128 + wc * 32 + fq * 8;
            const f32x4 g0 = *(const f32x4*)(gate + col) * coef, g1 = *(const f32x4*)(gate + col + 4) * coef;
#pragma unroll
            for (int ai = 0; ai < 2; ++ai)
#pragma unroll
                for (int m = 0; m < 4; ++m) {
                    const int row = u.pm * 256 + ai * 128 + wr * 64 + m * 16 + fr;
                    const f32x4 v0 = acc[ai][bj][m][0] * g0, v1 = acc[ai][bj][m][1] * g1;
                    u32x4 o; o.x = cvt_pk_bf16(v0[0], v0[1]); o.y = cvt_pk_bf16(v0[2], v0[3]); o.z = cvt_pk_bf16(v1[0], v1[1]); o.w = cvt_pk_bf16(v1[2], v1[3]);
                    *(u32x4*)((u.ks >= 0 ? (bf16_t*)(p.ws + WS_CAT) + (size_t)u.ks * MC * D + (size_t)(row - ML) * D : Hp + (size_t)row * D) + col) = o;
                }
        }
    } else {
        const int seg = u.pn >> 2;
        const bool lat = u.pm < 128;
        if (seg < 5) {
            if (seg >= 2 && !lat) return;
            bf16_t* dst = (bf16_t*)(p.ws + (seg == 0 ? WS_ZQK : seg == 1 ? WS_V : seg == 2 ? WS_O : seg == 3 ? WS_U : WS_GV));
#pragma unroll
            for (int ai = 0; ai < 2; ++ai)
#pragma unroll
                for (int m = 0; m < 4; ++m) {
                    const int row = u.pm * 256 + ai * 128 + wr * 64 + m * 16 + fr;
#pragma unroll
                    for (int bj = 0; bj < 2; ++bj) {
                        const int cl = (u.pn & 3) * 256 + bj * 128 + wc * 32 + fq * 8;
                        float h[8];
#pragma unroll
                        for (int n = 0; n < 2; ++n)
#pragma unroll
                            for (int i = 0; i < 4; ++i) { const float a = acc[ai][bj][m][n][i]; h[n * 4 + i] = seg < 2 ? a : seg == 2 ? sigmoidf_(a) : geluf_(a); }
                        u32x4 o; o.x = cvt_pk_bf16(h[0], h[1]); o.y = cvt_pk_bf16(h[2], h[3]); o.z = cvt_pk_bf16(h[4], h[5]); o.w = cvt_pk_bf16(h[6], h[7]);
                        *(u32x4*)(dst + (size_t)row * 1024 + cl) = o;
                    }
                }
        } else if (wc == 0 && fq < 2) {
            const f32x4 bi = *(const f32x4*)(p.in[13] + fq * 4), bfv = *(const f32x4*)(p.in[14] + fq * 4);
#pragma unroll
            for (int ai = 0; ai < 2; ++ai)
#pragma unroll
                for (int m = 0; m < 4; ++m) {
                    const int row = u.pm * 256 + ai * 128 + wr * 64 + m * 16 + fr;
                    const f32x4 li = acc[ai][0][m][0] + bi;
                    const f32x4 xf = acc[ai][0][m][1] + bfv;
                    f32x4 lf;
#pragma unroll
                    for (int i = 0; i < 4; ++i) lf[i] = fminf(xf[i], 0.f) - log1pf(expf(-fabsf(xf[i])));
                    *(f32x4*)((float*)(p.ws + WS_G) + (size_t)row * 16 + fq * 8) = li;
                    *(f32x4*)((float*)(p.ws + WS_G) + (size_t)row * 16 + fq * 8 + 4) = lf;
                }
        }
    }
}

__device__ __forceinline__ void gemm_phase(LAS unsigned char* lds, const Params& p, const bf16_t* gA, const bf16_t* gBt, const int gM, const int gN, const int gK, const int epi, const int perm, bf16_t* const Hp, const int goff, const float coef) {
    using namespace pg8;
    const int tid = threadIdx.x, wid = __builtin_amdgcn_readfirstlane(tid >> 6), lane = tid & 63, wr = wid >> 2, wc = wid & 3, fr = lane & 15, fq = lane >> 4;
    const int K = gK, ntf = K / BK;
    const size_t ksl = (size_t)(K / 4) * 2;
    StaticOrder S; S.init(gM, gN, (int)gridDim.x, (int)blockIdx.x);
    if (epi == EPI_INPROJ) { S.init(ML, gN, (int)gridDim.x, (int)blockIdx.x); S.extra = 56; }
    if (epi == EPI_RESID && gM == M1) { S.init(ML, gN, (int)gridDim.x, (int)blockIdx.x); S.pre = 256; }
    unsigned voffA[2], voffB[2];
#pragma unroll
    for (int i = 0; i < 2; ++i) { int R, C; stage_rc(tid * 16 + i * 8192, R, C); const int Rb = perm ? ((R & ~31) + perm32(R & 31)) : R;
        voffA[i] = (unsigned)(R * K + C) * 2u; voffB[i] = (unsigned)(Rb * K + C) * 2u; }
    const size_t kstep = (size_t)(BK * 2);
    const size_t hstep = (size_t)HALF * K * 2;
    const size_t tstep = 2 * hstep;
    const unsigned ldsw = (unsigned)wid * 1024u;
    const int aoff = lds_byte(wr * 64 + fr, fq * 8), boff = lds_byte(wc * 32 + fr, fq * 8);
#define PG8_SA(b, h) (((b) * 2 + (h)) * HTB)
#define PG8_SB(b, h) ((4 + (b) * 2 + (h)) * HTB)
#define PG8_STAGE(bufoff, gbase, voff) do { _Pragma("unroll") for (int _i = 0; _i < 2; ++_i) \
        __builtin_amdgcn_global_load_lds((const unsigned*)((const char*)(gbase) + (voff)[_i]), (LAS unsigned*)(lds + (bufoff) + ldsw + _i * 8192), 16, 0, 0); } while (0)
#define PG8_LDA(dst, b, h) do { _Pragma("unroll") for (int m = 0; m < 4; ++m) _Pragma("unroll") for (int k = 0; k < 2; ++k) dst[m][k] = *(const LAS bf16x8*)(lds + PG8_SA(b, h) + aoff + m * 2048 + k * 1024); } while (0)
#define PG8_LDB(dst, b, h) do { _Pragma("unroll") for (int n = 0; n < 2; ++n) _Pragma("unroll") for (int k = 0; k < 2; ++k) dst[n][k] = *(const LAS bf16x8*)(lds + PG8_SB(b, h) + boff + n * 2048 + k * 1024); } while (0)
#define PG8_MMA(ai, bj, At, Bt) do { __builtin_amdgcn_s_setprio(1); _Pragma("unroll") for (int m = 0; m < 4; ++m) _Pragma("unroll") for (int n = 0; n < 2; ++n) _Pragma("unroll") for (int k = 0; k < 2; ++k) \
        acc[ai][bj][m][n] = __builtin_amdgcn_mfma_f32_16x16x32_bf16(Bt[n][k], At[m][k], acc[ai][bj][m][n], 0, 0, 0); __builtin_amdgcn_s_setprio(0); } while (0)
#define PG8_WAIT_V(n) asm volatile("s_waitcnt vmcnt(" #n ")" ::: "memory")
#define PG8_WAIT_L(n) asm volatile("s_waitcnt lgkmcnt(" #n ")" ::: "memory")
#define PG8_BAR __builtin_amdgcn_s_barrier()
#define PG8_SCHED __builtin_amdgcn_sched_barrier(0)
    Unit cur, nxt; int ui = 0;
    if (!S.next(0, cur)) return;
    f32x4 acc[2][2][4][2];
#pragma unroll
    for (int a = 0; a < 2; ++a)
#pragma unroll
        for (int b = 0; b < 2; ++b)
#pragma unroll
            for (int m = 0; m < 4; ++m)
#pragma unroll
                for (int n = 0; n < 2; ++n) acc[a][b][m][n] = (f32x4){0.f, 0.f, 0.f, 0.f};
    bf16x8 At[4][2], B0[2][2], B1[2][2];
    const char* cA = (const char*)gA + (size_t)cur.pm * tstep + (cur.ks > 0 ? cur.ks * ksl : 0); const char* cB = (const char*)gBt + (size_t)cur.pn * tstep + (cur.ks > 0 ? cur.ks * ksl : 0);
    PG8_STAGE(PG8_SB(0, 0), cB, voffB); PG8_STAGE(PG8_SB(0, 1), cB + hstep, voffB); PG8_STAGE(PG8_SA(0, 0), cA, voffA); PG8_STAGE(PG8_SA(0, 1), cA + hstep, voffA);
    if (wr == 1) PG8_BAR;
    PG8_WAIT_V(2); PG8_BAR;
    PG8_STAGE(PG8_SB(1, 0), cB + kstep, voffB); PG8_STAGE(PG8_SA(1, 0), cA + kstep, voffA); PG8_STAGE(PG8_SB(1, 1), cB + hstep + kstep, voffB);
    PG8_WAIT_V(6); PG8_BAR;
    for (;;) {
        const bool has_next = S.next(ui + 1, nxt);
        const char* nA = has_next ? (const char*)gA + (size_t)nxt.pm * tstep + (nxt.ks > 0 ? nxt.ks * ksl : 0) : cA; const char* nB = has_next ? (const char*)gBt + (size_t)nxt.pn * tstep + (nxt.ks > 0 ? nxt.ks * ksl : 0) : cB;
        const int nt = cur.ks >= 0 ? ntf / 4 : ntf;
        for (int t = 0; t < nt; t += 2) {
            const bool last = (t == nt - 2);
            const char* a1 = cA + (size_t)(t + 1) * kstep;
            const char* a2 = last ? nA : cA + (size_t)(t + 2) * kstep; const char* b2 = last ? nB : cB + (size_t)(t + 2) * kstep;
            const char* a3 = a2 + kstep; const char* b3 = b2 + kstep;
            PG8_LDB(B0, 0, 0); PG8_LDB(B1, 0, 1); PG8_SCHED; PG8_LDA(At, 0, 0); PG8_STAGE(PG8_SA(1, 1), a1 + hstep, voffA);
            PG8_WAIT_V(8); PG8_WAIT_L(0); PG8_BAR; PG8_MMA(0, 0, At, B0); PG8_MMA(0, 1, At, B1); PG8_BAR; PG8_SCHED;
            PG8_LDA(At, 0, 1); PG8_STAGE(PG8_SB(0, 0), b2, voffB); PG8_STAGE(PG8_SB(0, 1), b2 + hstep, voffB); PG8_STAGE(PG8_SA(0, 0), a2, voffA);
            PG8_WAIT_V(8); PG8_WAIT_L(0); PG8_BAR; PG8_MMA(1, 0, At, B0); PG8_MMA(1, 1, At, B1); PG8_BAR; PG8_SCHED;
            PG8_LDB(B0, 1, 0); PG8_LDB(B1, 1, 1); PG8_SCHED; PG8_LDA(At, 1, 0); PG8_STAGE(PG8_SA(0, 1), a2 + hstep, voffA);
            PG8_WAIT_V(8); PG8_WAIT_L(0); PG8_BAR; PG8_MMA(0, 0, At, B0); PG8_MMA(0, 1, At, B1); PG8_BAR; PG8_SCHED;
            PG8_LDA(At, 1, 1); PG8_STAGE(PG8_SB(1, 0), b3, voffB); PG8_STAGE(PG8_SB(1, 1), b3 + hstep, voffB); PG8_STAGE(PG8_SA(1, 0), a3, voffA);
            PG8_WAIT_V(8); PG8_WAIT_L(0); PG8_BAR; PG8_MMA(1, 0, At, B0); PG8_MMA(1, 1, At, B1); PG8_BAR; PG8_SCHED;
        }
        if (wr == 0) PG8_BAR;
        gemm_epilogue(p, epi, Hp, goff, coef, acc, cur, wr, wc, fr, fq);
        if (!has_next) break;
#pragma unroll
        for (int a = 0; a < 2; ++a)
#pragma unroll
            for (int b = 0; b < 2; ++b)
#pragma unroll
                for (int m = 0; m < 4; ++m)
#pragma unroll
                    for (int n = 0; n < 2; ++n) acc[a][b][m][n] = (f32x4){0.f, 0.f, 0.f, 0.f};
        cur = nxt; cA = nA; cB = nB; ++ui;
        if (wr == 1) PG8_BAR;
    }
    PG8_WAIT_V(0);
    PG8_BAR;
#undef PG8_SA
#undef PG8_SB
#undef PG8_STAGE
#undef PG8_LDA
#undef PG8_LDB
#undef PG8_MMA
#undef PG8_WAIT_V
#undef PG8_WAIT_L
#undef PG8_BAR
#undef PG8_SCHED
}

__device__ __forceinline__ void adaln_unit(const Params& p, LAS float* sm, int unit) {
    const int t = threadIdx.x;
    for (int idx = t; idx < 9 * 2048; idx += 512) { const int i = idx >> 11, k = idx & 2047; const float v = (i < 8) ? p.in[1][i * 2048 + k] : p.in[3][k]; sm[k * 9 + i] = siluf_(v); }
    __syncthreads();
    const int cg4 = (t % 18) * 4, ksub = t / 18;
    const float* w = p.in[4] + (size_t)unit * 72 + cg4;
    float acc[9][4];
#pragma unroll
    for (int i = 0; i < 9; ++i)
#pragma unroll
        for (int j = 0; j < 4; ++j) acc[i][j] = 0.f;
    if (t < 504) {
#pragma unroll 4
        for (int k = ksub; k < 2048; k += 28) {
            const f32x4 wv = *(const f32x4*)(w + (size_t)k * NMODC);
#pragma unroll
            for (int i = 0; i < 9; ++i) { const float s = sm[k * 9 + i];
#pragma unroll
                for (int j = 0; j < 4; ++j) acc[i][j] += s * wv[j]; }
        }
    }
    __syncthreads();
    if (t < 504) {
#pragma unroll
        for (int i = 0; i < 9; ++i)
#pragma unroll
            for (int j = 0; j < 4; ++j) sm[(ksub * 9 + i) * 72 + cg4 + j] = acc[i][j];
    }
    __syncthreads();
    float* mod = (float*)(p.ws + WS_MOD);
    for (int o = t; o < 9 * 72; o += 512) { const int i = o / 72, c = o - i * 72; float s = 0.f;
        for (int ks = 0; ks < 28; ++ks) s += sm[(ks * 9 + i) * 72 + c];
        mod[(size_t)i * NMODC + unit * 72 + c] = s + p.in[5][unit * 72 + c]; }
    __syncthreads();
}

__device__ __forceinline__ int colmap(int map, int n) {
    if (map == 0) return n;
    if (map == 1) { const int pn = n >> 8, rem = n & 255; return (rem >> 7) * DFF + pn * 128 + (rem & 127); }
    return n < 3072 ? n : (n < 5120 ? n + 16 : (n < 5136 ? n - 2048 : -1));
}

__device__ __forceinline__ void wtile_unit(const Params& p, LAS float* sm, int tile) {
    const float* src; bf16_t* dst; int K, ldw, map, local;
    if (tile < 2816) { src = p.in[7]; dst = (bf16_t*)(p.ws + WS_WF1IN); K = 2048; ldw = 11264; map = 1; local = tile; }
    else if (tile < 4224) { src = p.in[8]; dst = (bf16_t*)(p.ws + WS_WF1OUT); K = 5632; ldw = 2048; map = 0; local = tile - 2816; }
    else if (tile < 5568) { src = p.in[10]; dst = (bf16_t*)(p.ws + WS_WIN); K = 2048; ldw = 5136; map = 2; local = tile - 4224; }
    else if (tile < 6080) { src = p.in[19]; dst = (bf16_t*)(p.ws + WS_WOUT); K = 2048; ldw = 2048; map = 0; local = tile - 5568; }
    else if (tile < 8896) { src = p.in[21]; dst = (bf16_t*)(p.ws + WS_WF2IN); K = 2048; ldw = 11264; map = 1; local = tile - 6080; }
    else { src = p.in[22]; dst = (bf16_t*)(p.ws + WS_WF2OUT); K = 5632; ldw = 2048; map = 0; local = tile - 8896; }
    const int nkt = K >> 7, ntile = local / nkt, kt = local - ntile * nkt;
    const int n0 = ntile * 64, k0 = kt * 128;
    const int t = threadIdx.x;
    {
        const int n4 = (t & 15) * 4, kr = t >> 4;
        const int col = colmap(map, n0 + n4);
#pragma unroll
        for (int i = 0; i < 4; ++i) { const int k = kr + 32 * i;
            f32x4 v = (f32x4){0.f, 0.f, 0.f, 0.f};
            if (col >= 0) v = *(const f32x4*)(src + (size_t)(k0 + k) * ldw + col);
#pragma unroll
            for (int j = 0; j < 4; ++j) sm[k * 65 + n4 + j] = v[j]; }
    }
    __syncthreads();
#pragma unroll
    for (int it = 0; it < 2; ++it) {
        const int n = t >> 3, k8 = (t & 7) * 8 + 64 * it;
        float f[8];
#pragma unroll
        for (int j = 0; j < 8; ++j) f[j] = sm[(k8 + j) * 65 + n];
        u32x4 o; o.x = cvt_pk_bf16(f[0], f[1]); o.y = cvt_pk_bf16(f[2], f[3]); o.z = cvt_pk_bf16(f[4], f[5]); o.w = cvt_pk_bf16(f[6], f[7]);
        *(u32x4*)(dst + (size_t)(n0 + n) * K + k0 + k8) = o;
    }
    __syncthreads();
}

__device__ __forceinline__ void norm_phase(const float* lat, const float* ctxp, const bf16_t* dbuf, const bf16_t* dbuf2, const bf16_t* dpart, float* xout, int nrows, const float* gw, const float* mod, int shift_off, int scale_off, bf16_t* outb, float* outf) {
    const int wid = threadIdx.x >> 6, lane = threadIdx.x & 63;
    const int nw = gridDim.x * 8, gwv = blockIdx.x * 8 + wid, per = (nrows + nw - 1) / nw;
    const int rb = gwv * per, re = (rb + per < nrows) ? rb + per : nrows;
    if (rb >= re) return;
    int cur_b = -1;
    f32x4 ca[8], cb[8], v[8]; u32x2 dv[8], dw[8];
    { const float* src = rb < ML ? lat + (size_t)rb * D : ctxp + (size_t)(rb - ML) * D;
#pragma unroll
      for (int i = 0; i < 8; ++i) { v[i] = __builtin_nontemporal_load((const f32x4*)(src + i * 256 + lane * 4)); dv[i] = (u32x2){0u, 0u}; if (dbuf && !dpart) dv[i] = *(const u32x2*)(dbuf + (size_t)rb * D + i * 256 + lane * 4);
          dw[i] = (u32x2){0u, 0u}; if (dbuf2) dw[i] = __builtin_nontemporal_load((const u32x2*)(dbuf2 + (size_t)rb * D + i * 256 + lane * 4)); } }
    for (int row = rb; row < re; ++row) {
        const int b = row < ML ? (row >> 12) : 8;
        if (b != cur_b) {
            cur_b = b;
#pragma unroll
            for (int i = 0; i < 8; ++i) { const int col = i * 256 + lane * 4; ca[i] = *(const f32x4*)(gw + col); cb[i] = (f32x4){0.f, 0.f, 0.f, 0.f};
                if (mod) { const f32x4 sc = *(const f32x4*)(mod + (size_t)b * NMODC + scale_off + col); cb[i] = *(const f32x4*)(mod + (size_t)b * NMODC + shift_off + col); ca[i] = ca[i] * (sc + 1.f); } }
        }
        f32x4 nv[8]; u32x2 nd[8], nw2[8];
        if (row + 1 < re) { const int r1 = row + 1; const float* src = r1 < ML ? lat + (size_t)r1 * D : ctxp + (size_t)(r1 - ML) * D;
#pragma unroll
            for (int i = 0; i < 8; ++i) { nv[i] = __builtin_nontemporal_load((const f32x4*)(src + i * 256 + lane * 4)); nd[i] = (u32x2){0u, 0u}; if (dbuf && !dpart) nd[i] = *(const u32x2*)(dbuf + (size_t)r1 * D + i * 256 + lane * 4);
                nw2[i] = (u32x2){0u, 0u}; if (dbuf2) nw2[i] = __builtin_nontemporal_load((const u32x2*)(dbuf2 + (size_t)r1 * D + i * 256 + lane * 4)); } }
        else {
#pragma unroll
            for (int i = 0; i < 8; ++i) { nv[i] = (f32x4){0.f, 0.f, 0.f, 0.f}; nd[i] = (u32x2){0u, 0u}; nw2[i] = (u32x2){0u, 0u}; } }
        if (dpart && row < ML) {
#pragma unroll
            for (int i = 0; i < 8; ++i) { const u32x2 e = *(const u32x2*)(dbuf + (size_t)row * D + i * 256 + lane * 4);
                v[i][0] += bflo(e.x); v[i][1] += bfhi(e.x); v[i][2] += bflo(e.y); v[i][3] += bfhi(e.y); }
        }
        if (dpart && row >= ML) {
#pragma unroll
            for (int ks = 0; ks < 4; ++ks)
#pragma unroll
                for (int i = 0; i < 8; ++i) { const u32x2 e = *(const u32x2*)(dpart + (size_t)ks * MC * D + (size_t)(row - ML) * D + i * 256 + lane * 4);
                    v[i][0] += bflo(e.x); v[i][1] += bfhi(e.x); v[i][2] += bflo(e.y); v[i][3] += bfhi(e.y); if (i == 7) asm volatile("" ::: "memory"); }
        }
        float ss = 0.f;
#pragma unroll
        for (int i = 0; i < 8; ++i) {
            v[i][0] += bflo(dv[i].x) + bflo(dw[i].x); v[i][1] += bfhi(dv[i].x) + bfhi(dw[i].x); v[i][2] += bflo(dv[i].y) + bflo(dw[i].y); v[i][3] += bfhi(dv[i].y) + bfhi(dw[i].y);
            ss += v[i][0] * v[i][0] + v[i][1] * v[i][1] + v[i][2] * v[i][2] + v[i][3] * v[i][3]; }
        ss = wave_sum(ss);
        const float rstd = rsqrtf(ss * (1.f / 2048.f) + 1e-6f);
#pragma unroll
        for (int i = 0; i < 8; ++i) {
            const int col = i * 256 + lane * 4;
            if (xout && row < ML) __builtin_nontemporal_store(v[i], (f32x4*)(xout + (size_t)row * D + col));
            const f32x4 y = v[i] * rstd * ca[i] + cb[i];
            if (outb) { u32x2 o; o.x = cvt_pk_bf16(y[0], y[1]); o.y = cvt_pk_bf16(y[2], y[3]); *(u32x2*)(outb + (size_t)row * D + col) = o; }
            else __builtin_nontemporal_store(y, (f32x4*)(outf + (size_t)row * D + col));
        }
#pragma unroll
        for (int i = 0; i < 8; ++i) { v[i] = nv[i]; dv[i] = nd[i]; dw[i] = nw2[i]; }
    }
}

__device__ __forceinline__ void conv_unit(const Params& p, int unit) {
    const int t = threadIdx.x, c8 = t & 31, t8 = t >> 5;
    const int ck = unit >> 3, cb = unit & 7;
    const int ch0 = cb * 256 + c8 * 8;
    const int row0 = ck * 128 + t8 * 8;
    const bool lat = ck < 256;
    const bf16_t* ZQK = (const bf16_t*)(p.ws + WS_ZQK);
    const bf16_t* V = (const bf16_t*)(p.ws + WS_V);
    bf16_t* Q = (bf16_t*)(p.ws + WS_Q); bf16_t* Kn = (bf16_t*)(p.ws + WS_K); bf16_t* KT = (bf16_t*)(p.ws + WS_KT); bf16_t* VT = (bf16_t*)(p.ws + WS_VT);
    if (cb < 4) {
        if (!lat && cb < 2) return;
        int seq_lo, seq_hi;
        if (lat) { seq_lo = (ck >> 5) * 4096; seq_hi = seq_lo + 4096; } else { seq_lo = ML + ((ck - 256) >> 1) * 256; seq_hi = seq_lo + 256; }
        u32x4 z[12];
#pragma unroll
        for (int i = 0; i < 12; ++i) { const int r = row0 - 2 + i; z[i] = (u32x4){0u, 0u, 0u, 0u}; if (r >= seq_lo && r < seq_hi) z[i] = *(const u32x4*)(ZQK + (size_t)r * 1024 + ch0); }
        const float* cw = p.in[11]; const float* cbias = p.in[12];
        float y[8][8];
#pragma unroll
        for (int c = 0; c < 8; ++c) {
            const float w0 = cw[0 * 1024 + ch0 + c], w1 = cw[1 * 1024 + ch0 + c], w2 = cw[2 * 1024 + ch0 + c], w3 = cw[3 * 1024 + ch0 + c], w4 = cw[4 * 1024 + ch0 + c], bb = cbias[ch0 + c];
#pragma unroll
            for (int r = 0; r < 8; ++r) {
                float a = bb + bfel(z[r], c) * w0 + bfel(z[r + 1], c) * w1 + bfel(z[r + 2], c) * w2 + bfel(z[r + 3], c) * w3 + bfel(z[r + 4], c) * w4;
                a = siluf_(a);
                y[r][c] = (cb < 2) ? a * 0.08838834764831845f : a;
            }
        }
        if (lat) {
            bf16_t* dn = (cb < 2) ? Q + (size_t)row0 * 512 + ch0 : Kn + (size_t)row0 * 512 + (ch0 - 512);
#pragma unroll
            for (int r = 0; r < 8; ++r) { u32x4 o; o.x = cvt_pk_bf16(y[r][0], y[r][1]); o.y = cvt_pk_bf16(y[r][2], y[r][3]); o.z = cvt_pk_bf16(y[r][4], y[r][5]); o.w = cvt_pk_bf16(y[r][6], y[r][7]);
                *(u32x4*)(dn + (size_t)r * 512) = o; }
        }
        if (cb >= 2) {
            const int kc = ch0 - 512, h = kc >> 7, dk = kc & 127;
            bf16_t* dt = KT + ((size_t)(ck * 4 + h) * 128 + dk) * 128 + t8 * 8;
#pragma unroll
            for (int c = 0; c < 8; ++c) { u32x4 o; o.x = cvt_pk_bf16(y[0][c], y[1][c]); o.y = cvt_pk_bf16(y[2][c], y[3][c]); o.z = cvt_pk_bf16(y[4][c], y[5][c]); o.w = cvt_pk_bf16(y[6][c], y[7][c]);
                *(u32x4*)(dt + (size_t)c * 128) = o; }
        }
    } else {
        const int vch = ch0 - 1024, h = vch >> 8, dv = vch & 255;
        u32x4 z[8];
#pragma unroll
        for (int r = 0; r < 8; ++r) z[r] = *(const u32x4*)(V + (size_t)(row0 + r) * 1024 + vch);
        bf16_t* dt = VT + ((size_t)(ck * 4 + h) * 256 + dv) * 128 + t8 * 8;
#pragma unroll
        for (int c = 0; c < 8; ++c) { u32x4 o;
            o.x = us16(z[0], c) | (us16(z[1], c) << 16); o.y = us16(z[2], c) | (us16(z[3], c) << 16); o.z = us16(z[4], c) | (us16(z[5], c) << 16); o.w = us16(z[6], c) | (us16(z[7], c) << 16);
            *(u32x4*)(dt + (size_t)c * 128) = o; }
    }
}

__device__ __forceinline__ void gmlp_unit(const Params& p, LAS unsigned char* lds, int unit) {
    LAS bf16_t* Wt = (LAS bf16_t*)lds;
    LAS bf16_t* vnT = (LAS bf16_t*)(lds + 34816);
    LAS float* rstd = (LAS float*)(lds + 69632);
    const int t = threadIdx.x, wid = t >> 6, lane = t & 63, fr = lane & 15, fq = lane >> 4;
    const int r0 = unit * 128;
    const bf16_t* U = (const bf16_t*)(p.ws + WS_U); const bf16_t* GV = (const bf16_t*)(p.ws + WS_GV); bf16_t* CAT = (bf16_t*)(p.ws + WS_CAT);
    for (int q = wid; q < 128; q += 8) {
        float ss = 0.f;
#pragma unroll
        for (int i = 0; i < 2; ++i) { const u32x4 v = *(const u32x4*)(GV + (size_t)(r0 + q) * 1024 + i * 512 + lane * 8);
#pragma unroll
            for (int c = 0; c < 8; ++c) { const float f = bfel(v, c); ss += f * f; } }
        ss = wave_sum(ss);
        if (lane == 0) rstd[q] = rsqrtf(ss * (1.f / 1024.f) + 1e-6f);
    }
    __syncthreads();
    for (int g = 0; g < 8; ++g) {
        const float* ws_ = p.in[17] + (size_t)g * 128 * 128;
#pragma unroll
        for (int i = 0; i < 8; ++i) { const int idx = t + 512 * i, pr = idx >> 5, q4 = (idx & 31) * 4; const f32x4 v = *(const f32x4*)(ws_ + pr * 128 + q4);
            u32x2 o; o.x = cvt_pk_bf16(v[0], v[1]); o.y = cvt_pk_bf16(v[2], v[3]); *(LAS u32x2*)(Wt + pr * 136 + q4) = o; }
        const float* gn = p.in[16] + g * 128;
#pragma unroll
        for (int i = 0; i < 4; ++i) { const int d8 = (t & 15) * 8, q = (t >> 4) + 32 * i; const u32x4 v = *(const u32x4*)(GV + (size_t)(r0 + q) * 1024 + g * 128 + d8); const float rs = rstd[q];
#pragma unroll
            for (int c = 0; c < 8; ++c) { const float f = bfel(v, c) * rs * gn[d8 + c]; vnT[(d8 + c) * 136 + q] = (bf16_t)(cvt_pk_bf16(f, 0.f) & 0xffffu); } }
        __syncthreads();
        f32x4 acc[8];
#pragma unroll
        for (int nb = 0; nb < 8; ++nb) acc[nb] = (f32x4){0.f, 0.f, 0.f, 0.f};
#pragma unroll
        for (int kk = 0; kk < 4; ++kk) { const bf16x8 a = *(const LAS bf16x8*)(Wt + (16 * wid + fr) * 136 + kk * 32 + fq * 8);
#pragma unroll
            for (int nb = 0; nb < 8; ++nb) { const bf16x8 bv = *(const LAS bf16x8*)(vnT + (nb * 16 + fr) * 136 + kk * 32 + fq * 8);
                acc[nb] = __builtin_amdgcn_mfma_f32_16x16x32_bf16(bv, a, acc[nb], 0, 0, 0); } }
        const int pp = 16 * wid + fr; const float bs = p.in[18][g * 128 + pp];
#pragma unroll
        for (int nb = 0; nb < 8; ++nb) { const int d = nb * 16 + fq * 4; const u32x2 uu = *(const u32x2*)(U + (size_t)(r0 + pp) * 1024 + g * 128 + d);
            u32x2 o; o.x = cvt_pk_bf16(bflo(uu.x) * (acc[nb][0] + bs), bfhi(uu.x) * (acc[nb][1] + bs)); o.y = cvt_pk_bf16(bflo(uu.y) * (acc[nb][2] + bs), bfhi(uu.y) * (acc[nb][3] + bs));
            *(u32x2*)(CAT + (size_t)(r0 + pp) * 2048 + 1024 + g * 128 + d) = o; }
        __syncthreads();
    }
}

__device__ __forceinline__ int scan_chunk(int s, int dir, int b) { if (s < 2) return 256 + 2 * b + (dir ? 1 - s : s); const int li = s - 2; return 32 * b + (dir ? 31 - li : li); }

__device__ __forceinline__ void scan_issue(const Params& p, int s, int dir, int b, int h, int slice, u32x4 (&kreg)[4], u32x4 (&vreg)[2]) {
    const int t = threadIdx.x;
    const int ck = scan_chunk(s, dir, b);
    const bf16_t* kt = (const bf16_t*)(p.ws + WS_KT) + (size_t)(ck * 4 + h) * 128 * 128;
#pragma unroll
    for (int i = 0; i < 4; ++i) { const int idx = t + 512 * i; kreg[i] = *(const u32x4*)(kt + (idx >> 4) * 128 + (idx & 15) * 8); }
    const bf16_t* vt = (const bf16_t*)(p.ws + WS_VT) + ((size_t)(ck * 4 + h) * 256 + slice * 64) * 128;
#pragma unroll
    for (int i = 0; i < 2; ++i) { const int idx = t + 512 * i; vreg[i] = *(const u32x4*)(vt + (idx >> 4) * 128 + (idx & 15) * 8); }
}

__device__ __forceinline__ void scan_phase(const Params& p, LAS unsigned char* lds) {
    LAS float* wls = (LAS float*)(lds + 113152);
    LAS float* scs = (LAS float*)(lds + 113152 + 17408);
    const int t = threadIdx.x, wid = t >> 6, lane = t & 63, fr = lane & 15, fq = lane >> 4;
    bf16_t* CP = (bf16_t*)(p.ws + WS_XN); float* MP = (float*)(p.ws + WS_MPREV);
    const float* G = (const float*)(p.ws + WS_G);
    for (int u = blockIdx.x; u < 256; u += gridDim.x) {
        const int chain = u >> 2, slice = u & 3, dir = chain & 1, bh = chain >> 1, h = bh & 3, b = bh >> 2;
        u32x4 kreg[4], vreg[2];
        scan_issue(p, 0, dir, b, h, slice, kreg, vreg);
        for (int s = wid; s < 34; s += 8) {
            const int ck = scan_chunk(s, dir, b);
            const int p0 = 2 * lane, t0 = dir ? 127 - p0 : p0, t1 = dir ? 126 - p0 : p0 + 1;
            const float* g = G + (size_t)ck * 128 * 16 + dir * 8 + h;
            const float gi0 = g[t0 * 16], gi1 = g[t1 * 16], gf0 = g[t0 * 16 + 4], gf1 = g[t1 * 16 + 4];
            const float P = wave_scan_sum(gf0 + gf1, lane);
            const float total = __shfl(P, 63);
            const float g0 = total - (P - gf1) + gi0, g1 = total - P + gi1;
            const float mloc = wave_max(fmaxf(g0, g1));
            wls[s * 128 + t0] = g0; wls[s * 128 + t1] = g1;
            if (lane == 0) { scs[s * 4 + 2] = total; scs[s * 4 + 3] = mloc; }
        }
        __syncthreads();
        if (t == 0) {
            float m = 0.f;
            for (int s = 0; s < 34; ++s) { const float total = scs[s * 4 + 2], mloc = scs[s * 4 + 3]; const float m_new = fmaxf(total + m, mloc);
                scs[s * 4 + 0] = __expf(total + m - m_new); scs[s * 4 + 1] = m; scs[s * 4 + 2] = m_new; m = m_new; }
        }
        __syncthreads();
        for (int idx = t; idx < 34 * 128; idx += 512) wls[idx] = __expf(wls[idx] - scs[(idx >> 7) * 4 + 2]);
        __syncthreads();
        f32x4 st[5];
#pragma unroll
        for (int nb = 0; nb < 5; ++nb) st[nb] = (f32x4){0.f, 0.f, 0.f, 0.f};
        for (int s = 0; s < 34; ++s) {
            LAS bf16_t* kT = (LAS bf16_t*)(lds + (s & 1) * 56576);
            LAS bf16_t* wvT = (LAS bf16_t*)(lds + (s & 1) * 56576 + 34816);
            LAS float* wb = wls + s * 128;
#pragma unroll
            for (int i = 0; i < 4; ++i) { const int idx = t + 512 * i; *(LAS u32x4*)(kT + (idx >> 4) * 136 + (idx & 15) * 8) = kreg[i]; }
#pragma unroll
            for (int i = 0; i < 2; ++i) { const int idx = t + 512 * i, r = idx >> 4, c8 = (idx & 15) * 8;
                const f32x4 w0 = *(const LAS f32x4*)(wb + c8), w1 = *(const LAS f32x4*)(wb + c8 + 4);
                u32x4 o; o.x = cvt_pk_bf16(bflo(vreg[i].x) * w0[0], bfhi(vreg[i].x) * w0[1]); o.y = cvt_pk_bf16(bflo(vreg[i].y) * w0[2], bfhi(vreg[i].y) * w0[3]);
                o.z = cvt_pk_bf16(bflo(vreg[i].z) * w1[0], bfhi(vreg[i].z) * w1[1]); o.w = cvt_pk_bf16(bflo(vreg[i].w) * w1[2], bfhi(vreg[i].w) * w1[3]);
                *(LAS u32x4*)(wvT + r * 136 + c8) = o; }
            if (t < 256) { const int r = 64 + (t >> 4), c8 = (t & 15) * 8; u32x4 o = (u32x4){0u, 0u, 0u, 0u};
                if (r == 64) { const f32x4 w0 = *(const LAS f32x4*)(wb + c8), w1 = *(const LAS f32x4*)(wb + c8 + 4);
                    o.x = cvt_pk_bf16(w0[0], w0[1]); o.y = cvt_pk_bf16(w0[2], w0[3]); o.z = cvt_pk_bf16(w1[0], w1[1]); o.w = cvt_pk_bf16(w1[2], w1[3]); }
                *(LAS u32x4*)(wvT + r * 136 + c8) = o; }
            const int ck = scan_chunk(s, dir, b);
            if (s + 1 < 34) scan_issue(p, s + 1, dir, b, h, slice, kreg, vreg);
            __syncthreads();
            const float decay = scs[s * 4];
            if (s >= 2) {
                const int cc = ck - 32 * b;
                bf16_t* cp = CP + (size_t)(chain * 32 + cc) * (272 * 128);
                const int col = 16 * wid + 4 * fq;
#pragma unroll
                for (int nb = 0; nb < 4; ++nb) { u32x2 o; o.x = cvt_pk_bf16(st[nb][0], st[nb][1]); o.y = cvt_pk_bf16(st[nb][2], st[nb][3]); *(u32x2*)(cp + (size_t)(slice * 64 + nb * 16 + fr) * 128 + col) = o; }
                if (slice == 0) { u32x2 o; o.x = cvt_pk_bf16(st[4][0], st[4][1]); o.y = cvt_pk_bf16(st[4][2], st[4][3]); *(u32x2*)(cp + (size_t)(256 + fr) * 128 + col) = o;
                    if (t == 0) MP[chain * 32 + cc] = scs[s * 4 + 1]; }
            }
            f32x4 acc[5];
#pragma unroll
            for (int nb = 0; nb < 5; ++nb) acc[nb] = (f32x4){0.f, 0.f, 0.f, 0.f};
#pragma unroll
            for (int kk = 0; kk < 4; ++kk) { const bf16x8 a = *(const LAS bf16x8*)(kT + (16 * wid + fr) * 136 + kk * 32 + fq * 8);
#pragma unroll
                for (int nb = 0; nb < 5; ++nb) { const bf16x8 bv = *(const LAS bf16x8*)(wvT + (nb * 16 + fr) * 136 + kk * 32 + fq * 8);
                    acc[nb] = __builtin_amdgcn_mfma_f32_16x16x32_bf16(a, bv, acc[nb], 0, 0, 0); } }
#pragma unroll
            for (int nb = 0; nb < 5; ++nb) st[nb] = st[nb] * decay + acc[nb];
        }
        __syncthreads();
    }
}

__device__ __forceinline__ void mout_issue(const Params& p, int u, u32x4 (&kreg)[4], bf16x8 (&qf)[4], float (&gg)[5]) {
    const int t = threadIdx.x, wid = t >> 6, lane = t & 63, fr = lane & 15, fq = lane >> 4;
    const int dir = u & 1, cc = (u >> 1) & 31, bh = u >> 6, h = bh & 3, b = bh >> 2, chain = bh * 2 + dir, ck = 32 * b + cc, r0 = ck * 128;
    const bf16_t* Q = (const bf16_t*)(p.ws + WS_Q); const bf16_t* Kn = (const bf16_t*)(p.ws + WS_K);
#pragma unroll
    for (int i = 0; i < 4; ++i) { const int idx = t + 512 * i, r = idx >> 4, c8 = (idx & 15) * 8; kreg[i] = *(const u32x4*)(Kn + (size_t)(r0 + r) * 512 + h * 128 + c8); }
#pragma unroll
    for (int kk = 0; kk < 4; ++kk) qf[kk] = *(const bf16x8*)(Q + (size_t)(r0 + 16 * wid + fr) * 512 + h * 128 + kk * 32 + fq * 8);
    if (wid == 0) {
        const int p0 = 2 * lane, t0 = dir ? 127 - p0 : p0, t1 = dir ? 126 - p0 : p0 + 1;
        const float* g = (const float*)(p.ws + WS_G) + (size_t)r0 * 16 + dir * 8 + h;
        gg[0] = g[t0 * 16]; gg[1] = g[t1 * 16]; gg[2] = g[t0 * 16 + 4]; gg[3] = g[t1 * 16 + 4];
        gg[4] = ((const float*)(p.ws + WS_MPREV))[chain * 32 + cc];
    }
}

__device__ __forceinline__ void mout_phase(const Params& p, LAS unsigned char* lds) {
    LAS bf16_t* T = (LAS bf16_t*)lds;
    LAS bf16_t* sb = (LAS bf16_t*)(lds + 73984);
    LAS float* fv = (LAS float*)(lds + 73984 + 34816);
    const int t = threadIdx.x, wid = t >> 6, lane = t & 63, fr = lane & 15, fq = lane >> 4;
    const bf16_t* CP = (const bf16_t*)(p.ws + WS_XN);
    const bf16_t* VT = (const bf16_t*)(p.ws + WS_VT);
    u32x4 kreg[4]; bf16x8 qf[4]; float gg[5] = {0.f, 0.f, 0.f, 0.f, 0.f};
    int u = 2 * blockIdx.x;
    if (u < 2048) mout_issue(p, u, kreg, qf, gg);
    for (; u < 2048; u = (u & 1) ? u - 1 + 2 * (int)gridDim.x : u + 1) {
        const int dir = u & 1, cc = (u >> 1) & 31, bh = u >> 6, h = bh & 3, b = bh >> 2, chain = bh * 2 + dir, ck = 32 * b + cc, r0 = ck * 128;
        if (wid == 0) {
            const int p0 = 2 * lane, t0 = dir ? 127 - p0 : p0, t1 = dir ? 126 - p0 : p0 + 1;
            const float gi0 = gg[0], gi1 = gg[1], gf0 = gg[2], gf1 = gg[3], mst = gg[4];
            const float P = wave_scan_sum(gf0 + gf1, lane);
            const float b1 = P, b0 = P - gf1;
            const float c0 = gi0 - b0, c1 = gi1 - b1;
            const float Mi = wave_scan_max(fmaxf(c0, c1), lane);
            float Me = __shfl_up(Mi, 1); if (lane == 0) Me = -INFINITY;
            const float pm0 = fmaxf(Me, c0), pm1 = Mi;
            const float mt0 = fmaxf(b0 + mst, b0 + pm0), mt1 = fmaxf(b1 + mst, b1 + pm1);
            fv[t0] = b0 - mt0; fv[t1] = b1 - mt1;
            fv[128 + t0] = c0; fv[128 + t1] = c1;
            fv[256 + t0] = __expf(b0 + mst - mt0); fv[256 + t1] = __expf(b1 + mst - mt1);
            fv[384 + t0] = __expf(-mt0); fv[384 + t1] = __expf(-mt1);
        }
#pragma unroll
        for (int i = 0; i < 4; ++i) { const int idx = t + 512 * i, r = idx >> 4, c8 = (idx & 15) * 8; *(LAS u32x4*)(T + r * 136 + c8) = kreg[i]; }
        u32x4 creg[9];
        { const bf16_t* cp = CP + (size_t)(chain * 32 + cc) * (272 * 128);
#pragma unroll
          for (int i = 0; i < 9; ++i) { const int idx = t + 512 * i; creg[i] = (u32x4){0u, 0u, 0u, 0u}; if (idx < 272 * 16) creg[i] = *(const u32x4*)(cp + (size_t)(idx >> 4) * 128 + (idx & 15) * 8); } }
        __syncthreads();
        const int j = 16 * wid + fr;
        {
            f32x4 S[8];
#pragma unroll
            for (int nb = 0; nb < 8; ++nb) S[nb] = (f32x4){0.f, 0.f, 0.f, 0.f};
#pragma unroll
            for (int kk = 0; kk < 4; ++kk)
#pragma unroll
                for (int nb = 0; nb < 8; ++nb) { const bf16x8 kf = *(const LAS bf16x8*)(T + (nb * 16 + fr) * 136 + kk * 32 + fq * 8);
                    S[nb] = __builtin_amdgcn_mfma_f32_16x16x32_bf16(kf, qf[kk], S[nb], 0, 0, 0); }
            const float rb = fv[j];
#pragma unroll
            for (int nb = 0; nb < 8; ++nb) { const int l0 = nb * 16 + 4 * fq; const f32x4 cw = *(const LAS f32x4*)(fv + 128 + l0);
                float sv[4];
#pragma unroll
                for (int i = 0; i < 4; ++i) { const int l = l0 + i; const bool valid = dir ? (l >= j) : (l <= j); sv[i] = valid ? S[nb][i] * __expf(rb + cw[i]) : 0.f; }
                u32x2 o; o.x = cvt_pk_bf16(sv[0], sv[1]); o.y = cvt_pk_bf16(sv[2], sv[3]); *(LAS u32x2*)(sb + j * 136 + l0) = o; }
        }
        __syncthreads();
#pragma unroll
        for (int i = 0; i < 9; ++i) { const int idx = t + 512 * i; if (idx < 272 * 16) *(LAS u32x4*)(T + (idx >> 4) * 136 + (idx & 15) * 8) = creg[i]; }
        u32x4 vreg[8];
        { const bf16_t* vt = VT + (size_t)(ck * 4 + h) * 256 * 128;
#pragma unroll
          for (int i = 0; i < 8; ++i) { const int idx = t + 512 * i; vreg[i] = *(const u32x4*)(vt + (size_t)(idx >> 4) * 128 + (idx & 15) * 8); } }
        __syncthreads();
        f32x4 acc[17];
#pragma unroll
        for (int nb = 0; nb < 17; ++nb) acc[nb] = (f32x4){0.f, 0.f, 0.f, 0.f};
#pragma unroll
        for (int kk = 0; kk < 4; ++kk)
#pragma unroll
            for (int nb = 0; nb < 17; ++nb) { const bf16x8 cf = *(const LAS bf16x8*)(T + (nb * 16 + fr) * 136 + kk * 32 + fq * 8);
                acc[nb] = __builtin_amdgcn_mfma_f32_16x16x32_bf16(cf, qf[kk], acc[nb], 0, 0, 0); }
        { const float aj = fv[256 + j];
#pragma unroll
          for (int nb = 0; nb < 17; ++nb) acc[nb] = acc[nb] * aj; }
        __syncthreads();
#pragma unroll
        for (int i = 0; i < 8; ++i) { const int idx = t + 512 * i; *(LAS u32x4*)(T + (idx >> 4) * 136 + (idx & 15) * 8) = vreg[i]; }
        if (t < 256) { const int r = 256 + (t >> 4), c8 = (t & 15) * 8; const unsigned one = (r == 256) ? 0x3F803F80u : 0u; *(LAS u32x4*)(T + r * 136 + c8) = (u32x4){one, one, one, one}; }
        const float einv = fv[384 + j];
        { const int un = (u & 1) ? u - 1 + 2 * (int)gridDim.x : u + 1; if (un < 2048) mout_issue(p, un, kreg, qf, gg); }
        __syncthreads();
#pragma unroll
        for (int kk = 0; kk < 4; ++kk) { const bf16x8 sf = *(const LAS bf16x8*)(sb + j * 136 + kk * 32 + fq * 8);
#pragma unroll
            for (int nb = 0; nb < 17; ++nb) { const bf16x8 vf = *(const LAS bf16x8*)(T + (nb * 16 + fr) * 136 + kk * 32 + fq * 8);
                acc[nb] = __builtin_amdgcn_mfma_f32_16x16x32_bf16(vf, sf, acc[nb], 0, 0, 0); } }
        const float nq = __shfl(acc[16][0], fr);
        const float inv = 1.f / fmaxf(fabsf(nq), einv);
        bf16_t* hd = (bf16_t*)(p.ws + WS_HDIR) + (size_t)(r0 + j) * 1024 + h * 256;
        if (dir == 0) {
#pragma unroll
            for (int nb = 0; nb < 16; ++nb) { u32x2 o; o.x = cvt_pk_bf16(acc[nb][0] * inv, acc[nb][1] * inv); o.y = cvt_pk_bf16(acc[nb][2] * inv, acc[nb][3] * inv); *(u32x2*)(hd + nb * 16 + 4 * fq) = o; }
        } else {
            float ss = 0.f;
#pragma unroll
            for (int nb = 0; nb < 16; ++nb) { const u32x2 hv = *(const u32x2*)(hd + nb * 16 + 4 * fq);
                acc[nb][0] = acc[nb][0] * inv + bflo(hv.x); acc[nb][1] = acc[nb][1] * inv + bfhi(hv.x); acc[nb][2] = acc[nb][2] * inv + bflo(hv.y); acc[nb][3] = acc[nb][3] * inv + bfhi(hv.y);
                ss += acc[nb][0] * acc[nb][0] + acc[nb][1] * acc[nb][1] + acc[nb][2] * acc[nb][2] + acc[nb][3] * acc[nb][3]; }
            ss += __shfl_xor(ss, 16); ss += __shfl_xor(ss, 32);
            const float rstd = rsqrtf(ss * (1.f / 256.f) + 1e-6f);
            const float* ng = p.in[15] + h * 256;
            const bf16_t* og = (const bf16_t*)(p.ws + WS_O) + (size_t)(r0 + j) * 1024 + h * 256;
            bf16_t* cat = (bf16_t*)(p.ws + WS_CAT) + (size_t)(r0 + j) * 2048 + h * 256;
#pragma unroll
            for (int nb = 0; nb < 16; ++nb) { const int dv = nb * 16 + 4 * fq; const f32x4 gn = *(const f32x4*)(ng + dv); const u32x2 ov = *(const u32x2*)(og + dv);
                u32x2 o; o.x = cvt_pk_bf16(acc[nb][0] * rstd * gn[0] * bflo(ov.x), acc[nb][1] * rstd * gn[1] * bfhi(ov.x));
                o.y = cvt_pk_bf16(acc[nb][2] * rstd * gn[2] * bflo(ov.y), acc[nb][3] * rstd * gn[3] * bfhi(ov.y));
                *(u32x2*)(cat + dv) = o;
                if ((nb & 3) == 3) asm volatile("" ::: "memory"); }
        }
        __syncthreads();
    }
}

__device__ __forceinline__ void finish_phase(const Params& p) {
    const int wid = threadIdx.x >> 6, lane = threadIdx.x & 63;
    const bf16_t* HD = (const bf16_t*)(p.ws + WS_HDIR); const bf16_t* O = (const bf16_t*)(p.ws + WS_O); bf16_t* CAT = (bf16_t*)(p.ws + WS_CAT);
    const float* ng = p.in[15];
    for (int row = blockIdx.x * 8 + wid; row < ML; row += gridDim.x * 8) {
        const int e0 = lane * 16;
        float hs[16]; float ss = 0.f;
#pragma unroll
        for (int i = 0; i < 2; ++i) { const u32x4 a = *(const u32x4*)(HD + (size_t)row * 1024 + e0 + i * 8), bq = *(const u32x4*)(HD + (size_t)ML * 1024 + (size_t)row * 1024 + e0 + i * 8);
#pragma unroll
            for (int c = 0; c < 8; ++c) { const float f = bfel(a, c) + bfel(bq, c); hs[i * 8 + c] = f; ss += f * f; } }
        ss += __shfl_xor(ss, 1); ss += __shfl_xor(ss, 2); ss += __shfl_xor(ss, 4); ss += __shfl_xor(ss, 8);
        const float rstd = rsqrtf(ss * (1.f / 256.f) + 1e-6f);
#pragma unroll
        for (int i = 0; i < 2; ++i) { const u32x4 ov = *(const u32x4*)(O + (size_t)row * 1024 + e0 + i * 8);
            float y[8];
#pragma unroll
            for (int c = 0; c < 8; ++c) y[c] = hs[i * 8 + c] * rstd * ng[e0 + i * 8 + c] * bfel(ov, c);
            u32x4 o; o.x = cvt_pk_bf16(y[0], y[1]); o.y = cvt_pk_bf16(y[2], y[3]); o.z = cvt_pk_bf16(y[4], y[5]); o.w = cvt_pk_bf16(y[6], y[7]);
            *(u32x4*)(CAT + (size_t)row * 2048 + e0 + i * 8) = o; }
    }
}

template <int ph> __device__ __forceinline__ void run_phase(const Params& p, LAS unsigned char* lds) {
    unsigned char* ws = p.ws;
    const float* mod = (const float*)(ws + WS_MOD);
    bf16_t* const XN = (bf16_t*)(ws + WS_XN); bf16_t* const Hb = (bf16_t*)(ws + WS_H);
    if (ph == 0) { unsigned* cnt = (unsigned*)(ws + WS_BAR) + 3600;
        for (int u = blockIdx.x; u < 256 + 10304; u += gridDim.x) {
            if (u < 256) { adaln_unit(p, (LAS float*)lds, u);
                if (threadIdx.x == 0) { __builtin_amdgcn_fence(__ATOMIC_RELEASE, "agent"); asm volatile("s_waitcnt vmcnt(0)" ::: "memory"); __hip_atomic_fetch_add(cnt, 1u, __ATOMIC_RELAXED, __HIP_MEMORY_SCOPE_AGENT); } }
            else wtile_unit(p, (LAS float*)lds, u - 256); }
        if (threadIdx.x == 0) { unsigned sp = 0; while (__hip_atomic_load(cnt, __ATOMIC_RELAXED, __HIP_MEMORY_SCOPE_AGENT) < 256u && ++sp < (1u << 22)) __builtin_amdgcn_s_sleep(2);
            __builtin_amdgcn_fence(__ATOMIC_ACQUIRE, "agent"); asm volatile("s_waitcnt vmcnt(0)" ::: "memory"); }
        __syncthreads();
        norm_phase(p.in[0], p.in[2], nullptr, nullptr, nullptr, nullptr, M1, p.in[6], mod, 0 * D, 1 * D, XN, nullptr); }
    else if (ph == 1) { }
    else if (ph == 2) gemm_phase(lds, p, XN, (const bf16_t*)(ws + WS_WF1IN), M1, 2 * DFF, D, EPI_SWIGLU, 1, Hb, 0, 0.f);
    else if (ph == 3) gemm_phase(lds, p, Hb, (const bf16_t*)(ws + WS_WF1OUT), M1, D, DFF, EPI_RESID, 1, XN, 2 * D, 0.5f);
    else if (ph == 4) norm_phase(p.in[0], p.in[2], XN, nullptr, (const bf16_t*)(ws + WS_CAT), p.out, M1, p.in[9], mod, 3 * D, 4 * D, XN, nullptr);
    else if (ph == 5) gemm_phase(lds, p, XN, (const bf16_t*)(ws + WS_WIN), M1, INP, D, EPI_INPROJ, 1, Hb, 0, 0.f);
    else if (ph == 6) { for (int u = blockIdx.x; u < 256 + 2176; u += gridDim.x) { if (u < 256) gmlp_unit(p, lds, u); else conv_unit(p, u - 256); } }
    else if (ph == 7) scan_phase(p, lds);
    else if (ph == 8) mout_phase(p, lds);
    else if (ph == 9) { }
    else if (ph == 10) gemm_phase(lds, p, (const bf16_t*)(ws + WS_CAT), (const bf16_t*)(ws + WS_WOUT), ML, D, D, EPI_RESID, 1, (bf16_t*)(ws + WS_K), 5 * D, 1.0f);
    else if (ph == 11) norm_phase(p.out, p.out, (const bf16_t*)(ws + WS_K), nullptr, nullptr, nullptr, ML, p.in[20], mod, 6 * D, 7 * D, XN, nullptr);
    else if (ph == 12) gemm_phase(lds, p, XN, (const bf16_t*)(ws + WS_WF2IN), ML, 2 * DFF, D, EPI_SWIGLU, 1, Hb, 0, 0.f);
    else if (ph == 13) gemm_phase(lds, p, Hb, (const bf16_t*)(ws + WS_WF2OUT), ML, D, DFF, EPI_RESID, 1, XN, 8 * D, 0.5f);
    else if (ph == 14) norm_phase(p.out, p.out, XN, (const bf16_t*)(ws + WS_K), nullptr, nullptr, ML, p.in[23], nullptr, 0, 0, nullptr, p.out);
}

#define RUNPH(n) if (p.ph_lo <= n && n < p.ph_hi) { run_phase<n>(p, lds); if (n + 1 < p.ph_hi) xcd_barrier(xb); }
__global__ void __launch_bounds__(512, 2) hymba_megakernel(Params p) {
    extern __shared__ __attribute__((aligned(16))) unsigned char shm[];
    LAS unsigned char* lds = (LAS unsigned char*)shm;
    cg::grid_group grid = cg::this_grid();
    unsigned* barw = (unsigned*)(p.ws + WS_BAR);
    volatile LAS unsigned* stw = (volatile LAS unsigned*)(lds + LDS_BYTES - 16);
    if (threadIdx.x == 0) { stw[0] = 0u; stw[1] = 0u; }
    __syncthreads();
    XcdBarrier xb = xcd_barrier_post(barw, stw);
    if (p.ph_hi < 0) grid.sync();
    RUNPH(0)
    RUNPH(2) RUNPH(3) RUNPH(4) RUNPH(5) RUNPH(6) RUNPH(7) RUNPH(8) RUNPH(10) RUNPH(11) RUNPH(12) RUNPH(13) RUNPH(14)
}

extern "C" void kernel_launch(void* const* d_in, const int* in_sizes, int n_in, void* d_out, int out_size, void* d_ws, size_t ws_size, hipStream_t stream) {
    static int grid = 0;
    if (grid == 0) {
        if (n_in != 24 || out_size != ML * D || ws_size < WS_END) { fprintf(stderr, "kernel_launch: unexpected shapes (n_in %d out %d ws %zu need %zu)\n", n_in, out_size, ws_size, (size_t)WS_END); grid = -1; return; }
        int dev = 0, cus = 0, per_cu = 0;
        hipGetDevice(&dev);
        hipDeviceGetAttribute(&cus, hipDeviceAttributeMultiprocessorCount, dev);
        if (hipFuncSetAttribute((const void*)hymba_megakernel, hipFuncAttributeMaxDynamicSharedMemorySize, LDS_BYTES) != hipSuccess) { fprintf(stderr, "kernel_launch: hipFuncSetAttribute failed\n"); }
        if (hipOccupancyMaxActiveBlocksPerMultiprocessor(&per_cu, (const void*)hymba_megakernel, 512, LDS_BYTES) != hipSuccess || per_cu < 1) per_cu = 1;
        (void)hipGetLastError();
        grid = cus * per_cu;
        fprintf(stderr, "kernel_launch: cus %d per_cu %d grid %d\n", cus, per_cu, grid);
    }
    if (grid < 0) return;
    Params p{};
    for (int i = 0; i < 24; ++i) p.in[i] = (const float*)d_in[i];
    p.out = (float*)d_out; p.ws = (unsigned char*)d_ws;
#if MK_MULTI
    for (int ph = 0; ph < NPH; ++ph) { p.ph_lo = ph; p.ph_hi = ph + 1; hipLaunchKernelGGL(hymba_megakernel, dim3(grid), dim3(512), LDS_BYTES, stream, p); }
#else
    p.ph_lo = 0; p.ph_hi = NPH;
    if (hipMemsetAsync((char*)d_ws + WS_BAR, 0, 16384, stream) != hipSuccess) fprintf(stderr, "kernel_launch: memset of the barrier words failed\n");
    void* args[] = {&p};
    hipError_t e = hipLaunchCooperativeKernel((const void*)hymba_megakernel, dim3(grid), dim3(512), args, LDS_BYTES, stream);
    if (e != hipSuccess) fprintf(stderr, "cooperative launch failed: %s (grid %d)\n", hipGetErrorString(e), grid);
#endif
}
```
